# Optimizing an MI355X kernel written in HIP

```python
import math
import jax, jax.numpy as jnp
from jax import lax
import numpy as np

D_MODEL = 2048
BATCH = 4
SEQ = 2048
DEPTH = 1
DEC_BATCH = 128
DEC_SEQ = 4
PAST_LEN = 16384
PAGE_SIZE = 128

N_META = 16
D_FF = 256 * ((8 * D_MODEL // 3 + 255) // 256)
W_POOL = D_MODEL // 2
W_SSM = D_MODEL // 2
POOL_WINDOWS = (2, 4, 8, 16)
N_POOL_GROUPS = len(POOL_WINDOWS)
POOL_GW = W_POOL // N_POOL_GROUPS
POOL_HIST = max(POOL_WINDOWS) - 1
SSM_GS = 16
N_SSM_GROUPS = W_SSM // SSM_GS
SSM_STATE = 64
W_IN = W_POOL + W_SSM + 2 * D_MODEL
RMS_EPS = 1e-6

kernel_name = "gated_pool_s5_macaron_decoder_step"


def rmsnorm(x, g):
    xf = x.astype(jnp.float32)
    r = lax.rsqrt(jnp.mean(xf * xf, axis=-1, keepdims=True) + RMS_EPS)
    return (xf * r * g.astype(jnp.float32)).astype(x.dtype)


def swiglu(x, w_gate, w_up, w_down):
    return (jax.nn.silu(x @ w_gate) * (x @ w_up)) @ w_down


def pool_mix(u, hist, pos0, w_grp, scale):
    nb, L, _ = u.shape
    full = jnp.concatenate([hist.astype(u.dtype), u], axis=1)
    cs = jnp.cumsum(full.astype(jnp.float32), axis=1)
    cs = jnp.pad(cs, ((0, 0), (1, 0), (0, 0)))
    avail = jnp.arange(L, dtype=jnp.int32) + (pos0 + 1)
    means = []
    for g, w in enumerate(POOL_WINDOWS):
        sl = slice(g * POOL_GW, (g + 1) * POOL_GW)
        s = cs[:, POOL_HIST + 1:POOL_HIST + 1 + L, sl] - cs[:, POOL_HIST + 1 - w:POOL_HIST + 1 - w + L, sl]
        cnt = jnp.minimum(avail, w).astype(jnp.float32)[None, :, None]
        means.append(s / cnt)
    d = jnp.concatenate(means, axis=-1) - u.astype(jnp.float32)
    d = d.reshape(nb, L, N_POOL_GROUPS, POOL_GW)
    y = jnp.einsum('blgc,gcd->blgd', d, w_grp.astype(jnp.float32)).reshape(nb, L, W_POOL)
    y = y * scale.astype(jnp.float32)
    return y.astype(u.dtype), full[:, -POOL_HIST:]


def s5_scan(u, h0_re, h0_im, lam_re, lam_im, log_dt, b_re, b_im, c_re, c_im, d_skip):
    nb, L, _ = u.shape
    f32 = jnp.float32
    lam = lax.complex(lam_re.astype(f32), lam_im.astype(f32))
    dt = jnp.exp(log_dt.astype(f32))[:, None]
    lam_bar = jnp.exp(lam * dt)
    b_mat = lax.complex(b_re.astype(f32), b_im.astype(f32))
    b_bar = ((lam_bar - 1.0) / lam)[..., None] * b_mat
    c_mat = lax.complex(c_re.astype(f32), c_im.astype(f32))
    ug = u.astype(f32).reshape(nb, L, N_SSM_GROUPS, SSM_GS)
    bu = jnp.einsum('blgc,gpc->blgp', ug.astype(jnp.complex64), b_bar)
    h0 = lax.complex(h0_re.astype(f32), h0_im.astype(f32))
    bu = bu.at[:, 0].add(lam_bar[None] * h0)
    a = jnp.broadcast_to(lam_bar[None, None], (1, L, N_SSM_GROUPS, SSM_STATE))

    def combine(left, right):
        a1, b1 = left
        a2, b2 = right
        return a1 * a2, a2 * b1 + b2

    _, h = lax.associative_scan(combine, (a, bu), axis=1)
    y = jnp.einsum('blgp,gcp->blgc', h, c_mat).real
    y = y + d_skip.astype(f32).reshape(N_SSM_GROUPS, SSM_GS) * ug
    h_last = h[:, -1]
    return y.reshape(nb, L, W_SSM).astype(u.dtype), jnp.real(h_last), jnp.imag(h_last)


def setup_inputs(seed: int = 0) -> dict:
    key = jax.random.key(seed)
    ks = iter(jax.random.split(key, 40))
    f32 = jnp.float32

    def nrm(shape, scale):
        return jax.random.normal(next(ks), shape, f32) * scale

    def gain(shape):
        return 1.0 + 0.05 * jax.random.normal(next(ks), shape, f32)

    L_ = DEPTH
    n_idx = jnp.arange(SSM_STATE, dtype=f32)
    inp = {}
    inp["x_prompt"] = nrm((BATCH, SEQ, D_MODEL), 1.0)
    inp["x_sample"] = nrm((DEC_BATCH, DEC_SEQ, D_MODEL), 1.0)
    inp["state_pool"] = nrm((L_, DEC_BATCH, POOL_HIST, W_POOL), 1.0)
    inp["state_ssm_re"] = nrm((L_, DEC_BATCH, N_SSM_GROUPS, SSM_STATE), 0.3)
    inp["state_ssm_im"] = nrm((L_, DEC_BATCH, N_SSM_GROUPS, SSM_STATE), 0.3)
    inp["meta_tokens"] = nrm((N_META, D_MODEL), 1.0)
    inp["norm_ffn1"] = gain((L_, D_MODEL))
    inp["ffn1_w_gate"] = nrm((L_, D_MODEL, D_FF), D_MODEL ** -0.5)
    inp["ffn1_w_up"] = nrm((L_, D_MODEL, D_FF), D_MODEL ** -0.5)
    inp["ffn1_w_down"] = nrm((L_, D_FF, D_MODEL), D_FF ** -0.5)
    inp["norm_mix"] = gain((L_, D_MODEL))
    inp["w_in"] = nrm((L_, D_MODEL, W_IN), D_MODEL ** -0.5)
    inp["b_gate"] = nrm((L_, 2 * D_MODEL), 0.02)
    inp["pool_w"] = nrm((L_, N_POOL_GROUPS, POOL_GW, POOL_GW), POOL_GW ** -0.5)
    inp["pool_scale"] = gain((L_, W_POOL))
    inp["ssm_lambda_re"] = -0.5 + nrm((L_, N_SSM_GROUPS, SSM_STATE), 0.01)
    inp["ssm_lambda_im"] = math.pi * n_idx + nrm((L_, N_SSM_GROUPS, SSM_STATE), 0.01)
    inp["ssm_log_dt"] = jax.random.uniform(next(ks), (L_, N_SSM_GROUPS), f32,
                                           math.log(1e-3), math.log(1e-1))
    inp["ssm_b_re"] = nrm((L_, N_SSM_GROUPS, SSM_STATE, SSM_GS), (2 * SSM_GS) ** -0.5)
    inp["ssm_b_im"] = nrm((L_, N_SSM_GROUPS, SSM_STATE, SSM_GS), (2 * SSM_GS) ** -0.5)
    inp["ssm_c_re"] = nrm((L_, N_SSM_GROUPS, SSM_GS, SSM_STATE), (2 * SSM_STATE) ** -0.5)
    inp["ssm_c_im"] = nrm((L_, N_SSM_GROUPS, SSM_GS, SSM_STATE), (2 * SSM_STATE) ** -0.5)
    inp["ssm_d"] = nrm((L_, W_SSM), 1.0)
    inp["glu_w"] = nrm((L_, W_SSM, W_SSM), W_SSM ** -0.5)
    inp["glu_b"] = nrm((L_, W_SSM), 0.02)
    inp["w_branch_a"] = nrm((L_, W_POOL, D_MODEL), W_POOL ** -0.5)
    inp["w_branch_b"] = nrm((L_, W_SSM, D_MODEL), W_SSM ** -0.5)
    inp["w_out"] = nrm((L_, D_MODEL, D_MODEL), D_MODEL ** -0.5)
    inp["norm_ffn2"] = gain((L_, D_MODEL))
    inp["ffn2_w_gate"] = nrm((L_, D_MODEL, D_FF), D_MODEL ** -0.5)
    inp["ffn2_w_up"] = nrm((L_, D_MODEL, D_FF), D_MODEL ** -0.5)
    inp["ffn2_w_down"] = nrm((L_, D_FF, D_MODEL), D_FF ** -0.5)
    inp["final_norm"] = gain((D_MODEL,))
    return inp


def reference(x_prompt, x_sample, state_pool, state_ssm_re, state_ssm_im, meta_tokens,
              norm_ffn1, ffn1_w_gate, ffn1_w_up, ffn1_w_down,
              norm_mix, w_in, b_gate, pool_w, pool_scale,
              ssm_lambda_re, ssm_lambda_im, ssm_log_dt, ssm_b_re, ssm_b_im, ssm_c_re, ssm_c_im,
              ssm_d, glu_w, glu_b, w_branch_a, w_branch_b, w_out,
              norm_ffn2, ffn2_w_gate, ffn2_w_up, ffn2_w_down, final_norm):

    def mixer(xn, l, hist, h_re, h_im, pos0):
        z = xn @ w_in[l]
        u_pool = z[..., :W_POOL]
        u_ssm = z[..., W_POOL:W_POOL + W_SSM]
        gates = jax.nn.sigmoid(z[..., W_POOL + W_SSM:] + b_gate[l])
        gate_a = gates[..., :D_MODEL]
        gate_b = gates[..., D_MODEL:]
        a_out, hist_new = pool_mix(u_pool, hist, pos0, pool_w[l], pool_scale[l])
        s_out, hre_new, him_new = s5_scan(u_ssm, h_re, h_im, ssm_lambda_re[l], ssm_lambda_im[l],
                                          ssm_log_dt[l], ssm_b_re[l], ssm_b_im[l],
                                          ssm_c_re[l], ssm_c_im[l], ssm_d[l])
        s_out = jax.nn.gelu(s_out)
        s_out = s_out * jax.nn.sigmoid(s_out @ glu_w[l] + glu_b[l])
        merged = gate_a * (a_out @ w_branch_a[l]) + gate_b * (s_out @ w_branch_b[l])
        return merged @ w_out[l], hist_new, hre_new, him_new

    def run_group(x, hists, hres, hims, pos0):
        new_h, new_re, new_im = [], [], []
        for l in range(DEPTH):
            x = x + 0.5 * swiglu(rmsnorm(x, norm_ffn1[l]), ffn1_w_gate[l], ffn1_w_up[l], ffn1_w_down[l])
            m, hn, rn, im_ = mixer(rmsnorm(x, norm_mix[l]), l, hists[l], hres[l], hims[l], pos0)
            x = x + m
            x = x + 0.5 * swiglu(rmsnorm(x, norm_ffn2[l]), ffn2_w_gate[l], ffn2_w_up[l], ffn2_w_down[l])
            new_h.append(hn)
            new_re.append(rn)
            new_im.append(im_)
        y = rmsnorm(x, final_norm)
        return y, jnp.stack(new_h, 0), jnp.stack(new_re, 0), jnp.stack(new_im, 0)

    nbp = x_prompt.shape[0]
    meta = jnp.broadcast_to(meta_tokens.astype(x_prompt.dtype)[None], (nbp, N_META, D_MODEL))
    xp = jnp.concatenate([meta, x_prompt], axis=1)
    zero_hist = jnp.zeros((DEPTH, nbp, POOL_HIST, W_POOL), x_prompt.dtype)
    zero_h = jnp.zeros((DEPTH, nbp, N_SSM_GROUPS, SSM_STATE), jnp.float32)
    yp_full, pool_p, ssm_re_p, ssm_im_p = run_group(xp, zero_hist, zero_h, zero_h, 0)
    y_prompt = yp_full[:, N_META:]

    y_sample, pool_s, ssm_re_s, ssm_im_s = run_group(x_sample, state_pool, state_ssm_re,
                                                     state_ssm_im, PAST_LEN)
    return (y_prompt, y_sample, pool_p, pool_s, ssm_re_p, ssm_im_p, ssm_re_s, ssm_im_s)
```

```cpp
#include <hip/hip_runtime.h>
#include <hip/hip_cooperative_groups.h>
#include <cstdio>
#include <cstdint>
namespace cg = cooperative_groups;

#ifndef MK_N_LAUNCHES
#define MK_N_LAUNCHES 1
#endif

#define LAS __attribute__((address_space(3)))
typedef unsigned short bf16_t;
typedef short bf16x8 __attribute__((ext_vector_type(8)));
typedef float f32x4 __attribute__((ext_vector_type(4)));
typedef float f32x2 __attribute__((ext_vector_type(2)));
typedef unsigned u32x4 __attribute__((ext_vector_type(4)));
typedef unsigned u32x2 __attribute__((ext_vector_type(2)));

constexpr int D = 2048, FF = 5632, NBP = 4, SEQ = 2048, NMETA = 16, LP = SEQ + NMETA  , NBS = 128, LS = 4;
constexpr int MPR = NBP * LP  , MSA = NBS * LS  , MV = MPR + MSA  , MP = 8960  ;
constexpr int WPOOL = 1024, WSSM = 1024, NG = 64, NP = 64, GS = 16, WIN = 6144, NCH = LP / 16  ;
constexpr float RMS_EPS = 1e-6f;
constexpr float LOG2E = 1.4426950408889634f;

constexpr size_t O_YP = 0, O_YS = 16777216, O_PP = 17825792, O_PS = 17887232, O_RP = 19853312, O_IP = 19869696, O_RS = 19886080, O_IS = 20410368;

constexpr size_t MiB = 1u << 20;
constexpr size_t WS_WGU = 0;
constexpr size_t WS_WD = 44 * MiB;
constexpr size_t WS_WIN = 66 * MiB;
constexpr size_t WS_PW = 90 * MiB;
constexpr size_t WS_GLU = 91 * MiB;
constexpr size_t WS_WA = 93 * MiB;
constexpr size_t WS_WB = 97 * MiB;
constexpr size_t WS_WOUT = 101 * MiB;
constexpr size_t WS_XN = 110 * MiB;
constexpr size_t WS_X = 145 * MiB;
constexpr size_t WS_R = 215 * MiB;
constexpr size_t WS_H = WS_R;
constexpr size_t WS_UP = WS_R;
constexpr size_t WS_US = WS_R + 35 * MiB;
constexpr size_t WS_T1 = WS_R;
constexpr size_t WS_PB = WS_R + 100 * MiB;
constexpr size_t WS_G = WS_R + 70 * MiB;
constexpr size_t WS_DD = WS_R + 140 * MiB;
constexpr size_t WS_SG = WS_DD + 18 * MiB;
constexpr size_t WS_MRG = WS_SG + 18 * MiB;
constexpr size_t WS_CTL = WS_MRG + 35 * MiB;
constexpr size_t CTL_BYTES = 65536;
constexpr size_t WS_END = WS_CTL + CTL_BYTES;
static_assert((size_t)MP * 2048 * 2 <= 35 * MiB && (size_t)MP * 1024 * 2 <= 18 * MiB && (size_t)MP * FF * 2 <= 140 * MiB, "ws map");

constexpr int LDS_BYTES = 147456;

__device__ __forceinline__ unsigned f2bf(float f) { unsigned u = __builtin_bit_cast(unsigned, f); return (u + 0x7fffu + ((u >> 16) & 1u)) >> 16; }
__device__ __forceinline__ float bf2f(unsigned b) { return __builtin_bit_cast(float, b << 16); }
typedef __bf16 bf16x2v __attribute__((ext_vector_type(2)));
__device__ __forceinline__ unsigned cvt_pk_bf16(float lo, float hi) { const f32x2 v = {lo, hi}; const bf16x2v b = __builtin_convertvector(v, bf16x2v); return __builtin_bit_cast(unsigned, b); }
__device__ __forceinline__ u32x4 pack8(f32x4 a, f32x4 b) { u32x4 w; w.x = cvt_pk_bf16(a[0], a[1]); w.y = cvt_pk_bf16(a[2], a[3]); w.z = cvt_pk_bf16(b[0], b[1]); w.w = cvt_pk_bf16(b[2], b[3]); return w; }
__device__ __forceinline__ void unpack8(u32x4 w, f32x4& a, f32x4& b) {
    a[0] = __builtin_bit_cast(float, w.x << 16); a[1] = __builtin_bit_cast(float, w.x & 0xffff0000u); a[2] = __builtin_bit_cast(float, w.y << 16); a[3] = __builtin_bit_cast(float, w.y & 0xffff0000u);
    b[0] = __builtin_bit_cast(float, w.z << 16); b[1] = __builtin_bit_cast(float, w.z & 0xffff0000u); b[2] = __builtin_bit_cast(float, w.w << 16); b[3] = __builtin_bit_cast(float, w.w & 0xffff0000u); }
__device__ __forceinline__ float sigm(float x) { return __builtin_amdgcn_rcpf(1.0f + __builtin_amdgcn_exp2f(-LOG2E * x)); }
__device__ __forceinline__ f32x4 sigm4(f32x4 x) { f32x4 r; r[0] = sigm(x[0]); r[1] = sigm(x[1]); r[2] = sigm(x[2]); r[3] = sigm(x[3]); return r; }
__device__ __forceinline__ float gelu_tanh(float x) { const float z = 1.5957691216057308f * (x + 0.044715f * x * x * x); return x * sigm(z); }
__device__ __forceinline__ float wave_sum(float v) {
#pragma unroll
    for (int o = 1; o < 64; o <<= 1) v += __shfl_xor(v, o);
    return v;
}

struct X0Src { const float* meta; const float* xp; const float* xs; };
__device__ __forceinline__ const float* x0_row(const X0Src& s, int r) {
    if (r < MPR) { const int b = r / LP, t = r - b * LP; return t < NMETA ? s.meta + (size_t)t * D : s.xp + ((size_t)b * SEQ + (t - NMETA)) * D; }
    if (r < MV) return s.xs + (size_t)(r - MPR) * D;
    return nullptr;
}

namespace pg8 {
constexpr int BM = 256, BK = 64, HALF = 128, HTB = HALF * BK * 2, NXCD = 8, WGM = 8;
__host__ __device__ __forceinline__ int lds_byte(int r, int c) { const int st = (r >> 4) * 2 + (c >> 5), rr = r & 15, cc = c & 31, ob = rr * 64 + cc * 2; return st * 1024 + (ob ^ (((ob >> 9) & 1) << 5)); }
__host__ __device__ __forceinline__ void stage_rc(int b, int& R, int& C) { const int st = b / 1024, sb = b % 1024, swz = sb ^ (((sb >> 9) & 1) << 5); R = (st >> 1) * 16 + swz / 64; C = (st & 1) * 32 + (swz % 64) / 2; }
__host__ __device__ __forceinline__ int perm32(int rho) { const int n = rho >> 4, i = rho & 15; return 8 * (i >> 2) + 4 * n + (i & 3); }

struct Unit { int pm, pn, kt0, nkt, full; };
struct Gemm { const bf16_t* A; const bf16_t* Bt; int lda, ldb, M, N, K, a_pn_bytes, img; };
__host__ __device__ __forceinline__ int perm32_inv(int w) { return ((w >> 2) & 1) * 16 + ((w >> 3) << 2) + (w & 3); }

struct StaticOrder {
    int nM, nN, nwg, G, c, nkt;
    __device__ void init(int M, int N, int G_, int c_, int K = 0) { nM = M / BM; nN = N / BM; nwg = nM * nN; G = G_; c = c_; nkt = K / BK; }
    __device__ bool next(int i, Unit& u) const {
        const long L = (long)i * G + c; if (L >= nwg) return false;
        int wgid = (int)L; { const int q = nwg / NXCD, r = nwg % NXCD, xcd = wgid % NXCD, off = wgid / NXCD; wgid = (xcd < r ? xcd * (q + 1) : r * (q + 1) + (xcd - r) * q) + off; }
        const int nig = WGM * nN, gid = wgid / nig, fm = gid * WGM, gsz = (nM - fm) < WGM ? (nM - fm) : WGM;
        u.pm = fm + ((wgid % nig) % gsz); u.pn = (wgid % nig) / gsz; u.kt0 = 0; u.nkt = nkt; u.full = 1; return true;
    }
};
struct PadOrder {
    StaticOrder so; int c, nN, nkt;
    __device__ void init(int N, int K, int G, int c_) { so.init((MP / BM - 1) * BM, N, G, c_, K); c = c_; nN = N / BM; nkt = K / BK; }
    __device__ bool next(int i, Unit& u) const {
        if (so.next(i, u)) return true;
        const int n0 = so.nwg / so.G, rem = so.nwg - n0 * so.G;
        if (i < n0 || c < rem) return false;
        const int f = (i - n0) * (so.G - rem) + (c - rem); if (f >= nN) return false;
        u.pm = MP / BM - 1; u.pn = f; u.kt0 = 0; u.nkt = nkt; u.full = 1; return true;
    }
};
constexpr int TS_ROWS0 = 8192, TS_NSPLIT = 4;
struct TailSplitOrder {
    StaticOrder so; int c, nkt;
    __device__ void init(int N, int K, int G, int c_) { so.init(TS_ROWS0, N, G, c_, K); c = c_; nkt = K / BK; }
    __device__ bool next(int i, Unit& u) const {
        if (i == 0) return so.next(0, u);
        if (i > 1 || c >= 24 * TS_NSPLIT) return false;
        const int t = c / TS_NSPLIT, kq = c % TS_NSPLIT;
        u.pm = TS_ROWS0 / BM + (t >> 3); u.pn = t & 7; u.nkt = nkt / TS_NSPLIT; u.kt0 = kq * u.nkt; u.full = 0; return true;
    }
};

template <class Epi, class Order>
__device__ __forceinline__ void gemm_phase(LAS unsigned char* lds, const Gemm g, const Order& S, const Epi& E) {
    int tid_ = threadIdx.x; asm volatile("" : "+v"(tid_));
    const int tid = tid_, wid = __builtin_amdgcn_readfirstlane(tid >> 6), lane = tid & 63, wr = wid >> 2, wc = wid & 3, fr = lane & 15, fq = lane >> 4;
    unsigned voffA[2], voffB[2];
#pragma unroll
    for (int i = 0; i < 2; ++i) { int R, C; stage_rc(tid * 16 + i * 8192, R, C); const int Rb = (R & ~31) + perm32(R & 31);
        voffA[i] = (g.img & 1) ? (unsigned)(tid * 16 + i * 8192) : (unsigned)(R * g.lda + C) * 2u;
        voffB[i] = (g.img & 2) ? (unsigned)(tid * 16 + i * 8192) : (unsigned)(Rb * g.ldb + C) * 2u; }
    const size_t kstepA = (g.img & 1) ? (size_t)(2 * HTB) : (size_t)(BK * 2), kstepB = (g.img & 2) ? (size_t)(2 * HTB) : (size_t)(BK * 2);
    const size_t hstepA = (g.img & 1) ? (size_t)HTB : (size_t)HALF * g.lda * 2, hstepB = (g.img & 2) ? (size_t)HTB : (size_t)HALF * g.ldb * 2;
    const size_t tstepA = (g.img & 1) ? (size_t)(g.K / BK) * (2 * HTB) : 2 * hstepA, tstepB = (g.img & 2) ? (size_t)(g.K / BK) * (2 * HTB) : 2 * hstepB;
    const unsigned ldsw = (unsigned)wid * 1024u;
    const int aoff = lds_byte(wr * 64 + fr, fq * 8), boff = lds_byte(wc * 32 + fr, fq * 8);
#define PG8_SA(b, h) (((b) * 2 + (h)) * HTB)
#define PG8_SB(b, h) ((4 + (b) * 2 + (h)) * HTB)
#define PG8_STAGE(bufoff, gbase, voff) do { _Pragma("unroll") for (int _i = 0; _i < 2; ++_i) \
        __builtin_amdgcn_global_load_lds((const unsigned*)((const char*)(gbase) + (voff)[_i]), (LAS unsigned*)(lds + (bufoff) + ldsw + _i * 8192), 16, 0, 0); } while (0)
#define PG8_LDA(dst, b, h) do { _Pragma("unroll") for (int m = 0; m < 4; ++m) _Pragma("unroll") for (int k = 0; k < 2; ++k) dst[m][k] = *(const LAS bf16x8*)(lds + PG8_SA(b, h) + aoff + m * 2048 + k * 1024); } while (0)
#define PG8_LDB(dst, b, h) do { _Pragma("unroll") for (int n = 0; n < 2; ++n) _Pragma("unroll") for (int k = 0; k < 2; ++k) dst[n][k] = *(const LAS bf16x8*)(lds + PG8_SB(b, h) + boff + n * 2048 + k * 1024); } while (0)
#define PG8_MMA(ai, bj, At, Bt) do { __builtin_amdgcn_s_setprio(1); _Pragma("unroll") for (int m = 0; m < 4; ++m) _Pragma("unroll") for (int n = 0; n < 2; ++n) _Pragma("unroll") for (int k = 0; k < 2; ++k) \
        acc[ai][bj][m][n] = __builtin_amdgcn_mfma_f32_16x16x32_bf16(Bt[n][k], At[m][k], acc[ai][bj][m][n], 0, 0, 0); __builtin_amdgcn_s_setprio(0); } while (0)
#define PG8_WAIT_V(n) asm volatile("s_waitcnt vmcnt(" #n ")" ::: "memory")
#define PG8_WAIT_L(n) asm volatile("s_waitcnt lgkmcnt(" #n ")" ::: "memory")
#define PG8_BAR __builtin_amdgcn_s_barrier()
#define PG8_SCHED __builtin_amdgcn_sched_barrier(0)
    Unit cur, nxt; int ui = 0;
    if (!S.next(0, cur)) return;
    f32x4 acc[2][2][4][2];
#pragma unroll
    for (int a = 0; a < 2; ++a)
#pragma unroll
        for (int b = 0; b < 2; ++b)
#pragma unroll
            for (int m = 0; m < 4; ++m)
#pragma unroll
                for (int n = 0; n < 2; ++n) acc[a][b][m][n] = (f32x4){0.f, 0.f, 0.f, 0.f};
    bf16x8 At[4][2], B0[2][2], B1[2][2];
    const char* cA = (const char*)g.A + (size_t)cur.pm * tstepA + (size_t)cur.pn * g.a_pn_bytes + (size_t)cur.kt0 * kstepA; const char* cB = (const char*)g.Bt + (size_t)cur.pn * tstepB + (size_t)cur.kt0 * kstepB;
    PG8_STAGE(PG8_SB(0, 0), cB, voffB); PG8_STAGE(PG8_SB(0, 1), cB + hstepB, voffB); PG8_STAGE(PG8_SA(0, 0), cA, voffA); PG8_STAGE(PG8_SA(0, 1), cA + hstepA, voffA);
    if (wr == 1) PG8_BAR;
    PG8_WAIT_V(2); PG8_BAR;
    PG8_STAGE(PG8_SB(1, 0), cB + kstepB, voffB); PG8_STAGE(PG8_SA(1, 0), cA + kstepA, voffA); PG8_STAGE(PG8_SB(1, 1), cB + hstepB + kstepB, voffB);
    PG8_WAIT_V(6); PG8_BAR;
    for (;;) {
        const bool has_next = S.next(ui + 1, nxt);
        const char* nA = has_next ? (const char*)g.A + (size_t)nxt.pm * tstepA + (size_t)nxt.pn * g.a_pn_bytes + (size_t)nxt.kt0 * kstepA : cA; const char* nB = has_next ? (const char*)g.Bt + (size_t)nxt.pn * tstepB + (size_t)nxt.kt0 * kstepB : cB;
        const int nt = cur.nkt;
        const int row_w = __builtin_amdgcn_readfirstlane(cur.pm) * BM + wr * 64;
        const bool do0 = row_w < MV, do1 = row_w + HALF < MV;
        if (do0 && do1) {
        for (int t = 0; t < nt; t += 2) {
            const bool last = (t == nt - 2);
            const char* a1 = cA + (size_t)(t + 1) * kstepA;
            const char* a2 = last ? nA : cA + (size_t)(t + 2) * kstepA; const char* b2 = last ? nB : cB + (size_t)(t + 2) * kstepB;
            const char* a3 = a2 + kstepA; const char* b3 = b2 + kstepB;
            PG8_LDB(B0, 0, 0); PG8_LDB(B1, 0, 1); PG8_SCHED; PG8_LDA(At, 0, 0); PG8_STAGE(PG8_SA(1, 1), a1 + hstepA, voffA);
            PG8_WAIT_V(8); PG8_WAIT_L(0); PG8_BAR; { PG8_MMA(0, 0, At, B0); PG8_MMA(0, 1, At, B1); } PG8_BAR; PG8_SCHED;
            PG8_LDA(At, 0, 1); PG8_STAGE(PG8_SB(0, 0), b2, voffB); PG8_STAGE(PG8_SB(0, 1), b2 + hstepB, voffB); PG8_STAGE(PG8_SA(0, 0), a2, voffA);
            PG8_WAIT_V(8); PG8_WAIT_L(0); PG8_BAR; { PG8_MMA(1, 0, At, B0); PG8_MMA(1, 1, At, B1); } PG8_BAR; PG8_SCHED;
            PG8_LDB(B0, 1, 0); PG8_LDB(B1, 1, 1); PG8_SCHED; PG8_LDA(At, 1, 0); PG8_STAGE(PG8_SA(0, 1), a2 + hstepA, voffA);
            PG8_WAIT_V(8); PG8_WAIT_L(0); PG8_BAR; { PG8_MMA(0, 0, At, B0); PG8_MMA(0, 1, At, B1); } PG8_BAR; PG8_SCHED;
            PG8_LDA(At, 1, 1); PG8_STAGE(PG8_SB(1, 0), b3, voffB); PG8_STAGE(PG8_SB(1, 1), b3 + hstepB, voffB); PG8_STAGE(PG8_SA(1, 0), a3, voffA);
            PG8_WAIT_V(8); PG8_WAIT_L(0); PG8_BAR; { PG8_MMA(1, 0, At, B0); PG8_MMA(1, 1, At, B1); } PG8_BAR; PG8_SCHED;
        }
        } else {
        for (int t = 0; t < nt; t += 2) {
            const bool last = (t == nt - 2);
            const char* a1 = cA + (size_t)(t + 1) * kstepA;
            const char* a2 = last ? nA : cA + (size_t)(t + 2) * kstepA; const char* b2 = last ? nB : cB + (size_t)(t + 2) * kstepB;
            const char* a3 = a2 + kstepA; const char* b3 = b2 + kstepB;
            PG8_LDB(B0, 0, 0); PG8_LDB(B1, 0, 1); PG8_SCHED; PG8_LDA(At, 0, 0); PG8_STAGE(PG8_SA(1, 1), a1 + hstepA, voffA);
            PG8_WAIT_V(8); PG8_WAIT_L(0); PG8_BAR; if (do0) { PG8_MMA(0, 0, At, B0); PG8_MMA(0, 1, At, B1); } PG8_BAR; PG8_SCHED;
            PG8_LDA(At, 0, 1); PG8_STAGE(PG8_SB(0, 0), b2, voffB); PG8_STAGE(PG8_SB(0, 1), b2 + hstepB, voffB); PG8_STAGE(PG8_SA(0, 0), a2, voffA);
            PG8_WAIT_V(8); PG8_WAIT_L(0); PG8_BAR; if (do1) { PG8_MMA(1, 0, At, B0); PG8_MMA(1, 1, At, B1); } PG8_BAR; PG8_SCHED;
            PG8_LDB(B0, 1, 0); PG8_LDB(B1, 1, 1); PG8_SCHED; PG8_LDA(At, 1, 0); PG8_STAGE(PG8_SA(0, 1), a2 + hstepA, voffA);
            PG8_WAIT_V(8); PG8_WAIT_L(0); PG8_BAR; if (do0) { PG8_MMA(0, 0, At, B0); PG8_MMA(0, 1, At, B1); } PG8_BAR; PG8_SCHED;
            PG8_LDA(At, 1, 1); PG8_STAGE(PG8_SB(1, 0), b3, voffB); PG8_STAGE(PG8_SB(1, 1), b3 + hstepB, voffB); PG8_STAGE(PG8_SA(1, 0), a3, voffA);
            PG8_WAIT_V(8); PG8_WAIT_L(0); PG8_BAR; if (do1) { PG8_MMA(1, 0, At, B0); PG8_MMA(1, 1, At, B1); } PG8_BAR; PG8_SCHED;
        }
        }
        if (wr == 0) PG8_BAR;
        E(acc, cur, wr, wc, fr, fq);
        if (!has_next) break;
#pragma unroll
        for (int a = 0; a < 2; ++a)
#pragma unroll
            for (int b = 0; b < 2; ++b)
#pragma unroll
                for (int m = 0; m < 4; ++m)
#pragma unroll
                    for (int n = 0; n < 2; ++n) acc[a][b][m][n] = (f32x4){0.f, 0.f, 0.f, 0.f};
        cur = nxt; cA = nA; cB = nB; ++ui;
        if (wr == 1) PG8_BAR;
    }
    PG8_WAIT_V(0);
    PG8_BAR;
#undef PG8_SA
#undef PG8_SB
#undef PG8_STAGE
#undef PG8_LDA
#undef PG8_LDB
#undef PG8_MMA
#undef PG8_WAIT_V
#undef PG8_WAIT_L
#undef PG8_BAR
#undef PG8_SCHED
}

typedef const f32x4 (&AccRef)[2][2][4][2];
#define EPI_ROWS(...) _Pragma("unroll") for (int ai = 0; ai < 2; ++ai) _Pragma("unroll") for (int m = 0; m < 4; ++m) { const int r = u.pm * BM + ai * HALF + wr * 64 + m * 16 + fr; __VA_ARGS__; asm volatile("" ::: "memory"); }

struct EpiSwiGLU {
    bf16_t* H;
    __device__ __forceinline__ void operator()(AccRef acc, const Unit& u, int wr, int wc, int fr, int fq) const {
        const int kt = u.pn * 2 + (wc >> 1);
        _Pragma("unroll") for (int ai = 0; ai < 2; ++ai) _Pragma("unroll") for (int m = 0; m < 4; ++m) {
            const size_t off = ((size_t)(u.pm * (FF / BK) + kt) * 2 + ai) * HTB + lds_byte(wr * 64 + m * 16 + fr, (wc & 1) * 32 + 8 * fq);
            const f32x4 g0 = acc[ai][0][m][0], g1 = acc[ai][0][m][1];
            const f32x4 v0 = g0 * sigm4(g0) * acc[ai][1][m][0], v1 = g1 * sigm4(g1) * acc[ai][1][m][1];
            *(u32x4*)((char*)H + off) = pack8(v0, v1);
            asm volatile("" ::: "memory"); }
    }
};
template <bool X0> struct EpiAdd {
    X0Src src; float* out; float* pb; float scale;
    __device__ __forceinline__ void operator()(AccRef acc, const Unit& u, int wr, int wc, int fr, int fq) const {
        const int col0 = u.pn * BM + wc * 32 + 8 * fq;
        if (u.kt0 == 0) {
            EPI_ROWS({
                float* op = out + (size_t)r * D + col0; const float* bp = X0 ? x0_row(src, r) : out + (size_t)r * D;
                _Pragma("unroll") for (int bj = 0; bj < 2; ++bj) {
                    f32x4 b0 = (f32x4){0.f, 0.f, 0.f, 0.f}, b1 = b0;
                    if (!X0 || bp) { b0 = *(const f32x4*)(bp + col0 + bj * HALF); b1 = *(const f32x4*)(bp + col0 + bj * HALF + 4); }
                    *(f32x4*)(op + bj * HALF) = b0 + scale * acc[ai][bj][m][0]; *(f32x4*)(op + bj * HALF + 4) = b1 + scale * acc[ai][bj][m][1]; }
            })
        } else {
            float* pbq = pb + (size_t)(u.kt0 / u.nkt - 1) * ((size_t)(MP - TS_ROWS0) * D) - (size_t)TS_ROWS0 * D;
            EPI_ROWS({
                float* op = pbq + (size_t)r * D + col0;
                _Pragma("unroll") for (int bj = 0; bj < 2; ++bj) { *(f32x4*)(op + bj * HALF) = scale * acc[ai][bj][m][0]; *(f32x4*)(op + bj * HALF + 4) = scale * acc[ai][bj][m][1]; }
            })
        }
    }
};
struct EpiWin {
    float* UP; float* US; bf16_t* G; const float* bg;
    __device__ __forceinline__ void operator()(AccRef acc, const Unit& u, int wr, int wc, int fr, int fq) const {
        if (u.pn < 8) {
            float* O = (u.pn < 4 ? UP : US); const int col0 = (u.pn & 3) * BM + wc * 32 + 8 * fq;
            EPI_ROWS({
                float* op = O + (size_t)r * 1024 + col0;
                _Pragma("unroll") for (int bj = 0; bj < 2; ++bj) { *(f32x4*)(op + bj * HALF) = acc[ai][bj][m][0]; *(f32x4*)(op + bj * HALF + 4) = acc[ai][bj][m][1]; }
            })
        } else {
            const int col0 = (u.pn - 8) * BM + wc * 32 + 8 * fq;
            f32x4 bv[2][2];
#pragma unroll
            for (int bj = 0; bj < 2; ++bj) { bv[bj][0] = *(const f32x4*)(bg + col0 + bj * HALF); bv[bj][1] = *(const f32x4*)(bg + col0 + bj * HALF + 4); }
            EPI_ROWS({
                bf16_t* op = G + (size_t)r * 4096 + col0;
                _Pragma("unroll") for (int bj = 0; bj < 2; ++bj) *(u32x4*)(op + bj * HALF) = pack8(sigm4(acc[ai][bj][m][0] + bv[bj][0]), sigm4(acc[ai][bj][m][1] + bv[bj][1]));
            })
        }
    }
};
struct EpiPool {
    bf16_t* AB; const float* sc;
    __device__ __forceinline__ void operator()(AccRef acc, const Unit& u, int wr, int wc, int fr, int fq) const {
        const int col0 = u.pn * BM + wc * 32 + 8 * fq;
        f32x4 sv[2][2];
#pragma unroll
        for (int bj = 0; bj < 2; ++bj) { sv[bj][0] = *(const f32x4*)(sc + col0 + bj * HALF); sv[bj][1] = *(const f32x4*)(sc + col0 + bj * HALF + 4); }
        EPI_ROWS({
            bf16_t* op = AB + (size_t)r * 2048 + col0;
            _Pragma("unroll") for (int bj = 0; bj < 2; ++bj) *(u32x4*)(op + bj * HALF) = pack8(acc[ai][bj][m][0] * sv[bj][0], acc[ai][bj][m][1] * sv[bj][1]);
        })
    }
};
struct EpiGLU {
    bf16_t* AB; const bf16_t* SG; const float* gb;
    __device__ __forceinline__ void operator()(AccRef acc, const Unit& u, int wr, int wc, int fr, int fq) const {
        const int col0 = u.pn * BM + wc * 32 + 8 * fq;
        f32x4 bv[2][2];
#pragma unroll
        for (int bj = 0; bj < 2; ++bj) { bv[bj][0] = *(const f32x4*)(gb + col0 + bj * HALF); bv[bj][1] = *(const f32x4*)(gb + col0 + bj * HALF + 4); }
        EPI_ROWS({
            bf16_t* op = AB + (size_t)r * 2048 + 1024 + col0; const bf16_t* sp = SG + (size_t)r * 1024 + col0;
            _Pragma("unroll") for (int bj = 0; bj < 2; ++bj) { f32x4 s0, s1; unpack8(*(const u32x4*)(sp + bj * HALF), s0, s1);
                *(u32x4*)(op + bj * HALF) = pack8(s0 * sigm4(acc[ai][bj][m][0] + bv[bj][0]), s1 * sigm4(acc[ai][bj][m][1] + bv[bj][1])); }
        })
    }
};
struct EpiBr1 {
    bf16_t* T1; const bf16_t* G;
    __device__ __forceinline__ void operator()(AccRef acc, const Unit& u, int wr, int wc, int fr, int fq) const {
        const int col0 = u.pn * BM + wc * 32 + 8 * fq;
        EPI_ROWS({
            bf16_t* op = T1 + (size_t)r * 2048 + col0; const bf16_t* gp = G + (size_t)r * 4096 + col0;
            _Pragma("unroll") for (int bj = 0; bj < 2; ++bj) { f32x4 g0, g1; unpack8(*(const u32x4*)(gp + bj * HALF), g0, g1);
                *(u32x4*)(op + bj * HALF) = pack8(g0 * acc[ai][bj][m][0], g1 * acc[ai][bj][m][1]); }
        })
    }
};
struct EpiBr2 {
    const bf16_t* T1; const bf16_t* G; bf16_t* MRG;
    __device__ __forceinline__ void operator()(AccRef acc, const Unit& u, int wr, int wc, int fr, int fq) const {
        const int col0 = u.pn * BM + wc * 32 + 8 * fq;
        EPI_ROWS({
            const bf16_t* tp = T1 + (size_t)r * 2048 + col0; const bf16_t* gp = G + (size_t)r * 4096 + 2048 + col0; bf16_t* op = MRG + (size_t)r * 2048 + col0;
            _Pragma("unroll") for (int bj = 0; bj < 2; ++bj) { f32x4 g0, g1; unpack8(*(const u32x4*)(gp + bj * HALF), g0, g1);
                f32x4 t0, t1; unpack8(*(const u32x4*)(tp + bj * HALF), t0, t1);
                *(u32x4*)(op + bj * HALF) = pack8(t0 + g0 * acc[ai][bj][m][0], t1 + g1 * acc[ai][bj][m][1]); }
        })
    }
};
}

__device__ __forceinline__ void cvt_item(const float* W, int K, int N, bf16_t* WT, int mode, int item, int lane) {
    const int nblk = N >> 6, kb = item / nblk, nb = item - kb * nblk, k0 = kb << 6, n0 = nb << 6;
    const int rg = lane >> 4, nq = lane & 15;
    const float* src = W + (size_t)(k0 + 16 * rg) * N + n0 + 4 * nq;
    f32x4 v[16];
#pragma unroll
    for (int i = 0; i < 16; ++i) v[i] = *(const f32x4*)(src + (size_t)i * N);
    if (mode == 3) {
#pragma unroll
        for (int j = 0; j < 4; ++j) { const int n = n0 + 4 * nq + j, slot = (n & 96) + pg8::perm32_inv(n & 31);
#pragma unroll
            for (int h = 0; h < 2; ++h) {
                u32x4 w; w.x = cvt_pk_bf16(v[8 * h + 0][j], v[8 * h + 1][j]); w.y = cvt_pk_bf16(v[8 * h + 2][j], v[8 * h + 3][j]);
                w.z = cvt_pk_bf16(v[8 * h + 4][j], v[8 * h + 5][j]); w.w = cvt_pk_bf16(v[8 * h + 6][j], v[8 * h + 7][j]);
                *(u32x4*)((char*)WT + ((size_t)((n >> 8) * (K >> 6) + kb) * 2 + ((n >> 7) & 1)) * pg8::HTB + pg8::lds_byte(slot, 16 * rg + 8 * h)) = w; } }
        return; }
    const int drow0 = (mode == 0 ? n0 : ((n0 >> 7) * 256 + (mode == 2 ? 128 : 0) + (n0 & 127))) + 4 * nq;
    bf16_t* dst = WT + (size_t)drow0 * K + k0 + 16 * rg;
#pragma unroll
    for (int j = 0; j < 4; ++j)
#pragma unroll
        for (int h = 0; h < 2; ++h) {
            u32x4 w; w.x = cvt_pk_bf16(v[8 * h + 0][j], v[8 * h + 1][j]); w.y = cvt_pk_bf16(v[8 * h + 2][j], v[8 * h + 3][j]);
            w.z = cvt_pk_bf16(v[8 * h + 4][j], v[8 * h + 5][j]); w.w = cvt_pk_bf16(v[8 * h + 6][j], v[8 * h + 7][j]);
            *(u32x4*)(dst + (size_t)j * K + 8 * h) = w; }
}
struct Args { const float* in[33]; float* out; unsigned char* ws; int ph_lo, ph_hi; };
typedef const __attribute__((address_space(4))) Args* ArgsP;
struct Frame {
    ArgsP a; unsigned char* ws; float* out;
    LAS unsigned char* lds; int tid, lane, wave, G, gw, NGW;
};
__device__ __forceinline__ void cvt_ffn(const Frame& F, int i0, int w0, int nw, int part = 0, int nparts = 1) {
    constexpr int IG = (D / 64) * (FF / 64);
    bf16_t* wgu = (bf16_t*)(F.ws + WS_WGU); bf16_t* wd = (bf16_t*)(F.ws + WS_WD);
    const int ib = (int)((long)part * (3 * IG) / nparts), ie = (int)((long)(part + 1) * (3 * IG) / nparts);
    for (int it = ib + w0; it < ie; it += nw) {
        if (it < IG) cvt_item(F.a->in[i0], D, FF, wgu, 1, it, F.lane);
        else if (it < 2 * IG) cvt_item(F.a->in[i0 + 1], D, FF, wgu, 2, it - IG, F.lane);
        else cvt_item(F.a->in[i0 + 2], FF, D, wd, 3, it - 2 * IG, F.lane);
    }
}
__device__ __forceinline__ void cvt_mixer(const Frame& F, int w0, int nw, int it0, int it1) {
    constexpr int I_IN = (D / 64) * (WIN / 64)  , I_PW = 4 * 16, I_GLU = 256, I_A = 16 * 32, I_O = 32 * 32;
    constexpr int TOT = I_IN + I_PW + I_GLU + 2 * I_A + I_O;
    static_assert(TOT == 5440, "mixer conversion items");
    for (int it = it0 + w0; it < it1; it += nw) {
        int r = it;
        if (r < I_IN) { cvt_item(F.a->in[11], D, WIN, (bf16_t*)(F.ws + WS_WIN), 0, r, F.lane); continue; } r -= I_IN;
        if (r < I_PW) { const int g = r >> 4; cvt_item(F.a->in[13] + (size_t)g * 65536, 256, 256, (bf16_t*)(F.ws + WS_PW) + (size_t)g * 65536, 0, r & 15, F.lane); continue; } r -= I_PW;
        if (r < I_GLU) { cvt_item(F.a->in[23], 1024, 1024, (bf16_t*)(F.ws + WS_GLU), 0, r, F.lane); continue; } r -= I_GLU;
        if (r < I_A) { cvt_item(F.a->in[25], 1024, 2048, (bf16_t*)(F.ws + WS_WA), 0, r, F.lane); continue; } r -= I_A;
        if (r < I_A) { cvt_item(F.a->in[26], 1024, 2048, (bf16_t*)(F.ws + WS_WB), 0, r, F.lane); continue; } r -= I_A;
        cvt_item(F.a->in[27], 2048, 2048, (bf16_t*)(F.ws + WS_WOUT), 0, r, F.lane);
    }
}

__device__ __forceinline__ void rms_row(const float* xrow, const float* gain, bf16_t* orow, float* frow, int lane, float* copy = nullptr, const float* pbrow = nullptr, size_t pbstride = 0) {
    f32x4 v[8]; float s = 0.f;
#pragma unroll
    for (int j = 0; j < 8; ++j) { v[j] = ((const f32x4*)xrow)[64 * j + lane]; if (pbrow) { v[j] += ((const f32x4*)pbrow)[64 * j + lane]; v[j] += ((const f32x4*)(pbrow + pbstride))[64 * j + lane]; v[j] += ((const f32x4*)(pbrow + 2 * pbstride))[64 * j + lane]; } s += (v[j][0] * v[j][0] + v[j][1] * v[j][1]) + (v[j][2] * v[j][2] + v[j][3] * v[j][3]); }
    if (copy) {
#pragma unroll
        for (int j = 0; j < 8; ++j) ((f32x4*)copy)[64 * j + lane] = v[j]; }
    const float rs = 1.0f / sqrtf(wave_sum(s) * (1.0f / D) + RMS_EPS);
#pragma unroll
    for (int j = 0; j < 8; ++j) { const f32x4 gg = ((const f32x4*)gain)[64 * j + lane]; const f32x4 o = v[j] * rs * gg;
        if (orow) { u32x2 w; w.x = cvt_pk_bf16(o[0], o[1]); w.y = cvt_pk_bf16(o[2], o[3]); ((u32x2*)orow)[64 * j + lane] = w; }
        else ((f32x4*)frow)[64 * j + lane] = o; }
}
__device__ __forceinline__ void zero_row_bf16(bf16_t* orow, int lane) {
#pragma unroll
    for (int j = 0; j < 8; ++j) ((u32x2*)orow)[64 * j + lane] = (u32x2){0u, 0u};
}

__device__ __forceinline__ void sincos_r(float x, float& s, float& c) {
    const float k = rintf(x * 0.6366197723675814f);
    float r = fmaf(-k, 1.5707963705062866f, x); r = fmaf(-k, -4.371139000186241e-8f, r);
    const float z = r * r;
    const float sp = r + r * z * (-1.6666654611e-1f + z * (8.3321608736e-3f + z * (-1.9515295891e-4f)));
    const float cp = 1.0f - 0.5f * z + z * z * (4.166664568298827e-2f + z * (-1.388731625493765e-3f + z * 2.443315711809948e-5f));
    const int q = ((int)k) & 3;
    s = (q == 0) ? sp : (q == 1) ? cp : (q == 2) ? -sp : -cp;
    c = (q == 0) ? cp : (q == 1) ? -sp : (q == 2) ? -cp : sp;
}
__device__ __forceinline__ bf16x8 pack8s(f32x4 a, f32x4 b) { const u32x4 w = pack8(a, b); return __builtin_bit_cast(bf16x8, w); }

#define WSYNC() asm volatile("s_waitcnt lgkmcnt(0)" ::: "memory")
struct S5K { float lbr, lbi; bf16x8 bb[8]; bf16x8 cm[4]; f32x4 dsk; };

__device__ __forceinline__ void s5_consts(const Frame& F, int g, LAS float* tab, S5K& k) {
    const int lane = F.lane, i16 = lane & 15, kq = lane >> 4;
    const float lre = F.a->in[15][g * NP + lane], lim = F.a->in[16][g * NP + lane], dt = expf(F.a->in[17][g]);
    const float a = lre * dt, b = lim * dt;
    const float em1 = a * (1.0f + a * (0.5f + a * (1.0f / 6.0f + a * (1.0f / 24.0f + a * (1.0f / 120.0f + a * (1.0f / 720.0f))))));
    const float ea = 1.0f + em1;
    float sh, ch; sincos_r(0.5f * b, sh, ch);
    const float sb = 2.0f * sh * ch, cbm1 = -2.0f * sh * sh, cb = 1.0f + cbm1;
    k.lbr = ea * cb; k.lbi = ea * sb;
    const float rm1 = em1 * cb + cbm1, im1 = ea * sb;
    const float inv = 1.0f / (lre * lre + lim * lim);
    tab[2 * lane] = (rm1 * lre + im1 * lim) * inv; tab[2 * lane + 1] = (im1 * lre - rm1 * lim) * inv;
    WSYNC();
#pragma unroll
    for (int n4 = 0; n4 < 4; ++n4) {
        const int p = 16 * n4 + i16; const float qr = tab[2 * p], qi = tab[2 * p + 1];
        const float* br = F.a->in[18] + ((size_t)g * NP + p) * GS + 8 * (kq & 1); const float* bi = F.a->in[19] + ((size_t)g * NP + p) * GS + 8 * (kq & 1);
        const f32x4 r0 = *(const f32x4*)br, r1 = *(const f32x4*)(br + 4), i0 = *(const f32x4*)bi, i1 = *(const f32x4*)(bi + 4);
        k.bb[n4] = pack8s(qr * r0 - qi * i0, qr * r1 - qi * i1);
        k.bb[4 + n4] = pack8s(qr * i0 + qi * r0, qr * i1 + qi * r1);
    }
#pragma unroll
    for (int s = 0; s < 4; ++s) {
        const float* cp = (s < 2 ? F.a->in[20] : F.a->in[21]) + ((size_t)g * GS + i16) * NP + 32 * (s & 1) + 8 * kq;
        f32x4 c0 = *(const f32x4*)cp, c1 = *(const f32x4*)(cp + 4);
        if (s >= 2) { c0 = -c0; c1 = -c1; }
        k.cm[s] = pack8s(c0, c1);
    }
    k.dsk = *(const f32x4*)(F.a->in[22] + g * GS + 4 * kq);
    WSYNC();
}
__device__ __forceinline__ void s5_ld(const float* US, int row0, int g, int lane, f32x4& u0, f32x4& u1) {
    const float* up = US + (size_t)(row0 + (lane & 15)) * WSSM + g * GS + 8 * ((lane >> 4) & 1);
    u0 = *(const f32x4*)up; u1 = *(const f32x4*)(up + 4);
}
__device__ __forceinline__ void s5_bu(const f32x4 u0, const f32x4 u1, int lane, const S5K& k, LAS float* HB) {
    const int t = lane & 15, kq = lane >> 4;
    u32x4 hi = pack8(u0, u1);
    f32x4 h0, h1; unpack8(hi, h0, h1);
    const u32x4 lo = pack8(u0 - h0, u1 - h1);
    const bf16x8 uop = __builtin_bit_cast(bf16x8, (kq >= 2) ? lo : hi);
#pragma unroll
    for (int n = 0; n < 8; ++n) {
        const f32x4 d = __builtin_amdgcn_mfma_f32_16x16x32_bf16(k.bb[n], uop, (f32x4){0.f, 0.f, 0.f, 0.f}, 0, 0, 0);
        *(LAS f32x4*)(HB + t * 132 + 16 * n + 4 * kq) = d;
    }
    WSYNC();
}
__device__ __forceinline__ void s5_out(const f32x4 uu, bf16_t* SG, int row0, int g, int lane, const S5K& k, const LAS float* HB) {
    const int t = lane & 15, kq = lane >> 4;
    f32x4 acc = (f32x4){0.f, 0.f, 0.f, 0.f};
#pragma unroll
    for (int s = 0; s < 4; ++s) {
        const LAS float* hp = HB + t * 132 + 32 * s + 8 * kq;
        const f32x4 h0 = *(const LAS f32x4*)hp, h1 = *(const LAS f32x4*)(hp + 4);
        acc = __builtin_amdgcn_mfma_f32_16x16x32_bf16(k.cm[s], pack8s(h0, h1), acc, 0, 0, 0);
    }
    const f32x4 y = acc + k.dsk * uu;
    u32x2 w; w.x = cvt_pk_bf16(gelu_tanh(y[0]), gelu_tanh(y[1])); w.y = cvt_pk_bf16(gelu_tanh(y[2]), gelu_tanh(y[3]));
    *(u32x2*)(SG + (size_t)(row0 + t) * WSSM + g * GS + 4 * kq) = w;
    WSYNC();
}

__device__ __forceinline__ void s5_phase(const Frame& F) {
    const float* US = (const float*)(F.ws + WS_US); bf16_t* SG = (bf16_t*)(F.ws + WS_SG);
    LAS f32x2* EB = (LAS f32x2*)F.lds;
    LAS float* HB = (LAS float*)(F.lds + 66048 + F.wave * 8448);
    const int lane = F.lane;
    S5K k;
    for (int item = blockIdx.x; item < NBP * NG; item += F.G) {
        const int b = item >> 6, g = item & 63, rb = b * LP;
        s5_consts(F, g, HB, k);
        f32x4 nu0, nu1; s5_ld(US, rb + 16 * F.wave, g, lane, nu0, nu1);
        for (int c = F.wave; c < NCH; c += 8) {
            const f32x4 u0 = nu0, u1 = nu1; if (c + 8 < NCH) s5_ld(US, rb + 16 * (c + 8), g, lane, nu0, nu1);
            s5_bu(u0, u1, lane, k, HB);
            float br[16], bi[16];
#pragma unroll
            for (int t = 0; t < 16; ++t) { br[t] = HB[t * 132 + lane]; bi[t] = HB[t * 132 + 64 + lane]; }
            float hr = 0.f, hi = 0.f;
#pragma unroll
            for (int t = 0; t < 16; ++t) { const float nr = k.lbr * hr - k.lbi * hi + br[t], ni = k.lbr * hi + k.lbi * hr + bi[t]; hr = nr; hi = ni; }
            EB[c * 64 + lane] = (f32x2){hr, hi};
            WSYNC();
        }
        __syncthreads();
        if (F.wave == 0) {
            float pr = k.lbr, pi = k.lbi;
#pragma unroll
            for (int q = 0; q < 4; ++q) { const float nr = pr * pr - pi * pi, ni = 2.0f * pr * pi; pr = nr; pi = ni; }
            float hr = 0.f, hi = 0.f;
            for (int c0 = 0; c0 < NCH; c0 += 8) {
                f32x2 e[8];
#pragma unroll
                for (int j = 0; j < 8; ++j) e[j] = (c0 + j < NCH) ? EB[(c0 + j) * 64 + lane] : (f32x2){0.f, 0.f};
#pragma unroll
                for (int j = 0; j < 8; ++j) { const float nr = pr * hr - pi * hi + e[j][0], ni = pr * hi + pi * hr + e[j][1]; hr = nr; hi = ni; e[j] = (f32x2){hr, hi}; }
#pragma unroll
                for (int j = 0; j < 8; ++j) if (c0 + j < NCH) EB[(c0 + j) * 64 + lane] = e[j];
            }
            const f32x2 fin = EB[(NCH - 1) * 64 + lane];
            F.out[O_RP + (size_t)(b * NG + g) * NP + lane] = fin[0]; F.out[O_IP + (size_t)(b * NG + g) * NP + lane] = fin[1];
        }
        __syncthreads();
        s5_ld(US, rb + 16 * F.wave, g, lane, nu0, nu1);
        for (int c = F.wave; c < NCH; c += 8) {
            const f32x4 u0 = nu0, u1 = nu1; if (c + 8 < NCH) s5_ld(US, rb + 16 * (c + 8), g, lane, nu0, nu1);
            const f32x4 uu = *(const f32x4*)(US + (size_t)(rb + 16 * c + (lane & 15)) * WSSM + g * GS + 4 * (lane >> 4));
            s5_bu(u0, u1, lane, k, HB);
            float br[16], bi[16];
#pragma unroll
            for (int t = 0; t < 16; ++t) { br[t] = HB[t * 132 + lane]; bi[t] = HB[t * 132 + 64 + lane]; }
            f32x2 h0 = (f32x2){0.f, 0.f}; if (c > 0) h0 = EB[(c - 1) * 64 + lane];
            float hr = h0[0], hi = h0[1];
#pragma unroll
            for (int t = 0; t < 16; ++t) { const float nr = k.lbr * hr - k.lbi * hi + br[t], ni = k.lbr * hi + k.lbi * hr + bi[t]; hr = nr; hi = ni; br[t] = hr; bi[t] = hi; }
#pragma unroll
            for (int t = 0; t < 16; ++t) { HB[t * 132 + lane] = br[t]; HB[t * 132 + 64 + lane] = bi[t]; }
            WSYNC();
            s5_out(uu, SG, rb + 16 * c, g, lane, k, HB);
        }
        __syncthreads();
    }
    for (int it = F.gw; it < NG * (MSA / 16); it += F.NGW) {
        const int g = it >> 5, j = it & 31, row0 = MPR + 16 * j;
        f32x4 u0, u1; s5_ld(US, row0, g, lane, u0, u1);
        const f32x4 uu = *(const f32x4*)(US + (size_t)(row0 + (lane & 15)) * WSSM + g * GS + 4 * (lane >> 4));
        s5_consts(F, g, HB, k);
        s5_bu(u0, u1, lane, k, HB);
        float br[16], bi[16];
#pragma unroll
        for (int t = 0; t < 16; ++t) { br[t] = HB[t * 132 + lane]; bi[t] = HB[t * 132 + 64 + lane]; }
#pragma unroll
        for (int sq = 0; sq < 4; ++sq) {
            const size_t so = ((size_t)(4 * j + sq) * NG + g) * NP + lane;
            float hr = F.a->in[3][so], hi = F.a->in[4][so];
#pragma unroll
            for (int t = 4 * sq; t < 4 * sq + 4; ++t) { const float nr = k.lbr * hr - k.lbi * hi + br[t], ni = k.lbr * hi + k.lbi * hr + bi[t]; hr = nr; hi = ni; br[t] = hr; bi[t] = hi; }
            F.out[O_RS + so] = hr; F.out[O_IS + so] = hi;
        }
#pragma unroll
        for (int t = 0; t < 16; ++t) { HB[t * 132 + lane] = br[t]; HB[t * 132 + 64 + lane] = bi[t]; }
        WSYNC();
        s5_out(uu, SG, row0, g, lane, k, HB);
    }
}

__device__ __forceinline__ void store_d(bf16_t* p, f32x4 d) { u32x2 w; w.x = cvt_pk_bf16(d[0], d[1]); w.y = cvt_pk_bf16(d[2], d[3]); *(u32x2*)p = w; }
template <int W, int T> __device__ __forceinline__ void pool_rows(const f32x4* cur, const f32x4* old, int skip, int avail0, bf16_t* dd) {
    f32x4 u[T], o[W - 1];
#pragma unroll
    for (int k = 0; k < W - 1; ++k) o[k] = (k >= skip) ? old[(size_t)k * 256] : (f32x4){0.f, 0.f, 0.f, 0.f};
#pragma unroll
    for (int t = 0; t < T; ++t) u[t] = cur[(size_t)t * 256];
    f32x4 s = (f32x4){0.f, 0.f, 0.f, 0.f};
#pragma unroll
    for (int k = 0; k < W - 1; ++k) s += o[k];
#pragma unroll
    for (int t = 0; t < T; ++t) {
        s += u[t];
        const int av = avail0 + t + 1; const float inv = 1.0f / (float)(av < W ? av : W);
        store_d(dd + (size_t)t * WPOOL, s * inv - u[t]);
        if (t - (W - 1) >= 0) s -= u[t - (W - 1) >= 0 ? t - (W - 1) : 0]; else s -= o[t < W - 1 ? t : 0];
    }
}
__device__ __forceinline__ void pool_phase(const Frame& F) {
    const f32x4* UP4 = (const f32x4*)(F.ws + WS_UP); bf16_t* DD = (bf16_t*)(F.ws + WS_DD);
    const int half = F.tid >> 8, q = F.tid & 255, grp = __builtin_amdgcn_readfirstlane(q >> 6);
    constexpr int NPI = NBP * NCH  , NSI = NBS;
    for (int it = blockIdx.x * 2 + half; it < NPI + NSI; it += F.G * 2) {
        if (it < NPI) {
            const int b = it / NCH, ch = it - b * NCH, t0 = 16 * ch, rb = b * LP;
            const f32x4* cur = UP4 + (size_t)(rb + t0) * 256 + q; bf16_t* dd = DD + (size_t)(rb + t0) * WPOOL + 4 * q;
            if (grp == 0)      pool_rows<2, 16>(cur, cur - (size_t)1 * 256, 1 - t0 > 0 ? 1 - t0 : 0, t0, dd);
            else if (grp == 1) pool_rows<4, 16>(cur, cur - (size_t)3 * 256, 3 - t0 > 0 ? 3 - t0 : 0, t0, dd);
            else if (grp == 2) pool_rows<8, 16>(cur, cur - (size_t)7 * 256, 7 - t0 > 0 ? 7 - t0 : 0, t0, dd);
            else               pool_rows<16, 16>(cur, cur - (size_t)15 * 256, 15 - t0 > 0 ? 15 - t0 : 0, t0, dd);
        } else {
            const int bs = it - NPI, rs = MPR + 4 * bs; const f32x4* hist = (const f32x4*)F.a->in[2] + (size_t)bs * 15 * 256 + q;
            const f32x4* cur = UP4 + (size_t)rs * 256 + q; bf16_t* dd = DD + (size_t)rs * WPOOL + 4 * q;
            if (grp == 0)      pool_rows<2, 4>(cur, hist + (size_t)14 * 256, 0, 1 << 20, dd);
            else if (grp == 1) pool_rows<4, 4>(cur, hist + (size_t)12 * 256, 0, 1 << 20, dd);
            else if (grp == 2) pool_rows<8, 4>(cur, hist + (size_t)8 * 256, 0, 1 << 20, dd);
            else               pool_rows<16, 4>(cur, hist, 0, 1 << 20, dd);
        }
    }
    const int gt = blockIdx.x * 512 + F.tid, NT = F.G * 512;
    f32x4* pp = (f32x4*)(F.out + O_PP); f32x4* ps = (f32x4*)(F.out + O_PS);
    for (int i = gt; i < NBP * 15 * 256; i += NT) { const int c = i & 255, j = (i >> 8) % 15, b = i / (15 * 256); pp[i] = UP4[(size_t)(b * LP + LP - 15 + j) * 256 + c]; }
    for (int i = gt; i < NBS * 15 * 256; i += NT) { const int c = i & 255, j = (i >> 8) % 15, b = i / (15 * 256);
        ps[i] = (j < 11) ? ((const f32x4*)F.a->in[2])[((size_t)b * 15 + j + 4) * 256 + c] : UP4[(size_t)(MPR + 4 * b + j - 11) * 256 + c]; }
}


#define XB_TMO      128
#define XB_XCNT(j)  (256  + 64 * (j))
#define XB_XSUB(j)  (1280 + 64 * (j))
#define XB_XGEN(j)  (2304 + 64 * (j))
#define XB_TOP      3328
#define XB_TOPGEN   3392
#define XCD_BAR_WORDS 3456
#define XB_SPIN_CAP (1u << 20)
__device__ __forceinline__ unsigned xb_ld(unsigned* p)              { return __hip_atomic_load(p, __ATOMIC_RELAXED, __HIP_MEMORY_SCOPE_AGENT); }
__device__ __forceinline__ unsigned xb_add(unsigned* p, unsigned v) { return __hip_atomic_fetch_add(p, v, __ATOMIC_RELAXED, __HIP_MEMORY_SCOPE_AGENT); }
__device__ __forceinline__ unsigned xb_xcc_id() { return (unsigned)__builtin_amdgcn_s_getreg((3 << 11) | 20) & 0xFu; }
#define XB_SPIN(cond, bar) do { unsigned _sp = 0; while (cond) { __builtin_amdgcn_s_sleep(1); \
    if ((++_sp & 255u) == 0u) { if (xb_ld(&(bar)[XB_TMO])) break; if (_sp > XB_SPIN_CAP) { atomicAdd(&(bar)[XB_TMO], 1u); break; } } } } while (0)
__device__ __forceinline__ void xcd_barrier_complete(unsigned* bar, unsigned x, unsigned& nloc, unsigned& nx) {
    const unsigned G = gridDim.x;
    unsigned sum, cnt, mine, sp = 0u;
    for (;;) {
        sum = 0u; cnt = 0u; mine = 0u;
#pragma unroll
        for (unsigned j = 0; j < 16; ++j) { const unsigned c = xb_ld(&bar[XB_XCNT(j)]); sum += c; cnt += (c > 0u) ? 1u : 0u; mine = (j == x) ? c : mine; }
        if (sum == G) break;
        __builtin_amdgcn_s_sleep(1);
        if ((++sp & 255u) == 0u) { if (xb_ld(&bar[XB_TMO])) break; if (sp > XB_SPIN_CAP) { atomicAdd(&bar[XB_TMO], 1u); break; } }
    }
    nloc = mine > 0u ? mine : 1u; nx = cnt > 0u ? cnt : 1u;
}
__device__ __forceinline__ void xcd_barrier(unsigned* bar, volatile LAS unsigned* st) {
    asm volatile("s_waitcnt vmcnt(0)" ::: "memory");
    __syncthreads();
    if (threadIdx.x == 0) {
        __builtin_amdgcn_s_waitcnt(0);
        const unsigned x = xb_xcc_id();
        unsigned nloc = st[0], nx = st[1];
        if (nloc == 0u) { xcd_barrier_complete(bar, x, nloc, nx); st[0] = nloc; st[1] = nx; }
        const unsigned old = xb_add(&bar[XB_XSUB(x)], 1u);
        const unsigned gen = old / nloc;
        if (old + 1u == (gen + 1u) * nloc) {
            __builtin_amdgcn_fence(__ATOMIC_RELEASE, "agent");
            asm volatile("s_waitcnt vmcnt(0)" ::: "memory");
            const unsigned og = xb_add(&bar[XB_TOP], 1u);
            const unsigned tg = og / nx;
            if (og + 1u == (tg + 1u) * nx) xb_add(&bar[XB_TOPGEN], 1u);
            else XB_SPIN(xb_ld(&bar[XB_TOPGEN]) == tg, bar);
            __builtin_amdgcn_fence(__ATOMIC_ACQUIRE, "agent");
            xb_add(&bar[XB_XGEN(x)], 1u);
            asm volatile("s_waitcnt vmcnt(0)" ::: "memory");
        } else {
            XB_SPIN(xb_ld(&bar[XB_XGEN(x)]) == gen, bar);
            __builtin_amdgcn_fence(__ATOMIC_ACQUIRE, "agent");
            asm volatile("s_waitcnt vmcnt(0)" ::: "memory");
        }
    }
    __syncthreads();
}
constexpr int LDS_BARST = LDS_BYTES - 64;

constexpr int N_PHASES = 14;
#ifndef DBG_STOP
#define DBG_STOP 99
#endif
#ifndef DBG_SRC
#define DBG_SRC WS_UP
#endif

__device__ __forceinline__ Frame make_frame(LAS unsigned char* lds) {
    Frame F;
    ArgsP a = (ArgsP)__builtin_amdgcn_kernarg_segment_ptr(); asm volatile("" : "+s"(a));
    int t = threadIdx.x; asm volatile("" : "+v"(t));
    F.a = a; F.ws = a->ws; F.out = a->out; F.lds = lds;
    F.tid = t; F.lane = t & 63; F.wave = __builtin_amdgcn_readfirstlane(t >> 6); F.G = gridDim.x;
    F.gw = blockIdx.x * 8 + F.wave; F.NGW = F.G * 8;
    return F;
}
#define XN_(F) ((bf16_t*)((F).ws + WS_XN))
#define X_(F) ((float*)((F).ws + WS_X))
#define H_(F) ((bf16_t*)((F).ws + WS_H))
#define VCU_(F) (((F).G & 7) == 0 ? (int)((blockIdx.x & 7) * ((F).G >> 3) + (blockIdx.x >> 3)) : (int)blockIdx.x)
#define PB_(F) ((float*)((F).ws + WS_PB))
#define X0_(F) (X0Src{(F).a->in[5], (F).a->in[0], (F).a->in[1]})

__global__ void __launch_bounds__(512, 2) mk_fwd(Args args) {
    extern __shared__ __attribute__((aligned(16))) unsigned char lds_raw[];
    LAS unsigned char* const lds = (LAS unsigned char*)lds_raw;
    const int lo = args.ph_lo, hi = args.ph_hi;
    if (threadIdx.x < 2) ((volatile LAS unsigned*)(lds + LDS_BARST))[threadIdx.x] = 0u;
    if (threadIdx.x == 0) (void)xb_add((unsigned*)(args.ws + WS_CTL) + XB_XCNT(xb_xcc_id()), 1u);
    __syncthreads();
#define IN(k) (lo <= (k) && (k) < hi && ((k) < DBG_STOP || (k) == 13))
#define SEAM(k) do { if (lo <= (k) && (k) + 1 < hi) { if (hi > 1000) cg::this_grid().sync();   ArgsP a_ = (ArgsP)__builtin_amdgcn_kernarg_segment_ptr(); asm volatile("" : "+s"(a_)); xcd_barrier((unsigned*)(a_->ws + WS_CTL), (volatile LAS unsigned*)(lds + LDS_BARST)); } } while (0)

    if (IN(0)) { const Frame F = make_frame(lds);
        cvt_ffn(F, 7, F.gw, F.NGW);
        const X0Src x0 = X0_(F); bf16_t* XN = XN_(F);
        for (int r = F.gw; r < MP; r += F.NGW) { const float* xr = x0_row(x0, r); if (xr) rms_row(xr, F.a->in[6], XN + (size_t)r * D, nullptr, F.lane); else zero_row_bf16(XN + (size_t)r * D, F.lane); }
    }
    SEAM(0);
    if (IN(1)) { const Frame F = make_frame(lds);
        pg8::Gemm g{XN_(F), (const bf16_t*)(F.ws + WS_WGU), D, D, MP, 2 * FF, D, 0, 0}; pg8::PadOrder S; S.init(2 * FF, D, F.G, blockIdx.x);
        pg8::EpiSwiGLU E{H_(F)}; pg8::gemm_phase(lds, g, S, E); }
    SEAM(1);
    if (IN(2)) { const Frame F = make_frame(lds);
        pg8::Gemm g{H_(F), (const bf16_t*)(F.ws + WS_WD), FF, FF, MP, D, FF, 0, 3}; pg8::TailSplitOrder S; S.init(D, FF, F.G, blockIdx.x);
        pg8::EpiAdd<true> E{X0_(F), X_(F), PB_(F), 0.5f}; pg8::gemm_phase(lds, g, S, E);
        if (lo == 0) { const Frame F2 = make_frame(lds); const int nb = 24 * pg8::TS_NSPLIT;
            if ((int)blockIdx.x >= nb) cvt_mixer(F2, ((int)blockIdx.x - nb) * 8 + F2.wave, (F2.G - nb) * 8, 0, 3904); } }
    SEAM(2);
    if (IN(3)) { const Frame F = make_frame(lds); bf16_t* XN = XN_(F); float* X = X_(F); const float* PB = PB_(F);
        for (int r = F.gw; r < MP; r += F.NGW) { if (r < MV) {
                rms_row(X + (size_t)r * D, F.a->in[10], XN + (size_t)r * D, nullptr, F.lane, r >= pg8::TS_ROWS0 ? X + (size_t)r * D : nullptr, r >= pg8::TS_ROWS0 ? PB + (size_t)(r - pg8::TS_ROWS0) * D : nullptr, (size_t)(MP - pg8::TS_ROWS0) * D); }
            else zero_row_bf16(XN + (size_t)r * D, F.lane); } }
    SEAM(3);
    if (IN(4)) { const Frame F = make_frame(lds);
        pg8::Gemm g{XN_(F), (const bf16_t*)(F.ws + WS_WIN), D, D, MP, WIN, D, 0, 0}; pg8::StaticOrder S; S.init(MP, WIN, F.G, blockIdx.x, D);
        pg8::EpiWin E{(float*)(F.ws + WS_UP), (float*)(F.ws + WS_US), (bf16_t*)(F.ws + WS_G), F.a->in[12]}; pg8::gemm_phase(lds, g, S, E);
        { const Frame F2 = make_frame(lds); const int nb = (MP / 256) * (WIN / 256) - 3 * F2.G;
          if ((int)blockIdx.x >= nb) { cvt_ffn(F2, 29, ((int)blockIdx.x - nb) * 8 + F2.wave, (F2.G - nb) * 8, 0, 4); cvt_ffn(F2, 29, ((int)blockIdx.x - nb) * 8 + F2.wave, (F2.G - nb) * 8, 1, 4); } } }
    SEAM(4);
    if (IN(5)) { __syncthreads();
        { const Frame F = make_frame(lds); s5_phase(F); }
        { const Frame F = make_frame(lds); pool_phase(F); }
        __syncthreads(); }
    SEAM(5);
    if (IN(6)) {
        { const Frame F = make_frame(lds);
          pg8::Gemm g{(const bf16_t*)(F.ws + WS_DD), (const bf16_t*)(F.ws + WS_PW), WPOOL, 256, MP, WPOOL, 256, 512, 0}; pg8::StaticOrder S; S.init(MP, WPOOL, F.G, blockIdx.x, 256);
          pg8::EpiPool E{XN_(F), F.a->in[14]}; pg8::gemm_phase(lds, g, S, E); }
        { const Frame F = make_frame(lds);
          pg8::Gemm g{(const bf16_t*)(F.ws + WS_SG), (const bf16_t*)(F.ws + WS_GLU), WSSM, WSSM, MP, WSSM, WSSM, 0, 0}; pg8::StaticOrder S; S.init(MP, WSSM, F.G, (blockIdx.x + F.G / 2) % F.G, WSSM);
          pg8::EpiGLU E{XN_(F), (const bf16_t*)(F.ws + WS_SG), F.a->in[24]}; pg8::gemm_phase(lds, g, S, E); }
    }
    SEAM(6);
    if (IN(7)) { const Frame F = make_frame(lds);
        pg8::Gemm g{XN_(F), (const bf16_t*)(F.ws + WS_WA), 2048, 1024, MP, D, 1024, 0, 0}; pg8::StaticOrder S; S.init(MP, D, F.G, blockIdx.x, 1024);
        pg8::EpiBr1 E{(bf16_t*)(F.ws + WS_T1), (const bf16_t*)(F.ws + WS_G)}; pg8::gemm_phase(lds, g, S, E);
        { const Frame F2 = make_frame(lds); if ((int)blockIdx.x >= 24) { cvt_mixer(F2, ((int)blockIdx.x - 24) * 8 + F2.wave, (F2.G - 24) * 8, 3904, 4416);
              cvt_ffn(F2, 29, ((int)blockIdx.x - 24) * 8 + F2.wave, (F2.G - 24) * 8, 2, 4); } } }
    SEAM(7);
    if (IN(8)) { const Frame F = make_frame(lds);
        pg8::Gemm g{XN_(F) + 1024, (const bf16_t*)(F.ws + WS_WB), 2048, 1024, MP, D, 1024, 0, 0}; pg8::StaticOrder S; S.init(MP, D, F.G, blockIdx.x, 1024);
        pg8::EpiBr2 E{(const bf16_t*)(F.ws + WS_T1), (const bf16_t*)(F.ws + WS_G), (bf16_t*)(F.ws + WS_MRG)}; pg8::gemm_phase(lds, g, S, E);
        { const Frame F2 = make_frame(lds); if ((int)blockIdx.x >= 24) { cvt_mixer(F2, ((int)blockIdx.x - 24) * 8 + F2.wave, (F2.G - 24) * 8, 4416, 5440);
              cvt_ffn(F2, 29, ((int)blockIdx.x - 24) * 8 + F2.wave, (F2.G - 24) * 8, 3, 4); } } }
    SEAM(8);
    if (IN(9)) { const Frame F = make_frame(lds);
        pg8::Gemm g{(const bf16_t*)(F.ws + WS_MRG), (const bf16_t*)(F.ws + WS_WOUT), D, D, MP, D, D, 0, 0}; pg8::TailSplitOrder S; S.init(D, D, F.G, blockIdx.x);
        pg8::EpiAdd<false> E{X0_(F), X_(F), (float*)(F.ws + WS_DD), 1.0f};     pg8::gemm_phase(lds, g, S, E); }
    SEAM(9);
    if (IN(10)) { const Frame F = make_frame(lds); bf16_t* XN = XN_(F); float* X = X_(F); const float* PB = (const float*)(F.ws + WS_DD);
        for (int r = F.gw; r < MP; r += F.NGW) { if (r < MV) {
                rms_row(X + (size_t)r * D, F.a->in[28], XN + (size_t)r * D, nullptr, F.lane, r >= pg8::TS_ROWS0 ? X + (size_t)r * D : nullptr, r >= pg8::TS_ROWS0 ? PB + (size_t)(r - pg8::TS_ROWS0) * D : nullptr, (size_t)(MP - pg8::TS_ROWS0) * D); }
            else zero_row_bf16(XN + (size_t)r * D, F.lane); } }
    SEAM(10);
    if (IN(11)) { const Frame F = make_frame(lds);
        pg8::Gemm g{XN_(F), (const bf16_t*)(F.ws + WS_WGU), D, D, MP, 2 * FF, D, 0, 0}; pg8::PadOrder S; S.init(2 * FF, D, F.G, blockIdx.x);
        pg8::EpiSwiGLU E{H_(F)}; pg8::gemm_phase(lds, g, S, E); }
    SEAM(11);
    if (IN(12)) { const Frame F = make_frame(lds);
        pg8::Gemm g{H_(F), (const bf16_t*)(F.ws + WS_WD), FF, FF, MP, D, FF, 0, 3}; pg8::TailSplitOrder S; S.init(D, FF, F.G, blockIdx.x);
        pg8::EpiAdd<false> E{X0_(F), X_(F), PB_(F), 0.5f}; pg8::gemm_phase(lds, g, S, E); }
    SEAM(12);
    if (IN(13) && DBG_STOP < 99) { const Frame F = make_frame(lds);
        const f32x4* src = (const f32x4*)(F.ws + DBG_SRC); f32x4* dst = (f32x4*)F.out;
        for (size_t i = (size_t)blockIdx.x * 512 + F.tid; i < O_PP / 4; i += (size_t)F.G * 512) dst[i] = src[i];
    } else
    if (IN(13)) { const Frame F = make_frame(lds); const float* X = X_(F);
        for (int r = F.gw; r < MV; r += F.NGW) {
            float* o;
            if (r < MPR) { const int b = r / LP, t = r - b * LP; if (t < NMETA) continue; o = F.out + O_YP + ((size_t)b * SEQ + (t - NMETA)) * D; }
            else o = F.out + O_YS + (size_t)(r - MPR) * D;
            rms_row(X + (size_t)r * D, F.a->in[32], nullptr, o, F.lane, nullptr, r >= pg8::TS_ROWS0 ? PB_(F) + (size_t)(r - pg8::TS_ROWS0) * D : nullptr, (size_t)(MP - pg8::TS_ROWS0) * D);
        }
    }
#undef IN
#undef SEAM
}

extern "C" void kernel_launch(void* const* d_in, const int* in_sizes, int n_in, void* d_out, int out_size, void* d_ws, size_t ws_size, hipStream_t stream) {
    static int grid = 0;
    if (grid == 0) {
        if (n_in != 33 || ws_size < WS_END) { fprintf(stderr, "kernel_launch: expected 33 inputs and >= %zu bytes of workspace; got %d, %zu\n", (size_t)WS_END, n_in, ws_size); grid = -1; return; }
        int dev = 0, cus = 0, per_cu = 0;
        if (hipGetDevice(&dev) != hipSuccess || hipDeviceGetAttribute(&cus, hipDeviceAttributeMultiprocessorCount, dev) != hipSuccess) { grid = -1; return; }
        if (hipFuncSetAttribute((const void*)mk_fwd, hipFuncAttributeMaxDynamicSharedMemorySize, LDS_BYTES) != hipSuccess) { fprintf(stderr, "kernel_launch: hipFuncSetAttribute failed\n"); grid = -1; return; }
        if (hipOccupancyMaxActiveBlocksPerMultiprocessor(&per_cu, (const void*)mk_fwd, 512, LDS_BYTES) != hipSuccess || per_cu < 1) { fprintf(stderr, "kernel_launch: occupancy query says %d\n", per_cu); per_cu = 1; }
        (void)hipGetLastError();
        grid = cus * per_cu;
        if (grid > 256) grid = 256;
        if (grid != 256) fprintf(stderr, "kernel_launch: this kernel needs a 256-workgroup cooperative grid; got capacity %d\n", grid);
    }
    if (grid < 0) return;
    Args a{};
    for (int i = 0; i < 33; ++i) a.in[i] = (const float*)d_in[i];
    a.out = (float*)d_out; a.ws = (unsigned char*)d_ws;
#if MK_N_LAUNCHES == 1
    if (hipMemsetAsync((char*)d_ws + WS_CTL, 0, CTL_BYTES, stream) != hipSuccess) { fprintf(stderr, "kernel_launch: hipMemsetAsync failed\n"); return; }
    a.ph_lo = 0; a.ph_hi = N_PHASES;
    void* kargs[] = {&a};
    hipError_t e = hipLaunchCooperativeKernel((const void*)mk_fwd, dim3(grid), dim3(512), kargs, LDS_BYTES, stream);
    if (e != hipSuccess) fprintf(stderr, "kernel_launch: cooperative launch failed: %s (grid %d)\n", hipGetErrorString(e), grid);
#else
    for (int p = 0; p < N_PHASES; ++p) { a.ph_lo = p; a.ph_hi = p + 1; hipLaunchKernelGGL(mk_fwd, dim3(grid), dim3(512), LDS_BYTES, stream, a); }
#endif
}
```

```cpp
#include <hip/hip_runtime.h>
#include <hip/hip_cooperative_groups.h>
#include <cstdio>
#include <cstdint>
namespace cg = cooperative_groups;

#ifndef MK_N_LAUNCHES
#define MK_N_LAUNCHES 1
#endif

#define LAS __attribute__((address_space(3)))
typedef unsigned short bf16_t;
typedef short bf16x8 __attribute__((ext_vector_type(8)));
typedef float f32x4 __attribute__((ext_vector_type(4)));
typedef float f32x2 __attribute__((ext_vector_type(2)));
typedef unsigned u32x4 __attribute__((ext_vector_type(4)));
typedef unsigned u32x2 __attribute__((ext_vector_type(2)));

constexpr int D = 2048, FF = 5632, NBP = 4, SEQ = 2048, NMETA = 16, LP = SEQ + NMETA  , NBS = 128, LS = 4;
constexpr int MPR = NBP * LP  , MSA = NBS * LS  , MV = MPR + MSA  , MP = 8960  ;
constexpr int WPOOL = 1024, WSSM = 1024, NG = 64, NP = 64, GS = 16, WIN = 6144, NCH = LP / 16  ;
constexpr float RMS_EPS = 1e-6f;
constexpr float LOG2E = 1.4426950408889634f;

constexpr size_t O_YP = 0, O_YS = 16777216, O_PP = 17825792, O_PS = 17887232, O_RP = 19853312, O_IP = 19869696, O_RS = 19886080, O_IS = 20410368;

constexpr size_t MiB = 1u << 20;
constexpr size_t WS_WGU = 0;
constexpr size_t WS_WD = 44 * MiB;
constexpr size_t WS_WIN = 66 * MiB;
constexpr size_t WS_PW = 90 * MiB;
constexpr size_t WS_GLU = 91 * MiB;
constexpr size_t WS_WA = 93 * MiB;
constexpr size_t WS_WB = 97 * MiB;
constexpr size_t WS_WOUT = 101 * MiB;
constexpr size_t WS_XN = 110 * MiB;
constexpr size_t WS_X = 145 * MiB;
constexpr size_t WS_R = 215 * MiB;
constexpr size_t WS_H = WS_R;
constexpr size_t WS_UP = WS_R;
constexpr size_t WS_US = WS_R + 35 * MiB;
constexpr size_t WS_T1 = WS_R;
constexpr size_t WS_PB = WS_R + 100 * MiB;
constexpr size_t WS_G = WS_R + 70 * MiB;
constexpr size_t WS_DD = WS_R + 140 * MiB;
constexpr size_t WS_SG = WS_DD + 18 * MiB;
constexpr size_t WS_MRG = WS_SG + 18 * MiB;
constexpr size_t WS_CTL = WS_MRG + 35 * MiB;
constexpr size_t CTL_BYTES = 65536 + 262144;
constexpr size_t CTL_CNT = 16384, CTL_XBUF = 65536;
constexpr size_t WS_END = WS_CTL + CTL_BYTES;
static_assert((size_t)MP * 2048 * 2 <= 35 * MiB && (size_t)MP * 1024 * 2 <= 18 * MiB && (size_t)MP * FF * 2 <= 140 * MiB, "ws map");

constexpr int LDS_BYTES = 147456;

__device__ __forceinline__ unsigned f2bf(float f) { unsigned u = __builtin_bit_cast(unsigned, f); return (u + 0x7fffu + ((u >> 16) & 1u)) >> 16; }
__device__ __forceinline__ float bf2f(unsigned b) { return __builtin_bit_cast(float, b << 16); }
typedef __bf16 bf16x2v __attribute__((ext_vector_type(2)));
__device__ __forceinline__ unsigned cvt_pk_bf16(float lo, float hi) { const f32x2 v = {lo, hi}; const bf16x2v b = __builtin_convertvector(v, bf16x2v); return __builtin_bit_cast(unsigned, b); }
__device__ __forceinline__ u32x4 pack8(f32x4 a, f32x4 b) { u32x4 w; w.x = cvt_pk_bf16(a[0], a[1]); w.y = cvt_pk_bf16(a[2], a[3]); w.z = cvt_pk_bf16(b[0], b[1]); w.w = cvt_pk_bf16(b[2], b[3]); return w; }
__device__ __forceinline__ void unpack8(u32x4 w, f32x4& a, f32x4& b) {
    a[0] = __builtin_bit_cast(float, w.x << 16); a[1] = __builtin_bit_cast(float, w.x & 0xffff0000u); a[2] = __builtin_bit_cast(float, w.y << 16); a[3] = __builtin_bit_cast(float, w.y & 0xffff0000u);
    b[0] = __builtin_bit_cast(float, w.z << 16); b[1] = __builtin_bit_cast(float, w.z & 0xffff0000u); b[2] = __builtin_bit_cast(float, w.w << 16); b[3] = __builtin_bit_cast(float, w.w & 0xffff0000u); }
__device__ __forceinline__ float sigm(float x) { return __builtin_amdgcn_rcpf(1.0f + __builtin_amdgcn_exp2f(-LOG2E * x)); }
__device__ __forceinline__ f32x4 sigm4(f32x4 x) { f32x4 r; r[0] = sigm(x[0]); r[1] = sigm(x[1]); r[2] = sigm(x[2]); r[3] = sigm(x[3]); return r; }
__device__ __forceinline__ float gelu_tanh(float x) { const float z = 1.5957691216057308f * (x + 0.044715f * x * x * x); return x * sigm(z); }
__device__ __forceinline__ float wave_sum(float v) {
#pragma unroll
    for (int o = 1; o < 64; o <<= 1) v += __shfl_xor(v, o);
    return v;
}

struct X0Src { const float* meta; const float* xp; const float* xs; };
__device__ __forceinline__ const float* x0_row(const X0Src& s, int r) {
    if (r < MPR) { const int b = r / LP, t = r - b * LP; return t < NMETA ? s.meta + (size_t)t * D : s.xp + ((size_t)b * SEQ + (t - NMETA)) * D; }
    if (r < MV) return s.xs + (size_t)(r - MPR) * D;
    return nullptr;
}

namespace pg8 {
constexpr int BM = 256, BK = 64, HALF = 128, HTB = HALF * BK * 2, NXCD = 8, WGM = 8;
__host__ __device__ __forceinline__ int lds_byte(int r, int c) { const int st = (r >> 4) * 2 + (c >> 5), rr = r & 15, cc = c & 31, ob = rr * 64 + cc * 2; return st * 1024 + (ob ^ (((ob >> 9) & 1) << 5)); }
__host__ __device__ __forceinline__ void stage_rc(int b, int& R, int& C) { const int st = b / 1024, sb = b % 1024, swz = sb ^ (((sb >> 9) & 1) << 5); R = (st >> 1) * 16 + swz / 64; C = (st & 1) * 32 + (swz % 64) / 2; }
__host__ __device__ __forceinline__ int perm32(int rho) { const int n = rho >> 4, i = rho & 15; return 8 * (i >> 2) + 4 * n + (i & 3); }

struct Unit { int pm, pn, kt0, nkt, full; };
struct Gemm { const bf16_t* A; const bf16_t* Bt; int lda, ldb, M, N, K, a_pn_bytes; };

struct StaticOrder {
    int nM, nN, nwg, G, c, nkt;
    __device__ void init(int M, int N, int G_, int c_, int K = 0) { nM = M / BM; nN = N / BM; nwg = nM * nN; G = G_; c = c_; nkt = K / BK; }
    __device__ bool next(int i, Unit& u) const {
        const long L = (long)i * G + c; if (L >= nwg) return false;
        int wgid = (int)L; { const int q = nwg / NXCD, r = nwg % NXCD, xcd = wgid % NXCD, off = wgid / NXCD; wgid = (xcd < r ? xcd * (q + 1) : r * (q + 1) + (xcd - r) * q) + off; }
        const int nig = WGM * nN, gid = wgid / nig, fm = gid * WGM, gsz = (nM - fm) < WGM ? (nM - fm) : WGM;
        u.pm = fm + ((wgid % nig) % gsz); u.pn = (wgid % nig) / gsz; u.kt0 = 0; u.nkt = nkt; u.full = 1; return true;
    }
};
struct PadOrder {
    StaticOrder so; int c, nN, nkt;
    __device__ void init(int N, int K, int G, int c_) { so.init((MP / BM - 1) * BM, N, G, c_, K); c = c_; nN = N / BM; nkt = K / BK; }
    __device__ bool next(int i, Unit& u) const {
        if (so.next(i, u)) return true;
        const int n0 = so.nwg / so.G, rem = so.nwg - n0 * so.G;
        if (i < n0 || c < rem) return false;
        const int f = (i - n0) * (so.G - rem) + (c - rem); if (f >= nN) return false;
        u.pm = MP / BM - 1; u.pn = f; u.kt0 = 0; u.nkt = nkt; u.full = 1; return true;
    }
};
constexpr int TS_ROWS0 = 8192, TS_NSPLIT = 4;
struct TailSplitOrder {
    StaticOrder so; int c, nkt, mode;
    __device__ void init(int N, int K, int G, int c_, int mode_ = 0) { so.init(TS_ROWS0, N, G, c_, K); c = c_; nkt = K / BK; mode = mode_; }
    __device__ bool next(int i, Unit& u) const {
        if (mode == 2) ++i;
        if (i == 0) return so.next(0, u);
        if (i > 1 || mode == 1 || c >= 24 * TS_NSPLIT) return false;
        const int t = c / TS_NSPLIT, kq = c % TS_NSPLIT;
        u.pm = TS_ROWS0 / BM + (t >> 3); u.pn = t & 7; u.nkt = nkt / TS_NSPLIT; u.kt0 = kq * u.nkt; u.full = 0; return true;
    }
};

template <class Epi, class Order>
__device__ __forceinline__ void gemm_phase(LAS unsigned char* lds, const Gemm g, const Order& S, const Epi& E) {
    int tid_ = threadIdx.x; asm volatile("" : "+v"(tid_));
    const int tid = tid_, wid = __builtin_amdgcn_readfirstlane(tid >> 6), lane = tid & 63, wr = wid >> 2, wc = wid & 3, fr = lane & 15, fq = lane >> 4;
    unsigned voffA[2], voffB[2];
#pragma unroll
    for (int i = 0; i < 2; ++i) { int R, C; stage_rc(tid * 16 + i * 8192, R, C); const int Rb = (R & ~31) + perm32(R & 31);
        voffA[i] = (unsigned)(R * g.lda + C) * 2u; voffB[i] = (unsigned)(Rb * g.ldb + C) * 2u; }
    const size_t kstep = (size_t)(BK * 2);
    const size_t hstepA = (size_t)HALF * g.lda * 2, hstepB = (size_t)HALF * g.ldb * 2;
    const size_t tstepA = 2 * hstepA, tstepB = 2 * hstepB;
    const unsigned ldsw = (unsigned)wid * 1024u;
    const int aoff = lds_byte(wr * 64 + fr, fq * 8), boff = lds_byte(wc * 32 + fr, fq * 8);
#define PG8_SA(b, h) (((b) * 2 + (h)) * HTB)
#define PG8_SB(b, h) ((4 + (b) * 2 + (h)) * HTB)
#define PG8_STAGE(bufoff, gbase, voff) do { _Pragma("unroll") for (int _i = 0; _i < 2; ++_i) \
        __builtin_amdgcn_global_load_lds((const unsigned*)((const char*)(gbase) + (voff)[_i]), (LAS unsigned*)(lds + (bufoff) + ldsw + _i * 8192), 16, 0, 0); } while (0)
#define PG8_LDA(dst, b, h) do { _Pragma("unroll") for (int m = 0; m < 4; ++m) _Pragma("unroll") for (int k = 0; k < 2; ++k) dst[m][k] = *(const LAS bf16x8*)(lds + PG8_SA(b, h) + aoff + m * 2048 + k * 1024); } while (0)
#define PG8_LDB(dst, b, h) do { _Pragma("unroll") for (int n = 0; n < 2; ++n) _Pragma("unroll") for (int k = 0; k < 2; ++k) dst[n][k] = *(const LAS bf16x8*)(lds + PG8_SB(b, h) + boff + n * 2048 + k * 1024); } while (0)
#define PG8_MMA(ai, bj, At, Bt) do { __builtin_amdgcn_s_setprio(1); _Pragma("unroll") for (int m = 0; m < 4; ++m) _Pragma("unroll") for (int n = 0; n < 2; ++n) _Pragma("unroll") for (int k = 0; k < 2; ++k) \
        acc[ai][bj][m][n] = __builtin_amdgcn_mfma_f32_16x16x32_bf16(Bt[n][k], At[m][k], acc[ai][bj][m][n], 0, 0, 0); __builtin_amdgcn_s_setprio(0); } while (0)
#define PG8_WAIT_V(n) asm volatile("s_waitcnt vmcnt(" #n ")" ::: "memory")
#define PG8_WAIT_L(n) asm volatile("s_waitcnt lgkmcnt(" #n ")" ::: "memory")
#define PG8_BAR __builtin_amdgcn_s_barrier()
#define PG8_SCHED __builtin_amdgcn_sched_barrier(0)
    Unit cur, nxt; int ui = 0;
    if (!S.next(0, cur)) return;
    f32x4 acc[2][2][4][2];
#pragma unroll
    for (int a = 0; a < 2; ++a)
#pragma unroll
        for (int b = 0; b < 2; ++b)
#pragma unroll
            for (int m = 0; m < 4; ++m)
#pragma unroll
                for (int n = 0; n < 2; ++n) acc[a][b][m][n] = (f32x4){0.f, 0.f, 0.f, 0.f};
    bf16x8 At[4][2], B0[2][2], B1[2][2];
    const char* cA = (const char*)g.A + (size_t)cur.pm * tstepA + (size_t)cur.pn * g.a_pn_bytes + (size_t)cur.kt0 * kstep; const char* cB = (const char*)g.Bt + (size_t)cur.pn * tstepB + (size_t)cur.kt0 * kstep;
    PG8_STAGE(PG8_SB(0, 0), cB, voffB); PG8_STAGE(PG8_SB(0, 1), cB + hstepB, voffB); PG8_STAGE(PG8_SA(0, 0), cA, voffA); PG8_STAGE(PG8_SA(0, 1), cA + hstepA, voffA);
    if (wr == 1) PG8_BAR;
    PG8_WAIT_V(2); PG8_BAR;
    PG8_STAGE(PG8_SB(1, 0), cB + kstep, voffB); PG8_STAGE(PG8_SA(1, 0), cA + kstep, voffA); PG8_STAGE(PG8_SB(1, 1), cB + hstepB + kstep, voffB);
    PG8_WAIT_V(6); PG8_BAR;
    for (;;) {
        const bool has_next = S.next(ui + 1, nxt);
        const char* nA = has_next ? (const char*)g.A + (size_t)nxt.pm * tstepA + (size_t)nxt.pn * g.a_pn_bytes + (size_t)nxt.kt0 * kstep : cA; const char* nB = has_next ? (const char*)g.Bt + (size_t)nxt.pn * tstepB + (size_t)nxt.kt0 * kstep : cB;
        const int nt = cur.nkt;
        const int row_w = __builtin_amdgcn_readfirstlane(cur.pm) * BM + wr * 64;
        const bool do0 = row_w < MV, do1 = row_w + HALF < MV;
        if (do0 && do1) {
        for (int t = 0; t < nt; t += 2) {
            const bool last = (t == nt - 2);
            const char* a1 = cA + (size_t)(t + 1) * kstep;
            const char* a2 = last ? nA : cA + (size_t)(t + 2) * kstep; const char* b2 = last ? nB : cB + (size_t)(t + 2) * kstep;
            const char* a3 = a2 + kstep; const char* b3 = b2 + kstep;
            PG8_LDB(B0, 0, 0); PG8_LDB(B1, 0, 1); PG8_SCHED; PG8_LDA(At, 0, 0); PG8_STAGE(PG8_SA(1, 1), a1 + hstepA, voffA);
            PG8_WAIT_V(8); PG8_WAIT_L(0); PG8_BAR; { PG8_MMA(0, 0, At, B0); PG8_MMA(0, 1, At, B1); } PG8_BAR; PG8_SCHED;
            PG8_LDA(At, 0, 1); PG8_STAGE(PG8_SB(0, 0), b2, voffB); PG8_STAGE(PG8_SB(0, 1), b2 + hstepB, voffB); PG8_STAGE(PG8_SA(0, 0), a2, voffA);
            PG8_WAIT_V(8); PG8_WAIT_L(0); PG8_BAR; { PG8_MMA(1, 0, At, B0); PG8_MMA(1, 1, At, B1); } PG8_BAR; PG8_SCHED;
            PG8_LDB(B0, 1, 0); PG8_LDB(B1, 1, 1); PG8_SCHED; PG8_LDA(At, 1, 0); PG8_STAGE(PG8_SA(0, 1), a2 + hstepA, voffA);
            PG8_WAIT_V(8); PG8_WAIT_L(0); PG8_BAR; { PG8_MMA(0, 0, At, B0); PG8_MMA(0, 1, At, B1); } PG8_BAR; PG8_SCHED;
            PG8_LDA(At, 1, 1); PG8_STAGE(PG8_SB(1, 0), b3, voffB); PG8_STAGE(PG8_SB(1, 1), b3 + hstepB, voffB); PG8_STAGE(PG8_SA(1, 0), a3, voffA);
            PG8_WAIT_V(8); PG8_WAIT_L(0); PG8_BAR; { PG8_MMA(1, 0, At, B0); PG8_MMA(1, 1, At, B1); } PG8_BAR; PG8_SCHED;
        }
        } else {
        for (int t = 0; t < nt; t += 2) {
            const bool last = (t == nt - 2);
            const char* a1 = cA + (size_t)(t + 1) * kstep;
            const char* a2 = last ? nA : cA + (size_t)(t + 2) * kstep; const char* b2 = last ? nB : cB + (size_t)(t + 2) * kstep;
            const char* a3 = a2 + kstep; const char* b3 = b2 + kstep;
            PG8_LDB(B0, 0, 0); PG8_LDB(B1, 0, 1); PG8_SCHED; PG8_LDA(At, 0, 0); PG8_STAGE(PG8_SA(1, 1), a1 + hstepA, voffA);
            PG8_WAIT_V(8); PG8_WAIT_L(0); PG8_BAR; if (do0) { PG8_MMA(0, 0, At, B0); PG8_MMA(0, 1, At, B1); } PG8_BAR; PG8_SCHED;
            PG8_LDA(At, 0, 1); PG8_STAGE(PG8_SB(0, 0), b2, voffB); PG8_STAGE(PG8_SB(0, 1), b2 + hstepB, voffB); PG8_STAGE(PG8_SA(0, 0), a2, voffA);
            PG8_WAIT_V(8); PG8_WAIT_L(0); PG8_BAR; if (do1) { PG8_MMA(1, 0, At, B0); PG8_MMA(1, 1, At, B1); } PG8_BAR; PG8_SCHED;
            PG8_LDB(B0, 1, 0); PG8_LDB(B1, 1, 1); PG8_SCHED; PG8_LDA(At, 1, 0); PG8_STAGE(PG8_SA(0, 1), a2 + hstepA, voffA);
            PG8_WAIT_V(8); PG8_WAIT_L(0); PG8_BAR; if (do0) { PG8_MMA(0, 0, At, B0); PG8_MMA(0, 1, At, B1); } PG8_BAR; PG8_SCHED;
            PG8_LDA(At, 1, 1); PG8_STAGE(PG8_SB(1, 0), b3, voffB); PG8_STAGE(PG8_SB(1, 1), b3 + hstepB, voffB); PG8_STAGE(PG8_SA(1, 0), a3, voffA);
            PG8_WAIT_V(8); PG8_WAIT_L(0); PG8_BAR; if (do1) { PG8_MMA(1, 0, At, B0); PG8_MMA(1, 1, At, B1); } PG8_BAR; PG8_SCHED;
        }
        }
        if (wr == 0) PG8_BAR;
        if constexpr (Epi::FUSED) E.fused(acc, cur, wr, wc, fr, fq, lds, wid, lane); else E(acc, cur, wr, wc, fr, fq);
        if (!has_next) break;
#pragma unroll
        for (int a = 0; a < 2; ++a)
#pragma unroll
            for (int b = 0; b < 2; ++b)
#pragma unroll
                for (int m = 0; m < 4; ++m)
#pragma unroll
                    for (int n = 0; n < 2; ++n) acc[a][b][m][n] = (f32x4){0.f, 0.f, 0.f, 0.f};
        cur = nxt; cA = nA; cB = nB; ++ui;
        if (wr == 1) PG8_BAR;
    }
    PG8_WAIT_V(0);
    PG8_BAR;
#undef PG8_SA
#undef PG8_SB
#undef PG8_STAGE
#undef PG8_LDA
#undef PG8_LDB
#undef PG8_MMA
#undef PG8_WAIT_V
#undef PG8_WAIT_L
#undef PG8_BAR
#undef PG8_SCHED
}

typedef const f32x4 (&AccRef)[2][2][4][2];
#define EPI_ROWS(...) _Pragma("unroll") for (int ai = 0; ai < 2; ++ai) _Pragma("unroll") for (int m = 0; m < 4; ++m) { const int r = u.pm * BM + ai * HALF + wr * 64 + m * 16 + fr; __VA_ARGS__; asm volatile("" ::: "memory"); }

struct EpiSwiGLU { static constexpr bool FUSED = false;
    bf16_t* H;
    __device__ __forceinline__ void operator()(AccRef acc, const Unit& u, int wr, int wc, int fr, int fq) const {
        const int col0 = u.pn * 128 + wc * 32 + 8 * fq;
        EPI_ROWS({
            const f32x4 g0 = acc[ai][0][m][0], g1 = acc[ai][0][m][1];
            const f32x4 v0 = g0 * sigm4(g0) * acc[ai][1][m][0], v1 = g1 * sigm4(g1) * acc[ai][1][m][1];
            *(u32x4*)(H + (size_t)r * FF + col0) = pack8(v0, v1);
        })
    }
};
template <bool X0> struct EpiAdd { static constexpr bool FUSED = false;
    X0Src src; float* out; float* pb; float scale;
    __device__ __forceinline__ void operator()(AccRef acc, const Unit& u, int wr, int wc, int fr, int fq) const {
        const int col0 = u.pn * BM + wc * 32 + 8 * fq;
        if (u.kt0 == 0) {
            EPI_ROWS({
                float* op = out + (size_t)r * D + col0; const float* bp = X0 ? x0_row(src, r) : out + (size_t)r * D;
                _Pragma("unroll") for (int bj = 0; bj < 2; ++bj) {
                    f32x4 b0 = (f32x4){0.f, 0.f, 0.f, 0.f}, b1 = b0;
                    if (!X0 || bp) { b0 = *(const f32x4*)(bp + col0 + bj * HALF); b1 = *(const f32x4*)(bp + col0 + bj * HALF + 4); }
                    *(f32x4*)(op + bj * HALF) = b0 + scale * acc[ai][bj][m][0]; *(f32x4*)(op + bj * HALF + 4) = b1 + scale * acc[ai][bj][m][1]; }
            })
        } else {
            float* pbq = pb + (size_t)(u.kt0 / u.nkt - 1) * ((size_t)(MP - TS_ROWS0) * D) - (size_t)TS_ROWS0 * D;
            EPI_ROWS({
                float* op = pbq + (size_t)r * D + col0;
                _Pragma("unroll") for (int bj = 0; bj < 2; ++bj) { *(f32x4*)(op + bj * HALF) = scale * acc[ai][bj][m][0]; *(f32x4*)(op + bj * HALF + 4) = scale * acc[ai][bj][m][1]; }
            })
        }
    }
};
struct EpiDownFinal { static constexpr bool FUSED = true;
    float* X; float* pb; float scale; const float* gain; float* out; unsigned* xbuf; unsigned* cnt;
    __device__ __forceinline__ void fused(f32x4 (&acc)[2][2][4][2], const Unit& u, int wr, int wc, int fr, int fq, LAS unsigned char* lds, int wid, int lane) const {
        const int col0 = u.pn * BM + wc * 32 + 8 * fq;
        int c1 = col0, pm1 = u.pm, rb1 = wr * 64 + fr, wc1 = wc; asm volatile("" : "+v"(c1), "+s"(pm1), "+v"(rb1), "+v"(wc1));
        LAS float* P = (LAS float*)(lds + 131072);
        LAS float* S = (LAS float*)(lds + 131072 + 4096);
#pragma unroll
        for (int ai = 0; ai < 2; ++ai)
#pragma unroll
            for (int m = 0; m < 4; ++m) { const int r = pm1 * BM + ai * HALF + m * 16 + rb1; const float* xp = X + (size_t)r * D + c1; float q = 0.f;
#pragma unroll
                for (int bj = 0; bj < 2; ++bj)
#pragma unroll
                    for (int n = 0; n < 2; ++n) { const f32x4 b = *(const f32x4*)(xp + bj * HALF + 4 * n); const f32x4 v = b + scale * acc[ai][bj][m][n]; acc[ai][bj][m][n] = v; q += (v[0] * v[0] + v[1] * v[1]) + (v[2] * v[2] + v[3] * v[3]); }
                q += __shfl_xor(q, 16); q += __shfl_xor(q, 32);
                if (fq == 0) P[(ai * HALF + m * 16 + rb1) * 4 + wc1] = q;
                asm volatile("" ::: "memory"); }
        asm volatile("s_waitcnt lgkmcnt(0)" ::: "memory"); __builtin_amdgcn_s_barrier(); asm volatile("" ::: "memory");
        int row = wid * 32 + (lane & 31); asm volatile("" : "+v"(row));
        if (lane < 32) { const float t = (P[row * 4 + 0] + P[row * 4 + 1]) + (P[row * 4 + 2] + P[row * 4 + 3]);
            __hip_atomic_store(xbuf + ((size_t)(u.pm * BM + row) * 8 + u.pn), __builtin_bit_cast(unsigned, t), __ATOMIC_RELAXED, __HIP_MEMORY_SCOPE_AGENT); }
        asm volatile("s_waitcnt vmcnt(0)" ::: "memory");
        if (lane == 0) (void)__hip_atomic_fetch_add(cnt + 64 * u.pm, 1u, __ATOMIC_RELAXED, __HIP_MEMORY_SCOPE_AGENT);
        if (wid == 0) { unsigned sp = 0;
            _Pragma("unroll 1") while ((unsigned)__builtin_amdgcn_readfirstlane(__hip_atomic_load(cnt + 64 * u.pm, __ATOMIC_RELAXED, __HIP_MEMORY_SCOPE_AGENT)) < 64u) { __builtin_amdgcn_s_sleep(2); if (++sp > (1u << 22)) break; }
            __builtin_amdgcn_fence(__ATOMIC_ACQUIRE, "agent"); }
        asm volatile("s_waitcnt vmcnt(0) lgkmcnt(0)" ::: "memory"); __builtin_amdgcn_s_barrier(); asm volatile("" ::: "memory");
        if (lane < 32) { const unsigned* sl = xbuf + (size_t)(u.pm * BM + row) * 8; float t = 0.f;
#pragma unroll
            for (int k = 0; k < 8; ++k) t += __builtin_bit_cast(float, __hip_atomic_load(sl + k, __ATOMIC_RELAXED, __HIP_MEMORY_SCOPE_AGENT));
            S[row] = 1.0f / sqrtf(t * (1.0f / D) + RMS_EPS); }
        asm volatile("s_waitcnt vmcnt(0) lgkmcnt(0)" ::: "memory"); __builtin_amdgcn_s_barrier(); asm volatile("" ::: "memory");
        int c5 = col0, pm5 = u.pm, rb5 = wr * 64 + fr; asm volatile("" : "+v"(c5), "+s"(pm5), "+v"(rb5));
        const int b0 = (pm5 * BM) / LP, t0 = pm5 * BM - b0 * LP;
#pragma unroll
        for (int ai = 0; ai < 2; ++ai)
#pragma unroll
            for (int m = 0; m < 4; ++m) { const int rl = ai * HALF + m * 16 + rb5; int t = t0 + rl, b = b0; if (t >= LP) { t -= LP; ++b; } const float rs = S[rl];
                if (t >= NMETA) { float* op = out + O_YP + ((size_t)b * SEQ + (t - NMETA)) * D + c5;
#pragma unroll
                    for (int bj = 0; bj < 2; ++bj) { const f32x4 g0 = *(const f32x4*)(gain + c5 + bj * HALF), g1 = *(const f32x4*)(gain + c5 + bj * HALF + 4);
                        *(f32x4*)(op + bj * HALF) = acc[ai][bj][m][0] * rs * g0; *(f32x4*)(op + bj * HALF + 4) = acc[ai][bj][m][1] * rs * g1; } }
                asm volatile("" ::: "memory"); }
    }
};
struct EpiWin { static constexpr bool FUSED = false;
    float* UP; float* US; bf16_t* G; const float* bg;
    __device__ __forceinline__ void operator()(AccRef acc, const Unit& u, int wr, int wc, int fr, int fq) const {
        if (u.pn < 8) {
            float* O = (u.pn < 4 ? UP : US); const int col0 = (u.pn & 3) * BM + wc * 32 + 8 * fq;
            EPI_ROWS({
                float* op = O + (size_t)r * 1024 + col0;
                _Pragma("unroll") for (int bj = 0; bj < 2; ++bj) { *(f32x4*)(op + bj * HALF) = acc[ai][bj][m][0]; *(f32x4*)(op + bj * HALF + 4) = acc[ai][bj][m][1]; }
            })
        } else {
            const int col0 = (u.pn - 8) * BM + wc * 32 + 8 * fq;
            f32x4 bv[2][2];
#pragma unroll
            for (int bj = 0; bj < 2; ++bj) { bv[bj][0] = *(const f32x4*)(bg + col0 + bj * HALF); bv[bj][1] = *(const f32x4*)(bg + col0 + bj * HALF + 4); }
            EPI_ROWS({
                bf16_t* op = G + (size_t)r * 4096 + col0;
                _Pragma("unroll") for (int bj = 0; bj < 2; ++bj) *(u32x4*)(op + bj * HALF) = pack8(sigm4(acc[ai][bj][m][0] + bv[bj][0]), sigm4(acc[ai][bj][m][1] + bv[bj][1]));
            })
        }
    }
};
struct EpiPool { static constexpr bool FUSED = false;
    bf16_t* AB; const float* sc;
    __device__ __forceinline__ void operator()(AccRef acc, const Unit& u, int wr, int wc, int fr, int fq) const {
        const int col0 = u.pn * BM + wc * 32 + 8 * fq;
        f32x4 sv[2][2];
#pragma unroll
        for (int bj = 0; bj < 2; ++bj) { sv[bj][0] = *(const f32x4*)(sc + col0 + bj * HALF); sv[bj][1] = *(const f32x4*)(sc + col0 + bj * HALF + 4); }
        EPI_ROWS({
            bf16_t* op = AB + (size_t)r * 2048 + col0;
            _Pragma("unroll") for (int bj = 0; bj < 2; ++bj) *(u32x4*)(op + bj * HALF) = pack8(acc[ai][bj][m][0] * sv[bj][0], acc[ai][bj][m][1] * sv[bj][1]);
        })
    }
};
struct EpiGLU { static constexpr bool FUSED = false;
    bf16_t* AB; const bf16_t* SG; const float* gb;
    __device__ __forceinline__ void operator()(AccRef acc, const Unit& u, int wr, int wc, int fr, int fq) const {
        const int col0 = u.pn * BM + wc * 32 + 8 * fq;
        f32x4 bv[2][2];
#pragma unroll
        for (int bj = 0; bj < 2; ++bj) { bv[bj][0] = *(const f32x4*)(gb + col0 + bj * HALF); bv[bj][1] = *(const f32x4*)(gb + col0 + bj * HALF + 4); }
        EPI_ROWS({
            bf16_t* op = AB + (size_t)r * 2048 + 1024 + col0; const bf16_t* sp = SG + (size_t)r * 1024 + col0;
            _Pragma("unroll") for (int bj = 0; bj < 2; ++bj) { f32x4 s0, s1; unpack8(*(const u32x4*)(sp + bj * HALF), s0, s1);
                *(u32x4*)(op + bj * HALF) = pack8(s0 * sigm4(acc[ai][bj][m][0] + bv[bj][0]), s1 * sigm4(acc[ai][bj][m][1] + bv[bj][1])); }
        })
    }
};
struct EpiBr1 { static constexpr bool FUSED = false;
    bf16_t* T1; const bf16_t* G;
    __device__ __forceinline__ void operator()(AccRef acc, const Unit& u, int wr, int wc, int fr, int fq) const {
        const int col0 = u.pn * BM + wc * 32 + 8 * fq;
        EPI_ROWS({
            bf16_t* op = T1 + (size_t)r * 2048 + col0; const bf16_t* gp = G + (size_t)r * 4096 + col0;
            _Pragma("unroll") for (int bj = 0; bj < 2; ++bj) { f32x4 g0, g1; unpack8(*(const u32x4*)(gp + bj * HALF), g0, g1);
                *(u32x4*)(op + bj * HALF) = pack8(g0 * acc[ai][bj][m][0], g1 * acc[ai][bj][m][1]); }
        })
    }
};
struct EpiBr2 { static constexpr bool FUSED = false;
    const bf16_t* T1; const bf16_t* G; bf16_t* MRG;
    __device__ __forceinline__ void operator()(AccRef acc, const Unit& u, int wr, int wc, int fr, int fq) const {
        const int col0 = u.pn * BM + wc * 32 + 8 * fq;
        EPI_ROWS({
            const bf16_t* tp = T1 + (size_t)r * 2048 + col0; const bf16_t* gp = G + (size_t)r * 4096 + 2048 + col0; bf16_t* op = MRG + (size_t)r * 2048 + col0;
            _Pragma("unroll") for (int bj = 0; bj < 2; ++bj) { f32x4 g0, g1; unpack8(*(const u32x4*)(gp + bj * HALF), g0, g1);
                f32x4 t0, t1; unpack8(*(const u32x4*)(tp + bj * HALF), t0, t1);
                *(u32x4*)(op + bj * HALF) = pack8(t0 + g0 * acc[ai][bj][m][0], t1 + g1 * acc[ai][bj][m][1]); }
        })
    }
};
}

__device__ __forceinline__ void cvt_item(const float* W, int K, int N, bf16_t* WT, int mode, int item, int lane) {
    const int nblk = N >> 6, kb = item / nblk, nb = item - kb * nblk, k0 = kb << 6, n0 = nb << 6;
    const int rg = lane >> 4, nq = lane & 15;
    const float* src = W + (size_t)(k0 + 16 * rg) * N + n0 + 4 * nq;
    f32x4 v[16];
#pragma unroll
    for (int i = 0; i < 16; ++i) v[i] = *(const f32x4*)(src + (size_t)i * N);
    const int drow0 = (mode == 0 ? n0 : ((n0 >> 7) * 256 + (mode == 2 ? 128 : 0) + (n0 & 127))) + 4 * nq;
    bf16_t* dst = WT + (size_t)drow0 * K + k0 + 16 * rg;
#pragma unroll
    for (int j = 0; j < 4; ++j)
#pragma unroll
        for (int h = 0; h < 2; ++h) {
            u32x4 w; w.x = cvt_pk_bf16(v[8 * h + 0][j], v[8 * h + 1][j]); w.y = cvt_pk_bf16(v[8 * h + 2][j], v[8 * h + 3][j]);
            w.z = cvt_pk_bf16(v[8 * h + 4][j], v[8 * h + 5][j]); w.w = cvt_pk_bf16(v[8 * h + 6][j], v[8 * h + 7][j]);
            *(u32x4*)(dst + (size_t)j * K + 8 * h) = w; }
}
struct Args { const float* in[33]; float* out; unsigned char* ws; int ph_lo, ph_hi; };
typedef const __attribute__((address_space(4))) Args* ArgsP;
struct Frame {
    ArgsP a; unsigned char* ws; float* out;
    LAS unsigned char* lds; int tid, lane, wave, G, gw, NGW;
};
__device__ __forceinline__ void cvt_ffn(const Frame& F, int i0, int w0, int nw, int part = 0, int nparts = 1) {
    constexpr int IG = (D / 64) * (FF / 64);
    bf16_t* wgu = (bf16_t*)(F.ws + WS_WGU); bf16_t* wd = (bf16_t*)(F.ws + WS_WD);
    const int ib = (int)((long)part * (3 * IG) / nparts), ie = (int)((long)(part + 1) * (3 * IG) / nparts);
    for (int it = ib + w0; it < ie; it += nw) {
        if (it < IG) cvt_item(F.a->in[i0], D, FF, wgu, 1, it, F.lane);
        else if (it < 2 * IG) cvt_item(F.a->in[i0 + 1], D, FF, wgu, 2, it - IG, F.lane);
        else cvt_item(F.a->in[i0 + 2], FF, D, wd, 0, it - 2 * IG, F.lane);
    }
}
__device__ __forceinline__ void cvt_mixer(const Frame& F, int w0, int nw, int it0, int it1) {
    constexpr int I_IN = (D / 64) * (WIN / 64)  , I_PW = 4 * 16, I_GLU = 256, I_A = 16 * 32, I_O = 32 * 32;
    constexpr int TOT = I_IN + I_PW + I_GLU + 2 * I_A + I_O;
    static_assert(TOT == 5440, "mixer conversion items");
    for (int it = it0 + w0; it < it1; it += nw) {
        int r = it;
        if (r < I_IN) { cvt_item(F.a->in[11], D, WIN, (bf16_t*)(F.ws + WS_WIN), 0, r, F.lane); continue; } r -= I_IN;
        if (r < I_PW) { const int g = r >> 4; cvt_item(F.a->in[13] + (size_t)g * 65536, 256, 256, (bf16_t*)(F.ws + WS_PW) + (size_t)g * 65536, 0, r & 15, F.lane); continue; } r -= I_PW;
        if (r < I_GLU) { cvt_item(F.a->in[23], 1024, 1024, (bf16_t*)(F.ws + WS_GLU), 0, r, F.lane); continue; } r -= I_GLU;
        if (r < I_A) { cvt_item(F.a->in[25], 1024, 2048, (bf16_t*)(F.ws + WS_WA), 0, r, F.lane); continue; } r -= I_A;
        if (r < I_A) { cvt_item(F.a->in[26], 1024, 2048, (bf16_t*)(F.ws + WS_WB), 0, r, F.lane); continue; } r -= I_A;
        cvt_item(F.a->in[27], 2048, 2048, (bf16_t*)(F.ws + WS_WOUT), 0, r, F.lane);
    }
}

__device__ __forceinline__ void rms_row(const float* xrow, const float* gain, bf16_t* orow, float* frow, int lane, float* copy = nullptr, const float* pbrow = nullptr, size_t pbstride = 0) {
    f32x4 v[8]; float s = 0.f;
#pragma unroll
    for (int j = 0; j < 8; ++j) { v[j] = ((const f32x4*)xrow)[64 * j + lane]; if (pbrow) { v[j] += ((const f32x4*)pbrow)[64 * j + lane]; v[j] += ((const f32x4*)(pbrow + pbstride))[64 * j + lane]; v[j] += ((const f32x4*)(pbrow + 2 * pbstride))[64 * j + lane]; } s += (v[j][0] * v[j][0] + v[j][1] * v[j][1]) + (v[j][2] * v[j][2] + v[j][3] * v[j][3]); }
    if (copy) {
#pragma unroll
        for (int j = 0; j < 8; ++j) ((f32x4*)copy)[64 * j + lane] = v[j]; }
    const float rs = 1.0f / sqrtf(wave_sum(s) * (1.0f / D) + RMS_EPS);
#pragma unroll
    for (int j = 0; j < 8; ++j) { const f32x4 gg = ((const f32x4*)gain)[64 * j + lane]; const f32x4 o = v[j] * rs * gg;
        if (orow) { u32x2 w; w.x = cvt_pk_bf16(o[0], o[1]); w.y = cvt_pk_bf16(o[2], o[3]); ((u32x2*)orow)[64 * j + lane] = w; }
        else ((f32x4*)frow)[64 * j + lane] = o; }
}
__device__ __forceinline__ void zero_row_bf16(bf16_t* orow, int lane) {
#pragma unroll
    for (int j = 0; j < 8; ++j) ((u32x2*)orow)[64 * j + lane] = (u32x2){0u, 0u};
}

__device__ __forceinline__ void sincos_r(float x, float& s, float& c) {
    const float k = rintf(x * 0.6366197723675814f);
    float r = fmaf(-k, 1.5707963705062866f, x); r = fmaf(-k, -4.371139000186241e-8f, r);
    const float z = r * r;
    const float sp = r + r * z * (-1.6666654611e-1f + z * (8.3321608736e-3f + z * (-1.9515295891e-4f)));
    const float cp = 1.0f - 0.5f * z + z * z * (4.166664568298827e-2f + z * (-1.388731625493765e-3f + z * 2.443315711809948e-5f));
    const int q = ((int)k) & 3;
    s = (q == 0) ? sp : (q == 1) ? cp : (q == 2) ? -sp : -cp;
    c = (q == 0) ? cp : (q == 1) ? -sp : (q == 2) ? -cp : sp;
}
__device__ __forceinline__ bf16x8 pack8s(f32x4 a, f32x4 b) { const u32x4 w = pack8(a, b); return __builtin_bit_cast(bf16x8, w); }

#define WSYNC() asm volatile("s_waitcnt lgkmcnt(0)" ::: "memory")
struct S5K { float lbr, lbi; bf16x8 bb[8]; bf16x8 cm[4]; f32x4 dsk; };

__device__ __forceinline__ void s5_consts(const Frame& F, int g, LAS float* tab, S5K& k) {
    const int lane = F.lane, i16 = lane & 15, kq = lane >> 4;
    const float lre = F.a->in[15][g * NP + lane], lim = F.a->in[16][g * NP + lane], dt = expf(F.a->in[17][g]);
    const float a = lre * dt, b = lim * dt;
    const float em1 = a * (1.0f + a * (0.5f + a * (1.0f / 6.0f + a * (1.0f / 24.0f + a * (1.0f / 120.0f + a * (1.0f / 720.0f))))));
    const float ea = 1.0f + em1;
    float sh, ch; sincos_r(0.5f * b, sh, ch);
    const float sb = 2.0f * sh * ch, cbm1 = -2.0f * sh * sh, cb = 1.0f + cbm1;
    k.lbr = ea * cb; k.lbi = ea * sb;
    const float rm1 = em1 * cb + cbm1, im1 = ea * sb;
    const float inv = 1.0f / (lre * lre + lim * lim);
    tab[2 * lane] = (rm1 * lre + im1 * lim) * inv; tab[2 * lane + 1] = (im1 * lre - rm1 * lim) * inv;
    WSYNC();
#pragma unroll
    for (int n4 = 0; n4 < 4; ++n4) {
        const int p = 16 * n4 + i16; const float qr = tab[2 * p], qi = tab[2 * p + 1];
        const float* br = F.a->in[18] + ((size_t)g * NP + p) * GS + 8 * (kq & 1); const float* bi = F.a->in[19] + ((size_t)g * NP + p) * GS + 8 * (kq & 1);
        const f32x4 r0 = *(const f32x4*)br, r1 = *(const f32x4*)(br + 4), i0 = *(const f32x4*)bi, i1 = *(const f32x4*)(bi + 4);
        k.bb[n4] = pack8s(qr * r0 - qi * i0, qr * r1 - qi * i1);
        k.bb[4 + n4] = pack8s(qr * i0 + qi * r0, qr * i1 + qi * r1);
    }
#pragma unroll
    for (int s = 0; s < 4; ++s) {
        const float* cp = (s < 2 ? F.a->in[20] : F.a->in[21]) + ((size_t)g * GS + i16) * NP + 32 * (s & 1) + 8 * kq;
        f32x4 c0 = *(const f32x4*)cp, c1 = *(const f32x4*)(cp + 4);
        if (s >= 2) { c0 = -c0; c1 = -c1; }
        k.cm[s] = pack8s(c0, c1);
    }
    k.dsk = *(const f32x4*)(F.a->in[22] + g * GS + 4 * kq);
    WSYNC();
}
__device__ __forceinline__ void s5_ld(const float* US, int row0, int g, int lane, f32x4& u0, f32x4& u1) {
    const float* up = US + (size_t)(row0 + (lane & 15)) * WSSM + g * GS + 8 * ((lane >> 4) & 1);
    u0 = *(const f32x4*)up; u1 = *(const f32x4*)(up + 4);
}
__device__ __forceinline__ void s5_bu(const f32x4 u0, const f32x4 u1, int lane, const S5K& k, LAS float* HB) {
    const int t = lane & 15, kq = lane >> 4;
    u32x4 hi = pack8(u0, u1);
    f32x4 h0, h1; unpack8(hi, h0, h1);
    const u32x4 lo = pack8(u0 - h0, u1 - h1);
    const bf16x8 uop = __builtin_bit_cast(bf16x8, (kq >= 2) ? lo : hi);
#pragma unroll
    for (int n = 0; n < 8; ++n) {
        const f32x4 d = __builtin_amdgcn_mfma_f32_16x16x32_bf16(k.bb[n], uop, (f32x4){0.f, 0.f, 0.f, 0.f}, 0, 0, 0);
        *(LAS f32x4*)(HB + t * 132 + 16 * n + 4 * kq) = d;
    }
    WSYNC();
}
__device__ __forceinline__ void s5_out(const f32x4 uu, bf16_t* SG, int row0, int g, int lane, const S5K& k, const LAS float* HB) {
    const int t = lane & 15, kq = lane >> 4;
    f32x4 acc = (f32x4){0.f, 0.f, 0.f, 0.f};
#pragma unroll
    for (int s = 0; s < 4; ++s) {
        const LAS float* hp = HB + t * 132 + 32 * s + 8 * kq;
        const f32x4 h0 = *(const LAS f32x4*)hp, h1 = *(const LAS f32x4*)(hp + 4);
        acc = __builtin_amdgcn_mfma_f32_16x16x32_bf16(k.cm[s], pack8s(h0, h1), acc, 0, 0, 0);
    }
    const f32x4 y = acc + k.dsk * uu;
    u32x2 w; w.x = cvt_pk_bf16(gelu_tanh(y[0]), gelu_tanh(y[1])); w.y = cvt_pk_bf16(gelu_tanh(y[2]), gelu_tanh(y[3]));
    *(u32x2*)(SG + (size_t)(row0 + t) * WSSM + g * GS + 4 * kq) = w;
    WSYNC();
}

__device__ __forceinline__ void s5_phase(const Frame& F) {
    const float* US = (const float*)(F.ws + WS_US); bf16_t* SG = (bf16_t*)(F.ws + WS_SG);
    LAS f32x2* EB = (LAS f32x2*)F.lds;
    LAS float* HB = (LAS float*)(F.lds + 66048 + F.wave * 8448);
    const int lane = F.lane;
    S5K k;
    for (int item = blockIdx.x; item < NBP * NG; item += F.G) {
        const int b = item >> 6, g = item & 63, rb = b * LP;
        s5_consts(F, g, HB, k);
        f32x4 nu0, nu1; s5_ld(US, rb + 16 * F.wave, g, lane, nu0, nu1);
        for (int c = F.wave; c < NCH; c += 8) {
            const f32x4 u0 = nu0, u1 = nu1; if (c + 8 < NCH) s5_ld(US, rb + 16 * (c + 8), g, lane, nu0, nu1);
            s5_bu(u0, u1, lane, k, HB);
            float br[16], bi[16];
#pragma unroll
            for (int t = 0; t < 16; ++t) { br[t] = HB[t * 132 + lane]; bi[t] = HB[t * 132 + 64 + lane]; }
            float hr = 0.f, hi = 0.f;
#pragma unroll
            for (int t = 0; t < 16; ++t) { const float nr = k.lbr * hr - k.lbi * hi + br[t], ni = k.lbr * hi + k.lbi * hr + bi[t]; hr = nr; hi = ni; }
            EB[c * 64 + lane] = (f32x2){hr, hi};
            WSYNC();
        }
        __syncthreads();
        if (F.wave == 0) {
            float pr = k.lbr, pi = k.lbi;
#pragma unroll
            for (int q = 0; q < 4; ++q) { const float nr = pr * pr - pi * pi, ni = 2.0f * pr * pi; pr = nr; pi = ni; }
            float hr = 0.f, hi = 0.f;
            for (int c0 = 0; c0 < NCH; c0 += 8) {
                f32x2 e[8];
#pragma unroll
                for (int j = 0; j < 8; ++j) e[j] = (c0 + j < NCH) ? EB[(c0 + j) * 64 + lane] : (f32x2){0.f, 0.f};
#pragma unroll
                for (int j = 0; j < 8; ++j) { const float nr = pr * hr - pi * hi + e[j][0], ni = pr * hi + pi * hr + e[j][1]; hr = nr; hi = ni; e[j] = (f32x2){hr, hi}; }
#pragma unroll
                for (int j = 0; j < 8; ++j) if (c0 + j < NCH) EB[(c0 + j) * 64 + lane] = e[j];
            }
            const f32x2 fin = EB[(NCH - 1) * 64 + lane];
            F.out[O_RP + (size_t)(b * NG + g) * NP + lane] = fin[0]; F.out[O_IP + (size_t)(b * NG + g) * NP + lane] = fin[1];
        }
        __syncthreads();
        s5_ld(US, rb + 16 * F.wave, g, lane, nu0, nu1);
        for (int c = F.wave; c < NCH; c += 8) {
            const f32x4 u0 = nu0, u1 = nu1; if (c + 8 < NCH) s5_ld(US, rb + 16 * (c + 8), g, lane, nu0, nu1);
            const f32x4 uu = *(const f32x4*)(US + (size_t)(rb + 16 * c + (lane & 15)) * WSSM + g * GS + 4 * (lane >> 4));
            s5_bu(u0, u1, lane, k, HB);
            float br[16], bi[16];
#pragma unroll
            for (int t = 0; t < 16; ++t) { br[t] = HB[t * 132 + lane]; bi[t] = HB[t * 132 + 64 + lane]; }
            f32x2 h0 = (f32x2){0.f, 0.f}; if (c > 0) h0 = EB[(c - 1) * 64 + lane];
            float hr = h0[0], hi = h0[1];
#pragma unroll
            for (int t = 0; t < 16; ++t) { const float nr = k.lbr * hr - k.lbi * hi + br[t], ni = k.lbr * hi + k.lbi * hr + bi[t]; hr = nr; hi = ni; br[t] = hr; bi[t] = hi; }
#pragma unroll
            for (int t = 0; t < 16; ++t) { HB[t * 132 + lane] = br[t]; HB[t * 132 + 64 + lane] = bi[t]; }
            WSYNC();
            s5_out(uu, SG, rb + 16 * c, g, lane, k, HB);
        }
        __syncthreads();
    }
    for (int it = F.gw; it < NG * (MSA / 16); it += F.NGW) {
        const int g = it >> 5, j = it & 31, row0 = MPR + 16 * j;
        f32x4 u0, u1; s5_ld(US, row0, g, lane, u0, u1);
        const f32x4 uu = *(const f32x4*)(US + (size_t)(row0 + (lane & 15)) * WSSM + g * GS + 4 * (lane >> 4));
        s5_consts(F, g, HB, k);
        s5_bu(u0, u1, lane, k, HB);
        float br[16], bi[16];
#pragma unroll
        for (int t = 0; t < 16; ++t) { br[t] = HB[t * 132 + lane]; bi[t] = HB[t * 132 + 64 + lane]; }
#pragma unroll
        for (int sq = 0; sq < 4; ++sq) {
            const size_t so = ((size_t)(4 * j + sq) * NG + g) * NP + lane;
            float hr = F.a->in[3][so], hi = F.a->in[4][so];
#pragma unroll
            for (int t = 4 * sq; t < 4 * sq + 4; ++t) { const float nr = k.lbr * hr - k.lbi * hi + br[t], ni = k.lbr * hi + k.lbi * hr + bi[t]; hr = nr; hi = ni; br[t] = hr; bi[t] = hi; }
            F.out[O_RS + so] = hr; F.out[O_IS + so] = hi;
        }
#pragma unroll
        for (int t = 0; t < 16; ++t) { HB[t * 132 + lane] = br[t]; HB[t * 132 + 64 + lane] = bi[t]; }
        WSYNC();
        s5_out(uu, SG, row0, g, lane, k, HB);
    }
}

__device__ __forceinline__ void store_d(bf16_t* p, f32x4 d) { u32x2 w; w.x = cvt_pk_bf16(d[0], d[1]); w.y = cvt_pk_bf16(d[2], d[3]); *(u32x2*)p = w; }
template <int W, int T> __device__ __forceinline__ void pool_rows(const f32x4* cur, const f32x4* old, int skip, int avail0, bf16_t* dd) {
    f32x4 u[T], o[W - 1];
#pragma unroll
    for (int k = 0; k < W - 1; ++k) o[k] = (k >= skip) ? old[(size_t)k * 256] : (f32x4){0.f, 0.f, 0.f, 0.f};
#pragma unroll
    for (int t = 0; t < T; ++t) u[t] = cur[(size_t)t * 256];
    f32x4 s = (f32x4){0.f, 0.f, 0.f, 0.f};
#pragma unroll
    for (int k = 0; k < W - 1; ++k) s += o[k];
#pragma unroll
    for (int t = 0; t < T; ++t) {
        s += u[t];
        const int av = avail0 + t + 1; const float inv = 1.0f / (float)(av < W ? av : W);
        store_d(dd + (size_t)t * WPOOL, s * inv - u[t]);
        if (t - (W - 1) >= 0) s -= u[t - (W - 1) >= 0 ? t - (W - 1) : 0]; else s -= o[t < W - 1 ? t : 0];
    }
}
__device__ __forceinline__ void pool_phase(const Frame& F) {
    const f32x4* UP4 = (const f32x4*)(F.ws + WS_UP); bf16_t* DD = (bf16_t*)(F.ws + WS_DD);
    const int half = F.tid >> 8, q = F.tid & 255, grp = __builtin_amdgcn_readfirstlane(q >> 6);
    constexpr int NPI = NBP * NCH  , NSI = NBS;
    for (int it = blockIdx.x * 2 + half; it < NPI + NSI; it += F.G * 2) {
        if (it < NPI) {
            const int b = it / NCH, ch = it - b * NCH, t0 = 16 * ch, rb = b * LP;
            const f32x4* cur = UP4 + (size_t)(rb + t0) * 256 + q; bf16_t* dd = DD + (size_t)(rb + t0) * WPOOL + 4 * q;
            if (grp == 0)      pool_rows<2, 16>(cur, cur - (size_t)1 * 256, 1 - t0 > 0 ? 1 - t0 : 0, t0, dd);
            else if (grp == 1) pool_rows<4, 16>(cur, cur - (size_t)3 * 256, 3 - t0 > 0 ? 3 - t0 : 0, t0, dd);
            else if (grp == 2) pool_rows<8, 16>(cur, cur - (size_t)7 * 256, 7 - t0 > 0 ? 7 - t0 : 0, t0, dd);
            else               pool_rows<16, 16>(cur, cur - (size_t)15 * 256, 15 - t0 > 0 ? 15 - t0 : 0, t0, dd);
        } else {
            const int bs = it - NPI, rs = MPR + 4 * bs; const f32x4* hist = (const f32x4*)F.a->in[2] + (size_t)bs * 15 * 256 + q;
            const f32x4* cur = UP4 + (size_t)rs * 256 + q; bf16_t* dd = DD + (size_t)rs * WPOOL + 4 * q;
            if (grp == 0)      pool_rows<2, 4>(cur, hist + (size_t)14 * 256, 0, 1 << 20, dd);
            else if (grp == 1) pool_rows<4, 4>(cur, hist + (size_t)12 * 256, 0, 1 << 20, dd);
            else if (grp == 2) pool_rows<8, 4>(cur, hist + (size_t)8 * 256, 0, 1 << 20, dd);
            else               pool_rows<16, 4>(cur, hist, 0, 1 << 20, dd);
        }
    }
    const int gt = blockIdx.x * 512 + F.tid, NT = F.G * 512;
    f32x4* pp = (f32x4*)(F.out + O_PP); f32x4* ps = (f32x4*)(F.out + O_PS);
    for (int i = gt; i < NBP * 15 * 256; i += NT) { const int c = i & 255, j = (i >> 8) % 15, b = i / (15 * 256); pp[i] = UP4[(size_t)(b * LP + LP - 15 + j) * 256 + c]; }
    for (int i = gt; i < NBS * 15 * 256; i += NT) { const int c = i & 255, j = (i >> 8) % 15, b = i / (15 * 256);
        ps[i] = (j < 11) ? ((const f32x4*)F.a->in[2])[((size_t)b * 15 + j + 4) * 256 + c] : UP4[(size_t)(MPR + 4 * b + j - 11) * 256 + c]; }
}


#define XB_TMO      128
#define XB_XCNT(j)  (256  + 64 * (j))
#define XB_XSUB(j)  (1280 + 64 * (j))
#define XB_XGEN(j)  (2304 + 64 * (j))
#define XB_TOP      3328
#define XB_TOPGEN   3392
#define XCD_BAR_WORDS 3456
#define XB_SPIN_CAP (1u << 20)
__device__ __forceinline__ unsigned xb_ld(unsigned* p)              { return __hip_atomic_load(p, __ATOMIC_RELAXED, __HIP_MEMORY_SCOPE_AGENT); }
__device__ __forceinline__ unsigned xb_add(unsigned* p, unsigned v) { return __hip_atomic_fetch_add(p, v, __ATOMIC_RELAXED, __HIP_MEMORY_SCOPE_AGENT); }
__device__ __forceinline__ unsigned xb_xcc_id() { return (unsigned)__builtin_amdgcn_s_getreg((3 << 11) | 20) & 0xFu; }
#define XB_SPIN(cond, bar) do { unsigned _sp = 0; while (cond) { __builtin_amdgcn_s_sleep(1); \
    if ((++_sp & 255u) == 0u) { if (xb_ld(&(bar)[XB_TMO])) break; if (_sp > XB_SPIN_CAP) { atomicAdd(&(bar)[XB_TMO], 1u); break; } } } } while (0)
__device__ __forceinline__ void xcd_barrier_complete(unsigned* bar, unsigned x, unsigned& nloc, unsigned& nx) {
    const unsigned G = gridDim.x;
    unsigned sum, cnt, mine, sp = 0u;
    for (;;) {
        sum = 0u; cnt = 0u; mine = 0u;
#pragma unroll
        for (unsigned j = 0; j < 16; ++j) { const unsigned c = xb_ld(&bar[XB_XCNT(j)]); sum += c; cnt += (c > 0u) ? 1u : 0u; mine = (j == x) ? c : mine; }
        if (sum == G) break;
        __builtin_amdgcn_s_sleep(1);
        if ((++sp & 255u) == 0u) { if (xb_ld(&bar[XB_TMO])) break; if (sp > XB_SPIN_CAP) { atomicAdd(&bar[XB_TMO], 1u); break; } }
    }
    nloc = mine > 0u ? mine : 1u; nx = cnt > 0u ? cnt : 1u;
}
__device__ __forceinline__ void xcd_barrier(unsigned* bar, volatile LAS unsigned* st) {
    asm volatile("s_waitcnt vmcnt(0)" ::: "memory");
    __syncthreads();
    if (threadIdx.x == 0) {
        __builtin_amdgcn_s_waitcnt(0);
        const unsigned x = xb_xcc_id();
        unsigned nloc = st[0], nx = st[1];
        if (nloc == 0u) { xcd_barrier_complete(bar, x, nloc, nx); st[0] = nloc; st[1] = nx; }
        const unsigned old = xb_add(&bar[XB_XSUB(x)], 1u);
        const unsigned gen = old / nloc;
        if (old + 1u == (gen + 1u) * nloc) {
            __builtin_amdgcn_fence(__ATOMIC_RELEASE, "agent");
            asm volatile("s_waitcnt vmcnt(0)" ::: "memory");
            const unsigned og = xb_add(&bar[XB_TOP], 1u);
            const unsigned tg = og / nx;
            if (og + 1u == (tg + 1u) * nx) xb_add(&bar[XB_TOPGEN], 1u);
            else XB_SPIN(xb_ld(&bar[XB_TOPGEN]) == tg, bar);
            __builtin_amdgcn_fence(__ATOMIC_ACQUIRE, "agent");
            xb_add(&bar[XB_XGEN(x)], 1u);
            asm volatile("s_waitcnt vmcnt(0)" ::: "memory");
        } else {
            XB_SPIN(xb_ld(&bar[XB_XGEN(x)]) == gen, bar);
            __builtin_amdgcn_fence(__ATOMIC_ACQUIRE, "agent");
            asm volatile("s_waitcnt vmcnt(0)" ::: "memory");
        }
    }
    __syncthreads();
}
constexpr int LDS_BARST = LDS_BYTES - 64;

constexpr int N_PHASES = 14;
#ifndef DBG_STOP
#define DBG_STOP 99
#endif
#ifndef DBG_SRC
#define DBG_SRC WS_UP
#endif

__device__ __forceinline__ Frame make_frame(LAS unsigned char* lds) {
    Frame F;
    ArgsP a = (ArgsP)__builtin_amdgcn_kernarg_segment_ptr(); asm volatile("" : "+s"(a));
    int t = threadIdx.x; asm volatile("" : "+v"(t));
    F.a = a; F.ws = a->ws; F.out = a->out; F.lds = lds;
    F.tid = t; F.lane = t & 63; F.wave = __builtin_amdgcn_readfirstlane(t >> 6); F.G = gridDim.x;
    F.gw = blockIdx.x * 8 + F.wave; F.NGW = F.G * 8;
    return F;
}
#define XN_(F) ((bf16_t*)((F).ws + WS_XN))
#define X_(F) ((float*)((F).ws + WS_X))
#define H_(F) ((bf16_t*)((F).ws + WS_H))
#define VCU_(F) (((F).G & 7) == 0 ? (int)((blockIdx.x & 7) * ((F).G >> 3) + (blockIdx.x >> 3)) : (int)blockIdx.x)
#define PB_(F) ((float*)((F).ws + WS_PB))
#define X0_(F) (X0Src{(F).a->in[5], (F).a->in[0], (F).a->in[1]})

__global__ void __launch_bounds__(512, 2) mk_fwd(Args args) {
    extern __shared__ __attribute__((aligned(16))) unsigned char lds_raw[];
    LAS unsigned char* const lds = (LAS unsigned char*)lds_raw;
    const int lo = args.ph_lo, hi = args.ph_hi;
    if (threadIdx.x < 2) ((volatile LAS unsigned*)(lds + LDS_BARST))[threadIdx.x] = 0u;
    if (threadIdx.x == 0) (void)xb_add((unsigned*)(args.ws + WS_CTL) + XB_XCNT(xb_xcc_id()), 1u);
    __syncthreads();
#define IN(k) (lo <= (k) && (k) < hi && ((k) < DBG_STOP || (k) == 13))
#define SEAM(k) do { if (lo <= (k) && (k) + 1 < hi) { if (hi > 1000) cg::this_grid().sync();   ArgsP a_ = (ArgsP)__builtin_amdgcn_kernarg_segment_ptr(); asm volatile("" : "+s"(a_)); xcd_barrier((unsigned*)(a_->ws + WS_CTL), (volatile LAS unsigned*)(lds + LDS_BARST)); } } while (0)

    if (IN(0)) { const Frame F = make_frame(lds);
        cvt_ffn(F, 7, F.gw, F.NGW);
        const X0Src x0 = X0_(F); bf16_t* XN = XN_(F);
        for (int r = F.gw; r < MP; r += F.NGW) { const float* xr = x0_row(x0, r); if (xr) rms_row(xr, F.a->in[6], XN + (size_t)r * D, nullptr, F.lane); else zero_row_bf16(XN + (size_t)r * D, F.lane); }
    }
    SEAM(0);
    if (IN(1)) { const Frame F = make_frame(lds);
        pg8::Gemm g{XN_(F), (const bf16_t*)(F.ws + WS_WGU), D, D, MP, 2 * FF, D, 0}; pg8::PadOrder S; S.init(2 * FF, D, F.G, blockIdx.x);
        pg8::EpiSwiGLU E{H_(F)}; pg8::gemm_phase(lds, g, S, E); }
    SEAM(1);
    if (IN(2)) { const Frame F = make_frame(lds);
        pg8::Gemm g{H_(F), (const bf16_t*)(F.ws + WS_WD), FF, FF, MP, D, FF, 0}; pg8::TailSplitOrder S; S.init(D, FF, F.G, blockIdx.x);
        pg8::EpiAdd<true> E{X0_(F), X_(F), PB_(F), 0.5f}; pg8::gemm_phase(lds, g, S, E);
        if (lo == 0) { const Frame F2 = make_frame(lds); const int nb = 24 * pg8::TS_NSPLIT;
            if ((int)blockIdx.x >= nb) cvt_mixer(F2, ((int)blockIdx.x - nb) * 8 + F2.wave, (F2.G - nb) * 8, 0, 3904); } }
    SEAM(2);
    if (IN(3)) { const Frame F = make_frame(lds); bf16_t* XN = XN_(F); float* X = X_(F); const float* PB = PB_(F);
        for (int r = F.gw; r < MP; r += F.NGW) { if (r < MV) {
                rms_row(X + (size_t)r * D, F.a->in[10], XN + (size_t)r * D, nullptr, F.lane, r >= pg8::TS_ROWS0 ? X + (size_t)r * D : nullptr, r >= pg8::TS_ROWS0 ? PB + (size_t)(r - pg8::TS_ROWS0) * D : nullptr, (size_t)(MP - pg8::TS_ROWS0) * D); }
            else zero_row_bf16(XN + (size_t)r * D, F.lane); } }
    SEAM(3);
    if (IN(4)) { const Frame F = make_frame(lds);
        pg8::Gemm g{XN_(F), (const bf16_t*)(F.ws + WS_WIN), D, D, MP, WIN, D, 0}; pg8::StaticOrder S; S.init(MP, WIN, F.G, blockIdx.x, D);
        pg8::EpiWin E{(float*)(F.ws + WS_UP), (float*)(F.ws + WS_US), (bf16_t*)(F.ws + WS_G), F.a->in[12]}; pg8::gemm_phase(lds, g, S, E);
        { const Frame F2 = make_frame(lds); const int nb = (MP / 256) * (WIN / 256) - 3 * F2.G;
          if ((int)blockIdx.x >= nb) { cvt_ffn(F2, 29, ((int)blockIdx.x - nb) * 8 + F2.wave, (F2.G - nb) * 8, 0, 4); cvt_ffn(F2, 29, ((int)blockIdx.x - nb) * 8 + F2.wave, (F2.G - nb) * 8, 1, 4); } } }
    SEAM(4);
    if (IN(5)) { __syncthreads();
        { const Frame F = make_frame(lds); s5_phase(F); }
        { const Frame F = make_frame(lds); pool_phase(F); }
        __syncthreads(); }
    SEAM(5);
    if (IN(6)) {
        { const Frame F = make_frame(lds);
          pg8::Gemm g{(const bf16_t*)(F.ws + WS_DD), (const bf16_t*)(F.ws + WS_PW), WPOOL, 256, MP, WPOOL, 256, 512}; pg8::StaticOrder S; S.init(MP, WPOOL, F.G, blockIdx.x, 256);
          pg8::EpiPool E{XN_(F), F.a->in[14]}; pg8::gemm_phase(lds, g, S, E); }
        { const Frame F = make_frame(lds);
          pg8::Gemm g{(const bf16_t*)(F.ws + WS_SG), (const bf16_t*)(F.ws + WS_GLU), WSSM, WSSM, MP, WSSM, WSSM, 0}; pg8::StaticOrder S; S.init(MP, WSSM, F.G, (blockIdx.x + F.G / 2) % F.G, WSSM);
          pg8::EpiGLU E{XN_(F), (const bf16_t*)(F.ws + WS_SG), F.a->in[24]}; pg8::gemm_phase(lds, g, S, E); }
    }
    SEAM(6);
    if (IN(7)) { const Frame F = make_frame(lds);
        pg8::Gemm g{XN_(F), (const bf16_t*)(F.ws + WS_WA), 2048, 1024, MP, D, 1024, 0}; pg8::StaticOrder S; S.init(MP, D, F.G, blockIdx.x, 1024);
        pg8::EpiBr1 E{(bf16_t*)(F.ws + WS_T1), (const bf16_t*)(F.ws + WS_G)}; pg8::gemm_phase(lds, g, S, E);
        { const Frame F2 = make_frame(lds); if ((int)blockIdx.x >= 24) { cvt_mixer(F2, ((int)blockIdx.x - 24) * 8 + F2.wave, (F2.G - 24) * 8, 3904, 4416);
              cvt_ffn(F2, 29, ((int)blockIdx.x - 24) * 8 + F2.wave, (F2.G - 24) * 8, 2, 4); } } }
    SEAM(7);
    if (IN(8)) { const Frame F = make_frame(lds);
        pg8::Gemm g{XN_(F) + 1024, (const bf16_t*)(F.ws + WS_WB), 2048, 1024, MP, D, 1024, 0}; pg8::StaticOrder S; S.init(MP, D, F.G, blockIdx.x, 1024);
        pg8::EpiBr2 E{(const bf16_t*)(F.ws + WS_T1), (const bf16_t*)(F.ws + WS_G), (bf16_t*)(F.ws + WS_MRG)}; pg8::gemm_phase(lds, g, S, E);
        { const Frame F2 = make_frame(lds); if ((int)blockIdx.x >= 24) { cvt_mixer(F2, ((int)blockIdx.x - 24) * 8 + F2.wave, (F2.G - 24) * 8, 4416, 5440);
              cvt_ffn(F2, 29, ((int)blockIdx.x - 24) * 8 + F2.wave, (F2.G - 24) * 8, 3, 4); } } }
    SEAM(8);
    if (IN(9)) { const Frame F = make_frame(lds);
        pg8::Gemm g{(const bf16_t*)(F.ws + WS_MRG), (const bf16_t*)(F.ws + WS_WOUT), D, D, MP, D, D, 0}; pg8::TailSplitOrder S; S.init(D, D, F.G, blockIdx.x);
        pg8::EpiAdd<false> E{X0_(F), X_(F), (float*)(F.ws + WS_DD), 1.0f};     pg8::gemm_phase(lds, g, S, E); }
    SEAM(9);
    if (IN(10)) { const Frame F = make_frame(lds); bf16_t* XN = XN_(F); float* X = X_(F); const float* PB = (const float*)(F.ws + WS_DD);
        for (int r = F.gw; r < MP; r += F.NGW) { if (r < MV) {
                rms_row(X + (size_t)r * D, F.a->in[28], XN + (size_t)r * D, nullptr, F.lane, r >= pg8::TS_ROWS0 ? X + (size_t)r * D : nullptr, r >= pg8::TS_ROWS0 ? PB + (size_t)(r - pg8::TS_ROWS0) * D : nullptr, (size_t)(MP - pg8::TS_ROWS0) * D); }
            else zero_row_bf16(XN + (size_t)r * D, F.lane); } }
    SEAM(10);
    if (IN(11)) { const Frame F = make_frame(lds);
        pg8::Gemm g{XN_(F), (const bf16_t*)(F.ws + WS_WGU), D, D, MP, 2 * FF, D, 0}; pg8::PadOrder S; S.init(2 * FF, D, F.G, blockIdx.x);
        pg8::EpiSwiGLU E{H_(F)}; pg8::gemm_phase(lds, g, S, E); }
    SEAM(11);
    if (IN(12)) { { const Frame F = make_frame(lds);
        pg8::Gemm g{H_(F), (const bf16_t*)(F.ws + WS_WD), FF, FF, MP, D, FF, 0}; pg8::TailSplitOrder S; S.init(D, FF, F.G, blockIdx.x, 1);
        pg8::EpiDownFinal E{X_(F), PB_(F), 0.5f, F.a->in[32], F.out, (unsigned*)(F.ws + WS_CTL + CTL_XBUF), (unsigned*)(F.ws + WS_CTL + CTL_CNT)}; pg8::gemm_phase(lds, g, S, E); }
      if ((int)blockIdx.x < 24 * pg8::TS_NSPLIT) { const Frame F = make_frame(lds);
        pg8::Gemm g{H_(F), (const bf16_t*)(F.ws + WS_WD), FF, FF, MP, D, FF, 0}; pg8::TailSplitOrder S; S.init(D, FF, F.G, blockIdx.x, 2);
        pg8::EpiAdd<false> E{X0_(F), X_(F), PB_(F), 0.5f}; pg8::gemm_phase(lds, g, S, E); } }
    SEAM(12);
    if (IN(13) && DBG_STOP < 99) { const Frame F = make_frame(lds);
        const f32x4* src = (const f32x4*)(F.ws + DBG_SRC); f32x4* dst = (f32x4*)F.out;
        for (size_t i = (size_t)blockIdx.x * 512 + F.tid; i < O_PP / 4; i += (size_t)F.G * 512) dst[i] = src[i];
    } else
    if (IN(13)) { const Frame F = make_frame(lds); const float* X = X_(F);
        for (int r = pg8::TS_ROWS0 + F.gw; r < MV; r += F.NGW) {
            float* o;
            if (r < MPR) { const int b = r / LP, t = r - b * LP; if (t < NMETA) continue; o = F.out + O_YP + ((size_t)b * SEQ + (t - NMETA)) * D; }
            else o = F.out + O_YS + (size_t)(r - MPR) * D;
            rms_row(X + (size_t)r * D, F.a->in[32], nullptr, o, F.lane, nullptr, r >= pg8::TS_ROWS0 ? PB_(F) + (size_t)(r - pg8::TS_ROWS0) * D : nullptr, (size_t)(MP - pg8::TS_ROWS0) * D);
        }
    }
#undef IN
#undef SEAM
}

extern "C" void kernel_launch(void* const* d_in, const int* in_sizes, int n_in, void* d_out, int out_size, void* d_ws, size_t ws_size, hipStream_t stream) {
    static int grid = 0;
    if (grid == 0) {
        if (n_in != 33 || ws_size < WS_END) { fprintf(stderr, "kernel_launch: expected 33 inputs and >= %zu bytes of workspace; got %d, %zu\n", (size_t)WS_END, n_in, ws_size); grid = -1; return; }
        int dev = 0, cus = 0, per_cu = 0;
        if (hipGetDevice(&dev) != hipSuccess || hipDeviceGetAttribute(&cus, hipDeviceAttributeMultiprocessorCount, dev) != hipSuccess) { grid = -1; return; }
        if (hipFuncSetAttribute((const void*)mk_fwd, hipFuncAttributeMaxDynamicSharedMemorySize, LDS_BYTES) != hipSuccess) { fprintf(stderr, "kernel_launch: hipFuncSetAttribute failed\n"); grid = -1; return; }
        if (hipOccupancyMaxActiveBlocksPerMultiprocessor(&per_cu, (const void*)mk_fwd, 512, LDS_BYTES) != hipSuccess || per_cu < 1) { fprintf(stderr, "kernel_launch: occupancy query says %d\n", per_cu); per_cu = 1; }
        (void)hipGetLastError();
        grid = cus * per_cu;
        if (grid > 256) grid = 256;
        if (grid != 256) fprintf(stderr, "kernel_launch: this kernel needs a 256-workgroup cooperative grid; got capacity %d\n", grid);
    }
    if (grid < 0) return;
    Args a{};
    for (int i = 0; i < 33; ++i) a.in[i] = (const float*)d_in[i];
    a.out = (float*)d_out; a.ws = (unsigned char*)d_ws;
#if MK_N_LAUNCHES == 1
    if (hipMemsetAsync((char*)d_ws + WS_CTL, 0, CTL_BYTES, stream) != hipSuccess) { fprintf(stderr, "kernel_launch: hipMemsetAsync failed\n"); return; }
    a.ph_lo = 0; a.ph_hi = N_PHASES;
    void* kargs[] = {&a};
    hipError_t e = hipLaunchCooperativeKernel((const void*)mk_fwd, dim3(grid), dim3(512), kargs, LDS_BYTES, stream);
    if (e != hipSuccess) fprintf(stderr, "kernel_launch: cooperative launch failed: %s (grid %d)\n", hipGetErrorString(e), grid);
#else
    for (int p = 0; p < N_PHASES; ++p) { a.ph_lo = p; a.ph_hi = p + 1; hipLaunchKernelGGL(mk_fwd, dim3(grid), dim3(512), LDS_BYTES, stream, a); }
#endif
}
```

```cpp
#include <hip/hip_runtime.h>
#include <hip/hip_cooperative_groups.h>
#include <cstdio>
#include <cstdint>
namespace cg = cooperative_groups;

#ifndef MK_N_LAUNCHES
#define MK_N_LAUNCHES 1
#endif

#define LAS __attribute__((address_space(3)))
typedef unsigned short bf16_t;
typedef short bf16x8 __attribute__((ext_vector_type(8)));
typedef float f32x4 __attribute__((ext_vector_type(4)));
typedef float f32x2 __attribute__((ext_vector_type(2)));
typedef unsigned u32x4 __attribute__((ext_vector_type(4)));
typedef unsigned u32x2 __attribute__((ext_vector_type(2)));

constexpr int D = 2048, FF = 5632, NBP = 4, SEQ = 2048, NMETA = 16, LP = SEQ + NMETA  , NBS = 128, LS = 4;
constexpr int MPR = NBP * LP  , MSA = NBS * LS  , MV = MPR + MSA  , MP = 8960  ;
constexpr int WPOOL = 1024, WSSM = 1024, NG = 64, NP = 64, GS = 16, WIN = 6144, NCH = LP / 16  ;
constexpr float RMS_EPS = 1e-6f;
constexpr float LOG2E = 1.4426950408889634f;

constexpr size_t O_YP = 0, O_YS = 16777216, O_PP = 17825792, O_PS = 17887232, O_RP = 19853312, O_IP = 19869696, O_RS = 19886080, O_IS = 20410368;

constexpr size_t MiB = 1u << 20;
constexpr size_t WS_WGU = 0;
constexpr size_t WS_WD = 44 * MiB;
constexpr size_t WS_WIN = 66 * MiB;
constexpr size_t WS_PW = 90 * MiB;
constexpr size_t WS_GLU = 91 * MiB;
constexpr size_t WS_WA = 93 * MiB;
constexpr size_t WS_WB = 97 * MiB;
constexpr size_t WS_WOUT = 101 * MiB;
constexpr size_t WS_XN = 110 * MiB;
constexpr size_t WS_X = 145 * MiB;
constexpr size_t WS_R = 215 * MiB;
constexpr size_t WS_H = WS_R;
constexpr size_t WS_UP = WS_R;
constexpr size_t WS_US = WS_R + 35 * MiB;
constexpr size_t WS_T1 = WS_R;
constexpr size_t WS_PB = WS_R + 100 * MiB;
constexpr size_t WS_G = WS_R + 70 * MiB;
constexpr size_t WS_DD = WS_R + 140 * MiB;
constexpr size_t WS_SG = WS_DD + 18 * MiB;
constexpr size_t WS_MRG = WS_SG + 18 * MiB;
constexpr size_t WS_CTL = WS_MRG + 35 * MiB;
constexpr size_t CTL_BYTES = 65536 + 3 * 262144;
constexpr size_t CTL_CNT = 16384, CTL_XBUF = 65536;
constexpr size_t WS_END = WS_CTL + CTL_BYTES;
static_assert((size_t)MP * 2048 * 2 <= 35 * MiB && (size_t)MP * 1024 * 2 <= 18 * MiB && (size_t)MP * FF * 2 <= 140 * MiB, "ws map");

constexpr int LDS_BYTES = 147456;

__device__ __forceinline__ unsigned f2bf(float f) { unsigned u = __builtin_bit_cast(unsigned, f); return (u + 0x7fffu + ((u >> 16) & 1u)) >> 16; }
__device__ __forceinline__ float bf2f(unsigned b) { return __builtin_bit_cast(float, b << 16); }
typedef __bf16 bf16x2v __attribute__((ext_vector_type(2)));
__device__ __forceinline__ unsigned cvt_pk_bf16(float lo, float hi) { const f32x2 v = {lo, hi}; const bf16x2v b = __builtin_convertvector(v, bf16x2v); return __builtin_bit_cast(unsigned, b); }
__device__ __forceinline__ u32x4 pack8(f32x4 a, f32x4 b) { u32x4 w; w.x = cvt_pk_bf16(a[0], a[1]); w.y = cvt_pk_bf16(a[2], a[3]); w.z = cvt_pk_bf16(b[0], b[1]); w.w = cvt_pk_bf16(b[2], b[3]); return w; }
__device__ __forceinline__ void unpack8(u32x4 w, f32x4& a, f32x4& b) {
    a[0] = __builtin_bit_cast(float, w.x << 16); a[1] = __builtin_bit_cast(float, w.x & 0xffff0000u); a[2] = __builtin_bit_cast(float, w.y << 16); a[3] = __builtin_bit_cast(float, w.y & 0xffff0000u);
    b[0] = __builtin_bit_cast(float, w.z << 16); b[1] = __builtin_bit_cast(float, w.z & 0xffff0000u); b[2] = __builtin_bit_cast(float, w.w << 16); b[3] = __builtin_bit_cast(float, w.w & 0xffff0000u); }
__device__ __forceinline__ float sigm(float x) { return __builtin_amdgcn_rcpf(1.0f + __builtin_amdgcn_exp2f(-LOG2E * x)); }
__device__ __forceinline__ f32x4 sigm4(f32x4 x) { f32x4 r; r[0] = sigm(x[0]); r[1] = sigm(x[1]); r[2] = sigm(x[2]); r[3] = sigm(x[3]); return r; }
__device__ __forceinline__ float gelu_tanh(float x) { const float z = 1.5957691216057308f * (x + 0.044715f * x * x * x); return x * sigm(z); }
__device__ __forceinline__ float wave_sum(float v) {
#pragma unroll
    for (int o = 1; o < 64; o <<= 1) v += __shfl_xor(v, o);
    return v;
}

struct X0Src { const float* meta; const float* xp; const float* xs; };
__device__ __forceinline__ const float* x0_row(const X0Src& s, int r) {
    if (r < MPR) { const int b = r / LP, t = r - b * LP; return t < NMETA ? s.meta + (size_t)t * D : s.xp + ((size_t)b * SEQ + (t - NMETA)) * D; }
    if (r < MV) return s.xs + (size_t)(r - MPR) * D;
    return nullptr;
}

namespace pg8 {
constexpr int BM = 256, BK = 64, HALF = 128, HTB = HALF * BK * 2, NXCD = 8, WGM = 8;
__host__ __device__ __forceinline__ int lds_byte(int r, int c) { const int st = (r >> 4) * 2 + (c >> 5), rr = r & 15, cc = c & 31, ob = rr * 64 + cc * 2; return st * 1024 + (ob ^ (((ob >> 9) & 1) << 5)); }
__host__ __device__ __forceinline__ void stage_rc(int b, int& R, int& C) { const int st = b / 1024, sb = b % 1024, swz = sb ^ (((sb >> 9) & 1) << 5); R = (st >> 1) * 16 + swz / 64; C = (st & 1) * 32 + (swz % 64) / 2; }
__host__ __device__ __forceinline__ int perm32(int rho) { const int n = rho >> 4, i = rho & 15; return 8 * (i >> 2) + 4 * n + (i & 3); }

struct Unit { int pm, pn, kt0, nkt, full; };
struct Gemm { const bf16_t* A; const bf16_t* Bt; int lda, ldb, M, N, K, a_pn_bytes; };

struct StaticOrder {
    int nM, nN, nwg, G, c, nkt;
    __device__ void init(int M, int N, int G_, int c_, int K = 0) { nM = M / BM; nN = N / BM; nwg = nM * nN; G = G_; c = c_; nkt = K / BK; }
    __device__ bool next(int i, Unit& u) const {
        const long L = (long)i * G + c; if (L >= nwg) return false;
        int wgid = (int)L; { const int q = nwg / NXCD, r = nwg % NXCD, xcd = wgid % NXCD, off = wgid / NXCD; wgid = (xcd < r ? xcd * (q + 1) : r * (q + 1) + (xcd - r) * q) + off; }
        const int nig = WGM * nN, gid = wgid / nig, fm = gid * WGM, gsz = (nM - fm) < WGM ? (nM - fm) : WGM;
        u.pm = fm + ((wgid % nig) % gsz); u.pn = (wgid % nig) / gsz; u.kt0 = 0; u.nkt = nkt; u.full = 1; return true;
    }
};
struct PadOrder {
    StaticOrder so; int c, nN, nkt;
    __device__ void init(int N, int K, int G, int c_) { so.init((MP / BM - 1) * BM, N, G, c_, K); c = c_; nN = N / BM; nkt = K / BK; }
    __device__ bool next(int i, Unit& u) const {
        if (so.next(i, u)) return true;
        const int n0 = so.nwg / so.G, rem = so.nwg - n0 * so.G;
        if (i < n0 || c < rem) return false;
        const int f = (i - n0) * (so.G - rem) + (c - rem); if (f >= nN) return false;
        u.pm = MP / BM - 1; u.pn = f; u.kt0 = 0; u.nkt = nkt; u.full = 1; return true;
    }
};
constexpr int TS_ROWS0 = 8192, TS_NSPLIT = 4;
struct TailSplitOrder {
    StaticOrder so; int c, nkt, mode;
    __device__ void init(int N, int K, int G, int c_, int mode_ = 0) { so.init(TS_ROWS0, N, G, c_, K); c = c_; nkt = K / BK; mode = mode_; }
    __device__ bool next(int i, Unit& u) const {
        if (mode == 2) ++i;
        if (i == 0) return so.next(0, u);
        if (i > 1 || mode == 1 || c >= 24 * TS_NSPLIT) return false;
        const int t = c / TS_NSPLIT, kq = c % TS_NSPLIT;
        u.pm = TS_ROWS0 / BM + (t >> 3); u.pn = t & 7; u.nkt = nkt / TS_NSPLIT; u.kt0 = kq * u.nkt; u.full = 0; return true;
    }
};

template <class Epi, class Order>
__device__ __forceinline__ void gemm_phase(LAS unsigned char* lds, const Gemm g, const Order& S, const Epi& E) {
    int tid_ = threadIdx.x; asm volatile("" : "+v"(tid_));
    const int tid = tid_, wid = __builtin_amdgcn_readfirstlane(tid >> 6), lane = tid & 63, wr = wid >> 2, wc = wid & 3, fr = lane & 15, fq = lane >> 4;
    unsigned voffA[2], voffB[2];
#pragma unroll
    for (int i = 0; i < 2; ++i) { int R, C; stage_rc(tid * 16 + i * 8192, R, C); const int Rb = (R & ~31) + perm32(R & 31);
        voffA[i] = (unsigned)(R * g.lda + C) * 2u; voffB[i] = (unsigned)(Rb * g.ldb + C) * 2u; }
    const size_t kstep = (size_t)(BK * 2);
    const size_t hstepA = (size_t)HALF * g.lda * 2, hstepB = (size_t)HALF * g.ldb * 2;
    const size_t tstepA = 2 * hstepA, tstepB = 2 * hstepB;
    const unsigned ldsw = (unsigned)wid * 1024u;
    const int aoff = lds_byte(wr * 64 + fr, fq * 8), boff = lds_byte(wc * 32 + fr, fq * 8);
#define PG8_SA(b, h) (((b) * 2 + (h)) * HTB)
#define PG8_SB(b, h) ((4 + (b) * 2 + (h)) * HTB)
#define PG8_STAGE(bufoff, gbase, voff) do { _Pragma("unroll") for (int _i = 0; _i < 2; ++_i) \
        __builtin_amdgcn_global_load_lds((const unsigned*)((const char*)(gbase) + (voff)[_i]), (LAS unsigned*)(lds + (bufoff) + ldsw + _i * 8192), 16, 0, 0); } while (0)
#define PG8_LDA(dst, b, h) do { _Pragma("unroll") for (int m = 0; m < 4; ++m) _Pragma("unroll") for (int k = 0; k < 2; ++k) dst[m][k] = *(const LAS bf16x8*)(lds + PG8_SA(b, h) + aoff + m * 2048 + k * 1024); } while (0)
#define PG8_LDB(dst, b, h) do { _Pragma("unroll") for (int n = 0; n < 2; ++n) _Pragma("unroll") for (int k = 0; k < 2; ++k) dst[n][k] = *(const LAS bf16x8*)(lds + PG8_SB(b, h) + boff + n * 2048 + k * 1024); } while (0)
#define PG8_MMA(ai, bj, At, Bt) do { __builtin_amdgcn_s_setprio(1); _Pragma("unroll") for (int m = 0; m < 4; ++m) _Pragma("unroll") for (int n = 0; n < 2; ++n) _Pragma("unroll") for (int k = 0; k < 2; ++k) \
        acc[ai][bj][m][n] = __builtin_amdgcn_mfma_f32_16x16x32_bf16(Bt[n][k], At[m][k], acc[ai][bj][m][n], 0, 0, 0); __builtin_amdgcn_s_setprio(0); } while (0)
#define PG8_WAIT_V(n) asm volatile("s_waitcnt vmcnt(" #n ")" ::: "memory")
#define PG8_WAIT_L(n) asm volatile("s_waitcnt lgkmcnt(" #n ")" ::: "memory")
#define PG8_BAR __builtin_amdgcn_s_barrier()
#define PG8_SCHED __builtin_amdgcn_sched_barrier(0)
    Unit cur, nxt; int ui = 0;
    if (!S.next(0, cur)) return;
    f32x4 acc[2][2][4][2];
#pragma unroll
    for (int a = 0; a < 2; ++a)
#pragma unroll
        for (int b = 0; b < 2; ++b)
#pragma unroll
            for (int m = 0; m < 4; ++m)
#pragma unroll
                for (int n = 0; n < 2; ++n) acc[a][b][m][n] = (f32x4){0.f, 0.f, 0.f, 0.f};
    bf16x8 At[4][2], B0[2][2], B1[2][2];
    const char* cA = (const char*)g.A + (size_t)cur.pm * tstepA + (size_t)cur.pn * g.a_pn_bytes + (size_t)cur.kt0 * kstep; const char* cB = (const char*)g.Bt + (size_t)cur.pn * tstepB + (size_t)cur.kt0 * kstep;
    PG8_STAGE(PG8_SB(0, 0), cB, voffB); PG8_STAGE(PG8_SB(0, 1), cB + hstepB, voffB); PG8_STAGE(PG8_SA(0, 0), cA, voffA); PG8_STAGE(PG8_SA(0, 1), cA + hstepA, voffA);
    if (wr == 1) PG8_BAR;
    PG8_WAIT_V(2); PG8_BAR;
    PG8_STAGE(PG8_SB(1, 0), cB + kstep, voffB); PG8_STAGE(PG8_SA(1, 0), cA + kstep, voffA); PG8_STAGE(PG8_SB(1, 1), cB + hstepB + kstep, voffB);
    PG8_WAIT_V(6); PG8_BAR;
    for (;;) {
        const bool has_next = S.next(ui + 1, nxt);
        const char* nA = has_next ? (const char*)g.A + (size_t)nxt.pm * tstepA + (size_t)nxt.pn * g.a_pn_bytes + (size_t)nxt.kt0 * kstep : cA; const char* nB = has_next ? (const char*)g.Bt + (size_t)nxt.pn * tstepB + (size_t)nxt.kt0 * kstep : cB;
        const int nt = cur.nkt;
        const int row_w = __builtin_amdgcn_readfirstlane(cur.pm) * BM + wr * 64;
        const bool do0 = row_w < MV, do1 = row_w + HALF < MV;
        if (do0 && do1) {
        for (int t = 0; t < nt; t += 2) {
            const bool last = (t == nt - 2);
            const char* a1 = cA + (size_t)(t + 1) * kstep;
            const char* a2 = last ? nA : cA + (size_t)(t + 2) * kstep; const char* b2 = last ? nB : cB + (size_t)(t + 2) * kstep;
            const char* a3 = a2 + kstep; const char* b3 = b2 + kstep;
            PG8_LDB(B0, 0, 0); PG8_LDB(B1, 0, 1); PG8_SCHED; PG8_LDA(At, 0, 0); PG8_STAGE(PG8_SA(1, 1), a1 + hstepA, voffA);
            PG8_WAIT_V(8); PG8_WAIT_L(0); PG8_BAR; { PG8_MMA(0, 0, At, B0); PG8_MMA(0, 1, At, B1); } PG8_BAR; PG8_SCHED;
            PG8_LDA(At, 0, 1); PG8_STAGE(PG8_SB(0, 0), b2, voffB); PG8_STAGE(PG8_SB(0, 1), b2 + hstepB, voffB); PG8_STAGE(PG8_SA(0, 0), a2, voffA);
            PG8_WAIT_V(8); PG8_WAIT_L(0); PG8_BAR; { PG8_MMA(1, 0, At, B0); PG8_MMA(1, 1, At, B1); } PG8_BAR; PG8_SCHED;
            PG8_LDB(B0, 1, 0); PG8_LDB(B1, 1, 1); PG8_SCHED; PG8_LDA(At, 1, 0); PG8_STAGE(PG8_SA(0, 1), a2 + hstepA, voffA);
            PG8_WAIT_V(8); PG8_WAIT_L(0); PG8_BAR; { PG8_MMA(0, 0, At, B0); PG8_MMA(0, 1, At, B1); } PG8_BAR; PG8_SCHED;
            PG8_LDA(At, 1, 1); PG8_STAGE(PG8_SB(1, 0), b3, voffB); PG8_STAGE(PG8_SB(1, 1), b3 + hstepB, voffB); PG8_STAGE(PG8_SA(1, 0), a3, voffA);
            PG8_WAIT_V(8); PG8_WAIT_L(0); PG8_BAR; { PG8_MMA(1, 0, At, B0); PG8_MMA(1, 1, At, B1); } PG8_BAR; PG8_SCHED;
        }
        } else {
        for (int t = 0; t < nt; t += 2) {
            const bool last = (t == nt - 2);
            const char* a1 = cA + (size_t)(t + 1) * kstep;
            const char* a2 = last ? nA : cA + (size_t)(t + 2) * kstep; const char* b2 = last ? nB : cB + (size_t)(t + 2) * kstep;
            const char* a3 = a2 + kstep; const char* b3 = b2 + kstep;
            PG8_LDB(B0, 0, 0); PG8_LDB(B1, 0, 1); PG8_SCHED; PG8_LDA(At, 0, 0); PG8_STAGE(PG8_SA(1, 1), a1 + hstepA, voffA);
            PG8_WAIT_V(8); PG8_WAIT_L(0); PG8_BAR; if (do0) { PG8_MMA(0, 0, At, B0); PG8_MMA(0, 1, At, B1); } PG8_BAR; PG8_SCHED;
            PG8_LDA(At, 0, 1); PG8_STAGE(PG8_SB(0, 0), b2, voffB); PG8_STAGE(PG8_SB(0, 1), b2 + hstepB, voffB); PG8_STAGE(PG8_SA(0, 0), a2, voffA);
            PG8_WAIT_V(8); PG8_WAIT_L(0); PG8_BAR; if (do1) { PG8_MMA(1, 0, At, B0); PG8_MMA(1, 1, At, B1); } PG8_BAR; PG8_SCHED;
            PG8_LDB(B0, 1, 0); PG8_LDB(B1, 1, 1); PG8_SCHED; PG8_LDA(At, 1, 0); PG8_STAGE(PG8_SA(0, 1), a2 + hstepA, voffA);
            PG8_WAIT_V(8); PG8_WAIT_L(0); PG8_BAR; if (do0) { PG8_MMA(0, 0, At, B0); PG8_MMA(0, 1, At, B1); } PG8_BAR; PG8_SCHED;
            PG8_LDA(At, 1, 1); PG8_STAGE(PG8_SB(1, 0), b3, voffB); PG8_STAGE(PG8_SB(1, 1), b3 + hstepB, voffB); PG8_STAGE(PG8_SA(1, 0), a3, voffA);
            PG8_WAIT_V(8); PG8_WAIT_L(0); PG8_BAR; if (do1) { PG8_MMA(1, 0, At, B0); PG8_MMA(1, 1, At, B1); } PG8_BAR; PG8_SCHED;
        }
        }
        if (wr == 0) PG8_BAR;
        if constexpr (Epi::FUSED) E.fused(acc, cur, wr, wc, fr, fq, lds, wid, lane); else E(acc, cur, wr, wc, fr, fq);
        if (!has_next) break;
#pragma unroll
        for (int a = 0; a < 2; ++a)
#pragma unroll
            for (int b = 0; b < 2; ++b)
#pragma unroll
                for (int m = 0; m < 4; ++m)
#pragma unroll
                    for (int n = 0; n < 2; ++n) acc[a][b][m][n] = (f32x4){0.f, 0.f, 0.f, 0.f};
        cur = nxt; cA = nA; cB = nB; ++ui;
        if (wr == 1) PG8_BAR;
    }
    PG8_WAIT_V(0);
    PG8_BAR;
#undef PG8_SA
#undef PG8_SB
#undef PG8_STAGE
#undef PG8_LDA
#undef PG8_LDB
#undef PG8_MMA
#undef PG8_WAIT_V
#undef PG8_WAIT_L
#undef PG8_BAR
#undef PG8_SCHED
}

typedef const f32x4 (&AccRef)[2][2][4][2];
#define EPI_ROWS(...) _Pragma("unroll") for (int ai = 0; ai < 2; ++ai) _Pragma("unroll") for (int m = 0; m < 4; ++m) { const int r = u.pm * BM + ai * HALF + wr * 64 + m * 16 + fr; __VA_ARGS__; asm volatile("" ::: "memory"); }

struct EpiSwiGLU { static constexpr bool FUSED = false;
    bf16_t* H;
    __device__ __forceinline__ void operator()(AccRef acc, const Unit& u, int wr, int wc, int fr, int fq) const {
        const int col0 = u.pn * 128 + wc * 32 + 8 * fq;
        EPI_ROWS({
            const f32x4 g0 = acc[ai][0][m][0], g1 = acc[ai][0][m][1];
            const f32x4 v0 = g0 * sigm4(g0) * acc[ai][1][m][0], v1 = g1 * sigm4(g1) * acc[ai][1][m][1];
            *(u32x4*)(H + (size_t)r * FF + col0) = pack8(v0, v1);
        })
    }
};
template <bool X0> struct EpiAdd { static constexpr bool FUSED = false;
    X0Src src; float* out; float* pb; float scale;
    __device__ __forceinline__ void operator()(AccRef acc, const Unit& u, int wr, int wc, int fr, int fq) const {
        const int col0 = u.pn * BM + wc * 32 + 8 * fq;
        if (u.kt0 == 0) {
            EPI_ROWS({
                float* op = out + (size_t)r * D + col0; const float* bp = X0 ? x0_row(src, r) : out + (size_t)r * D;
                _Pragma("unroll") for (int bj = 0; bj < 2; ++bj) {
                    f32x4 b0 = (f32x4){0.f, 0.f, 0.f, 0.f}, b1 = b0;
                    if (!X0 || bp) { b0 = *(const f32x4*)(bp + col0 + bj * HALF); b1 = *(const f32x4*)(bp + col0 + bj * HALF + 4); }
                    *(f32x4*)(op + bj * HALF) = b0 + scale * acc[ai][bj][m][0]; *(f32x4*)(op + bj * HALF + 4) = b1 + scale * acc[ai][bj][m][1]; }
            })
        } else {
            float* pbq = pb + (size_t)(u.kt0 / u.nkt - 1) * ((size_t)(MP - TS_ROWS0) * D) - (size_t)TS_ROWS0 * D;
            EPI_ROWS({
                float* op = pbq + (size_t)r * D + col0;
                _Pragma("unroll") for (int bj = 0; bj < 2; ++bj) { *(f32x4*)(op + bj * HALF) = scale * acc[ai][bj][m][0]; *(f32x4*)(op + bj * HALF + 4) = scale * acc[ai][bj][m][1]; }
            })
        }
    }
};
template <int MODE  , bool X0> struct EpiDownFinal { static constexpr bool FUSED = true;
    X0Src src; float* X; float scale; const float* gain; float* out; bf16_t* XN; unsigned* xbuf; unsigned* cnt;
    __device__ __forceinline__ void fused(f32x4 (&acc)[2][2][4][2], const Unit& u, int wr, int wc, int fr, int fq, LAS unsigned char* lds, int wid, int lane) const {
        const int col0 = u.pn * BM + wc * 32 + 8 * fq;
        int c1 = col0, pm1 = u.pm, rb1 = wr * 64 + fr, wc1 = wc; asm volatile("" : "+v"(c1), "+s"(pm1), "+v"(rb1), "+v"(wc1));
        LAS float* P = (LAS float*)(lds + 131072);
        LAS float* S = (LAS float*)(lds + 131072 + 4096);
#pragma unroll
        for (int ai = 0; ai < 2; ++ai)
#pragma unroll
            for (int m = 0; m < 4; ++m) { const int r = pm1 * BM + ai * HALF + m * 16 + rb1; const float* xp = (X0 ? x0_row(src, r) : X + (size_t)r * D) + c1; float* xo = X + (size_t)r * D + c1; float q = 0.f;
#pragma unroll
                for (int bj = 0; bj < 2; ++bj)
#pragma unroll
                    for (int n = 0; n < 2; ++n) { const f32x4 b = *(const f32x4*)(xp + bj * HALF + 4 * n); const f32x4 v = b + scale * acc[ai][bj][m][n]; acc[ai][bj][m][n] = v;
                        if (MODE == 1) *(f32x4*)(xo + bj * HALF + 4 * n) = v;
                        q += (v[0] * v[0] + v[1] * v[1]) + (v[2] * v[2] + v[3] * v[3]); }
                q += __shfl_xor(q, 16); q += __shfl_xor(q, 32);
                if (fq == 0) P[(ai * HALF + m * 16 + rb1) * 4 + wc1] = q;
                asm volatile("" ::: "memory"); }
        asm volatile("s_waitcnt lgkmcnt(0)" ::: "memory"); __builtin_amdgcn_s_barrier(); asm volatile("" ::: "memory");
        int row = wid * 32 + (lane & 31); asm volatile("" : "+v"(row));
        if (lane < 32) { const float t = (P[row * 4 + 0] + P[row * 4 + 1]) + (P[row * 4 + 2] + P[row * 4 + 3]);
            __hip_atomic_store(xbuf + ((size_t)(u.pm * BM + row) * 8 + u.pn), __builtin_bit_cast(unsigned, t), __ATOMIC_RELAXED, __HIP_MEMORY_SCOPE_AGENT); }
        asm volatile("s_waitcnt vmcnt(0)" ::: "memory");
        if (lane == 0) (void)__hip_atomic_fetch_add(cnt + 64 * u.pm, 1u, __ATOMIC_RELAXED, __HIP_MEMORY_SCOPE_AGENT);
        if (wid == 0) { unsigned sp = 0;
            _Pragma("unroll 1") while ((unsigned)__builtin_amdgcn_readfirstlane(__hip_atomic_load(cnt + 64 * u.pm, __ATOMIC_RELAXED, __HIP_MEMORY_SCOPE_AGENT)) < 64u) { __builtin_amdgcn_s_sleep(2); if (++sp > (1u << 22)) break; }
            __builtin_amdgcn_fence(__ATOMIC_ACQUIRE, "agent"); }
        asm volatile("s_waitcnt vmcnt(0) lgkmcnt(0)" ::: "memory"); __builtin_amdgcn_s_barrier(); asm volatile("" ::: "memory");
        if (lane < 32) { const unsigned* sl = xbuf + (size_t)(u.pm * BM + row) * 8; float t = 0.f;
#pragma unroll
            for (int k = 0; k < 8; ++k) t += __builtin_bit_cast(float, __hip_atomic_load(sl + k, __ATOMIC_RELAXED, __HIP_MEMORY_SCOPE_AGENT));
            S[row] = 1.0f / sqrtf(t * (1.0f / D) + RMS_EPS); }
        asm volatile("s_waitcnt vmcnt(0) lgkmcnt(0)" ::: "memory"); __builtin_amdgcn_s_barrier(); asm volatile("" ::: "memory");
        int c5 = col0, pm5 = u.pm, rb5 = wr * 64 + fr; asm volatile("" : "+v"(c5), "+s"(pm5), "+v"(rb5));
        const int b0 = (pm5 * BM) / LP, t0 = pm5 * BM - b0 * LP;
#pragma unroll
        for (int ai = 0; ai < 2; ++ai)
#pragma unroll
            for (int m = 0; m < 4; ++m) { const int rl = ai * HALF + m * 16 + rb5; const float rs = S[rl];
                if (MODE == 0) { int t = t0 + rl, b = b0; if (t >= LP) { t -= LP; ++b; }
                    if (t >= NMETA) { float* op = out + O_YP + ((size_t)b * SEQ + (t - NMETA)) * D + c5;
#pragma unroll
                        for (int bj = 0; bj < 2; ++bj) { const f32x4 g0 = *(const f32x4*)(gain + c5 + bj * HALF), g1 = *(const f32x4*)(gain + c5 + bj * HALF + 4);
                            *(f32x4*)(op + bj * HALF) = acc[ai][bj][m][0] * rs * g0; *(f32x4*)(op + bj * HALF + 4) = acc[ai][bj][m][1] * rs * g1; } } }
                else { bf16_t* op = XN + (size_t)(pm5 * BM + rl) * D + c5;
#pragma unroll
                    for (int bj = 0; bj < 2; ++bj) { const f32x4 g0 = *(const f32x4*)(gain + c5 + bj * HALF), g1 = *(const f32x4*)(gain + c5 + bj * HALF + 4);
                        *(u32x4*)(op + bj * HALF) = pack8(acc[ai][bj][m][0] * rs * g0, acc[ai][bj][m][1] * rs * g1); } }
                asm volatile("" ::: "memory"); }
    }
};
struct EpiWin { static constexpr bool FUSED = false;
    float* UP; float* US; bf16_t* G; const float* bg;
    __device__ __forceinline__ void operator()(AccRef acc, const Unit& u, int wr, int wc, int fr, int fq) const {
        if (u.pn < 8) {
            float* O = (u.pn < 4 ? UP : US); const int col0 = (u.pn & 3) * BM + wc * 32 + 8 * fq;
            EPI_ROWS({
                float* op = O + (size_t)r * 1024 + col0;
                _Pragma("unroll") for (int bj = 0; bj < 2; ++bj) { *(f32x4*)(op + bj * HALF) = acc[ai][bj][m][0]; *(f32x4*)(op + bj * HALF + 4) = acc[ai][bj][m][1]; }
            })
        } else {
            const int col0 = (u.pn - 8) * BM + wc * 32 + 8 * fq;
            f32x4 bv[2][2];
#pragma unroll
            for (int bj = 0; bj < 2; ++bj) { bv[bj][0] = *(const f32x4*)(bg + col0 + bj * HALF); bv[bj][1] = *(const f32x4*)(bg + col0 + bj * HALF + 4); }
            EPI_ROWS({
                bf16_t* op = G + (size_t)r * 4096 + col0;
                _Pragma("unroll") for (int bj = 0; bj < 2; ++bj) *(u32x4*)(op + bj * HALF) = pack8(sigm4(acc[ai][bj][m][0] + bv[bj][0]), sigm4(acc[ai][bj][m][1] + bv[bj][1]));
            })
        }
    }
};
struct EpiPool { static constexpr bool FUSED = false;
    bf16_t* AB; const float* sc;
    __device__ __forceinline__ void operator()(AccRef acc, const Unit& u, int wr, int wc, int fr, int fq) const {
        const int col0 = u.pn * BM + wc * 32 + 8 * fq;
        f32x4 sv[2][2];
#pragma unroll
        for (int bj = 0; bj < 2; ++bj) { sv[bj][0] = *(const f32x4*)(sc + col0 + bj * HALF); sv[bj][1] = *(const f32x4*)(sc + col0 + bj * HALF + 4); }
        EPI_ROWS({
            bf16_t* op = AB + (size_t)r * 2048 + col0;
            _Pragma("unroll") for (int bj = 0; bj < 2; ++bj) *(u32x4*)(op + bj * HALF) = pack8(acc[ai][bj][m][0] * sv[bj][0], acc[ai][bj][m][1] * sv[bj][1]);
        })
    }
};
struct EpiGLU { static constexpr bool FUSED = false;
    bf16_t* AB; const bf16_t* SG; const float* gb;
    __device__ __forceinline__ void operator()(AccRef acc, const Unit& u, int wr, int wc, int fr, int fq) const {
        const int col0 = u.pn * BM + wc * 32 + 8 * fq;
        f32x4 bv[2][2];
#pragma unroll
        for (int bj = 0; bj < 2; ++bj) { bv[bj][0] = *(const f32x4*)(gb + col0 + bj * HALF); bv[bj][1] = *(const f32x4*)(gb + col0 + bj * HALF + 4); }
        EPI_ROWS({
            bf16_t* op = AB + (size_t)r * 2048 + 1024 + col0; const bf16_t* sp = SG + (size_t)r * 1024 + col0;
            _Pragma("unroll") for (int bj = 0; bj < 2; ++bj) { f32x4 s0, s1; unpack8(*(const u32x4*)(sp + bj * HALF), s0, s1);
                *(u32x4*)(op + bj * HALF) = pack8(s0 * sigm4(acc[ai][bj][m][0] + bv[bj][0]), s1 * sigm4(acc[ai][bj][m][1] + bv[bj][1])); }
        })
    }
};
struct EpiBr1 { static constexpr bool FUSED = false;
    bf16_t* T1; const bf16_t* G;
    __device__ __forceinline__ void operator()(AccRef acc, const Unit& u, int wr, int wc, int fr, int fq) const {
        const int col0 = u.pn * BM + wc * 32 + 8 * fq;
        EPI_ROWS({
            bf16_t* op = T1 + (size_t)r * 2048 + col0; const bf16_t* gp = G + (size_t)r * 4096 + col0;
            _Pragma("unroll") for (int bj = 0; bj < 2; ++bj) { f32x4 g0, g1; unpack8(*(const u32x4*)(gp + bj * HALF), g0, g1);
                *(u32x4*)(op + bj * HALF) = pack8(g0 * acc[ai][bj][m][0], g1 * acc[ai][bj][m][1]); }
        })
    }
};
struct EpiBr2 { static constexpr bool FUSED = false;
    const bf16_t* T1; const bf16_t* G; bf16_t* MRG;
    __device__ __forceinline__ void operator()(AccRef acc, const Unit& u, int wr, int wc, int fr, int fq) const {
        const int col0 = u.pn * BM + wc * 32 + 8 * fq;
        EPI_ROWS({
            const bf16_t* tp = T1 + (size_t)r * 2048 + col0; const bf16_t* gp = G + (size_t)r * 4096 + 2048 + col0; bf16_t* op = MRG + (size_t)r * 2048 + col0;
            _Pragma("unroll") for (int bj = 0; bj < 2; ++bj) { f32x4 g0, g1; unpack8(*(const u32x4*)(gp + bj * HALF), g0, g1);
                f32x4 t0, t1; unpack8(*(const u32x4*)(tp + bj * HALF), t0, t1);
                *(u32x4*)(op + bj * HALF) = pack8(t0 + g0 * acc[ai][bj][m][0], t1 + g1 * acc[ai][bj][m][1]); }
        })
    }
};
}

__device__ __forceinline__ void cvt_item(const float* W, int K, int N, bf16_t* WT, int mode, int item, int lane) {
    const int nblk = N >> 6, kb = item / nblk, nb = item - kb * nblk, k0 = kb << 6, n0 = nb << 6;
    const int rg = lane >> 4, nq = lane & 15;
    const float* src = W + (size_t)(k0 + 16 * rg) * N + n0 + 4 * nq;
    f32x4 v[16];
#pragma unroll
    for (int i = 0; i < 16; ++i) v[i] = *(const f32x4*)(src + (size_t)i * N);
    const int drow0 = (mode == 0 ? n0 : ((n0 >> 7) * 256 + (mode == 2 ? 128 : 0) + (n0 & 127))) + 4 * nq;
    bf16_t* dst = WT + (size_t)drow0 * K + k0 + 16 * rg;
#pragma unroll
    for (int j = 0; j < 4; ++j)
#pragma unroll
        for (int h = 0; h < 2; ++h) {
            u32x4 w; w.x = cvt_pk_bf16(v[8 * h + 0][j], v[8 * h + 1][j]); w.y = cvt_pk_bf16(v[8 * h + 2][j], v[8 * h + 3][j]);
            w.z = cvt_pk_bf16(v[8 * h + 4][j], v[8 * h + 5][j]); w.w = cvt_pk_bf16(v[8 * h + 6][j], v[8 * h + 7][j]);
            *(u32x4*)(dst + (size_t)j * K + 8 * h) = w; }
}
struct Args { const float* in[33]; float* out; unsigned char* ws; int ph_lo, ph_hi; };
typedef const __attribute__((address_space(4))) Args* ArgsP;
struct Frame {
    ArgsP a; unsigned char* ws; float* out;
    LAS unsigned char* lds; int tid, lane, wave, G, gw, NGW;
};
__device__ __forceinline__ void cvt_ffn(const Frame& F, int i0, int w0, int nw, int part = 0, int nparts = 1) {
    constexpr int IG = (D / 64) * (FF / 64);
    bf16_t* wgu = (bf16_t*)(F.ws + WS_WGU); bf16_t* wd = (bf16_t*)(F.ws + WS_WD);
    const int ib = (int)((long)part * (3 * IG) / nparts), ie = (int)((long)(part + 1) * (3 * IG) / nparts);
    for (int it = ib + w0; it < ie; it += nw) {
        if (it < IG) cvt_item(F.a->in[i0], D, FF, wgu, 1, it, F.lane);
        else if (it < 2 * IG) cvt_item(F.a->in[i0 + 1], D, FF, wgu, 2, it - IG, F.lane);
        else cvt_item(F.a->in[i0 + 2], FF, D, wd, 0, it - 2 * IG, F.lane);
    }
}
__device__ __forceinline__ void cvt_mixer(const Frame& F, int w0, int nw, int it0, int it1) {
    constexpr int I_IN = (D / 64) * (WIN / 64)  , I_PW = 4 * 16, I_GLU = 256, I_A = 16 * 32, I_O = 32 * 32;
    constexpr int TOT = I_IN + I_PW + I_GLU + 2 * I_A + I_O;
    static_assert(TOT == 5440, "mixer conversion items");
    for (int it = it0 + w0; it < it1; it += nw) {
        int r = it;
        if (r < I_IN) { cvt_item(F.a->in[11], D, WIN, (bf16_t*)(F.ws + WS_WIN), 0, r, F.lane); continue; } r -= I_IN;
        if (r < I_PW) { const int g = r >> 4; cvt_item(F.a->in[13] + (size_t)g * 65536, 256, 256, (bf16_t*)(F.ws + WS_PW) + (size_t)g * 65536, 0, r & 15, F.lane); continue; } r -= I_PW;
        if (r < I_GLU) { cvt_item(F.a->in[23], 1024, 1024, (bf16_t*)(F.ws + WS_GLU), 0, r, F.lane); continue; } r -= I_GLU;
        if (r < I_A) { cvt_item(F.a->in[25], 1024, 2048, (bf16_t*)(F.ws + WS_WA), 0, r, F.lane); continue; } r -= I_A;
        if (r < I_A) { cvt_item(F.a->in[26], 1024, 2048, (bf16_t*)(F.ws + WS_WB), 0, r, F.lane); continue; } r -= I_A;
        cvt_item(F.a->in[27], 2048, 2048, (bf16_t*)(F.ws + WS_WOUT), 0, r, F.lane);
    }
}

__device__ __forceinline__ void rms_row(const float* xrow, const float* gain, bf16_t* orow, float* frow, int lane, float* copy = nullptr, const float* pbrow = nullptr, size_t pbstride = 0) {
    f32x4 v[8]; float s = 0.f;
#pragma unroll
    for (int j = 0; j < 8; ++j) { v[j] = ((const f32x4*)xrow)[64 * j + lane]; if (pbrow) { v[j] += ((const f32x4*)pbrow)[64 * j + lane]; v[j] += ((const f32x4*)(pbrow + pbstride))[64 * j + lane]; v[j] += ((const f32x4*)(pbrow + 2 * pbstride))[64 * j + lane]; } s += (v[j][0] * v[j][0] + v[j][1] * v[j][1]) + (v[j][2] * v[j][2] + v[j][3] * v[j][3]); }
    if (copy) {
#pragma unroll
        for (int j = 0; j < 8; ++j) ((f32x4*)copy)[64 * j + lane] = v[j]; }
    const float rs = 1.0f / sqrtf(wave_sum(s) * (1.0f / D) + RMS_EPS);
#pragma unroll
    for (int j = 0; j < 8; ++j) { const f32x4 gg = ((const f32x4*)gain)[64 * j + lane]; const f32x4 o = v[j] * rs * gg;
        if (orow) { u32x2 w; w.x = cvt_pk_bf16(o[0], o[1]); w.y = cvt_pk_bf16(o[2], o[3]); ((u32x2*)orow)[64 * j + lane] = w; }
        else ((f32x4*)frow)[64 * j + lane] = o; }
}
__device__ __forceinline__ void zero_row_bf16(bf16_t* orow, int lane) {
#pragma unroll
    for (int j = 0; j < 8; ++j) ((u32x2*)orow)[64 * j + lane] = (u32x2){0u, 0u};
}

__device__ __forceinline__ void sincos_r(float x, float& s, float& c) {
    const float k = rintf(x * 0.6366197723675814f);
    float r = fmaf(-k, 1.5707963705062866f, x); r = fmaf(-k, -4.371139000186241e-8f, r);
    const float z = r * r;
    const float sp = r + r * z * (-1.6666654611e-1f + z * (8.3321608736e-3f + z * (-1.9515295891e-4f)));
    const float cp = 1.0f - 0.5f * z + z * z * (4.166664568298827e-2f + z * (-1.388731625493765e-3f + z * 2.443315711809948e-5f));
    const int q = ((int)k) & 3;
    s = (q == 0) ? sp : (q == 1) ? cp : (q == 2) ? -sp : -cp;
    c = (q == 0) ? cp : (q == 1) ? -sp : (q == 2) ? -cp : sp;
}
__device__ __forceinline__ bf16x8 pack8s(f32x4 a, f32x4 b) { const u32x4 w = pack8(a, b); return __builtin_bit_cast(bf16x8, w); }

#define WSYNC() asm volatile("s_waitcnt lgkmcnt(0)" ::: "memory")
struct S5K { float lbr, lbi; bf16x8 bb[8]; bf16x8 cm[4]; f32x4 dsk; };

__device__ __forceinline__ void s5_consts(const Frame& F, int g, LAS float* tab, S5K& k) {
    const int lane = F.lane, i16 = lane & 15, kq = lane >> 4;
    const float lre = F.a->in[15][g * NP + lane], lim = F.a->in[16][g * NP + lane], dt = expf(F.a->in[17][g]);
    const float a = lre * dt, b = lim * dt;
    const float em1 = a * (1.0f + a * (0.5f + a * (1.0f / 6.0f + a * (1.0f / 24.0f + a * (1.0f / 120.0f + a * (1.0f / 720.0f))))));
    const float ea = 1.0f + em1;
    float sh, ch; sincos_r(0.5f * b, sh, ch);
    const float sb = 2.0f * sh * ch, cbm1 = -2.0f * sh * sh, cb = 1.0f + cbm1;
    k.lbr = ea * cb; k.lbi = ea * sb;
    const float rm1 = em1 * cb + cbm1, im1 = ea * sb;
    const float inv = 1.0f / (lre * lre + lim * lim);
    tab[2 * lane] = (rm1 * lre + im1 * lim) * inv; tab[2 * lane + 1] = (im1 * lre - rm1 * lim) * inv;
    WSYNC();
#pragma unroll
    for (int n4 = 0; n4 < 4; ++n4) {
        const int p = 16 * n4 + i16; const float qr = tab[2 * p], qi = tab[2 * p + 1];
        const float* br = F.a->in[18] + ((size_t)g * NP + p) * GS + 8 * (kq & 1); const float* bi = F.a->in[19] + ((size_t)g * NP + p) * GS + 8 * (kq & 1);
        const f32x4 r0 = *(const f32x4*)br, r1 = *(const f32x4*)(br + 4), i0 = *(const f32x4*)bi, i1 = *(const f32x4*)(bi + 4);
        k.bb[n4] = pack8s(qr * r0 - qi * i0, qr * r1 - qi * i1);
        k.bb[4 + n4] = pack8s(qr * i0 + qi * r0, qr * i1 + qi * r1);
    }
#pragma unroll
    for (int s = 0; s < 4; ++s) {
        const float* cp = (s < 2 ? F.a->in[20] : F.a->in[21]) + ((size_t)g * GS + i16) * NP + 32 * (s & 1) + 8 * kq;
        f32x4 c0 = *(const f32x4*)cp, c1 = *(const f32x4*)(cp + 4);
        if (s >= 2) { c0 = -c0; c1 = -c1; }
        k.cm[s] = pack8s(c0, c1);
    }
    k.dsk = *(const f32x4*)(F.a->in[22] + g * GS + 4 * kq);
    WSYNC();
}
__device__ __forceinline__ void s5_ld(const float* US, int row0, int g, int lane, f32x4& u0, f32x4& u1) {
    const float* up = US + (size_t)(row0 + (lane & 15)) * WSSM + g * GS + 8 * ((lane >> 4) & 1);
    u0 = *(const f32x4*)up; u1 = *(const f32x4*)(up + 4);
}
__device__ __forceinline__ void s5_bu(const f32x4 u0, const f32x4 u1, int lane, const S5K& k, LAS float* HB) {
    const int t = lane & 15, kq = lane >> 4;
    u32x4 hi = pack8(u0, u1);
    f32x4 h0, h1; unpack8(hi, h0, h1);
    const u32x4 lo = pack8(u0 - h0, u1 - h1);
    const bf16x8 uop = __builtin_bit_cast(bf16x8, (kq >= 2) ? lo : hi);
#pragma unroll
    for (int n = 0; n < 8; ++n) {
        const f32x4 d = __builtin_amdgcn_mfma_f32_16x16x32_bf16(k.bb[n], uop, (f32x4){0.f, 0.f, 0.f, 0.f}, 0, 0, 0);
        *(LAS f32x4*)(HB + t * 132 + 16 * n + 4 * kq) = d;
    }
    WSYNC();
}
__device__ __forceinline__ void s5_out(const f32x4 uu, bf16_t* SG, int row0, int g, int lane, const S5K& k, const LAS float* HB) {
    const int t = lane & 15, kq = lane >> 4;
    f32x4 acc = (f32x4){0.f, 0.f, 0.f, 0.f};
#pragma unroll
    for (int s = 0; s < 4; ++s) {
        const LAS float* hp = HB + t * 132 + 32 * s + 8 * kq;
        const f32x4 h0 = *(const LAS f32x4*)hp, h1 = *(const LAS f32x4*)(hp + 4);
        acc = __builtin_amdgcn_mfma_f32_16x16x32_bf16(k.cm[s], pack8s(h0, h1), acc, 0, 0, 0);
    }
    const f32x4 y = acc + k.dsk * uu;
    u32x2 w; w.x = cvt_pk_bf16(gelu_tanh(y[0]), gelu_tanh(y[1])); w.y = cvt_pk_bf16(gelu_tanh(y[2]), gelu_tanh(y[3]));
    *(u32x2*)(SG + (size_t)(row0 + t) * WSSM + g * GS + 4 * kq) = w;
    WSYNC();
}

__device__ __forceinline__ void s5_phase(const Frame& F) {
    const float* US = (const float*)(F.ws + WS_US); bf16_t* SG = (bf16_t*)(F.ws + WS_SG);
    LAS f32x2* EB = (LAS f32x2*)F.lds;
    LAS float* HB = (LAS float*)(F.lds + 66048 + F.wave * 8448);
    const int lane = F.lane;
    S5K k;
    for (int item = blockIdx.x; item < NBP * NG; item += F.G) {
        const int b = item >> 6, g = item & 63, rb = b * LP;
        s5_consts(F, g, HB, k);
        f32x4 nu0, nu1; s5_ld(US, rb + 16 * F.wave, g, lane, nu0, nu1);
        for (int c = F.wave; c < NCH; c += 8) {
            const f32x4 u0 = nu0, u1 = nu1; if (c + 8 < NCH) s5_ld(US, rb + 16 * (c + 8), g, lane, nu0, nu1);
            s5_bu(u0, u1, lane, k, HB);
            float br[16], bi[16];
#pragma unroll
            for (int t = 0; t < 16; ++t) { br[t] = HB[t * 132 + lane]; bi[t] = HB[t * 132 + 64 + lane]; }
            float hr = 0.f, hi = 0.f;
#pragma unroll
            for (int t = 0; t < 16; ++t) { const float nr = k.lbr * hr - k.lbi * hi + br[t], ni = k.lbr * hi + k.lbi * hr + bi[t]; hr = nr; hi = ni; }
            EB[c * 64 + lane] = (f32x2){hr, hi};
            WSYNC();
        }
        __syncthreads();
        if (F.wave == 0) {
            float pr = k.lbr, pi = k.lbi;
#pragma unroll
            for (int q = 0; q < 4; ++q) { const float nr = pr * pr - pi * pi, ni = 2.0f * pr * pi; pr = nr; pi = ni; }
            float hr = 0.f, hi = 0.f;
            for (int c0 = 0; c0 < NCH; c0 += 8) {
                f32x2 e[8];
#pragma unroll
                for (int j = 0; j < 8; ++j) e[j] = (c0 + j < NCH) ? EB[(c0 + j) * 64 + lane] : (f32x2){0.f, 0.f};
#pragma unroll
                for (int j = 0; j < 8; ++j) { const float nr = pr * hr - pi * hi + e[j][0], ni = pr * hi + pi * hr + e[j][1]; hr = nr; hi = ni; e[j] = (f32x2){hr, hi}; }
#pragma unroll
                for (int j = 0; j < 8; ++j) if (c0 + j < NCH) EB[(c0 + j) * 64 + lane] = e[j];
            }
            const f32x2 fin = EB[(NCH - 1) * 64 + lane];
            F.out[O_RP + (size_t)(b * NG + g) * NP + lane] = fin[0]; F.out[O_IP + (size_t)(b * NG + g) * NP + lane] = fin[1];
        }
        __syncthreads();
        s5_ld(US, rb + 16 * F.wave, g, lane, nu0, nu1);
        for (int c = F.wave; c < NCH; c += 8) {
            const f32x4 u0 = nu0, u1 = nu1; if (c + 8 < NCH) s5_ld(US, rb + 16 * (c + 8), g, lane, nu0, nu1);
            const f32x4 uu = *(const f32x4*)(US + (size_t)(rb + 16 * c + (lane & 15)) * WSSM + g * GS + 4 * (lane >> 4));
            s5_bu(u0, u1, lane, k, HB);
            float br[16], bi[16];
#pragma unroll
            for (int t = 0; t < 16; ++t) { br[t] = HB[t * 132 + lane]; bi[t] = HB[t * 132 + 64 + lane]; }
            f32x2 h0 = (f32x2){0.f, 0.f}; if (c > 0) h0 = EB[(c - 1) * 64 + lane];
            float hr = h0[0], hi = h0[1];
#pragma unroll
            for (int t = 0; t < 16; ++t) { const float nr = k.lbr * hr - k.lbi * hi + br[t], ni = k.lbr * hi + k.lbi * hr + bi[t]; hr = nr; hi = ni; br[t] = hr; bi[t] = hi; }
#pragma unroll
            for (int t = 0; t < 16; ++t) { HB[t * 132 + lane] = br[t]; HB[t * 132 + 64 + lane] = bi[t]; }
            WSYNC();
            s5_out(uu, SG, rb + 16 * c, g, lane, k, HB);
        }
        __syncthreads();
    }
    for (int it = F.gw; it < NG * (MSA / 16); it += F.NGW) {
        const int g = it >> 5, j = it & 31, row0 = MPR + 16 * j;
        f32x4 u0, u1; s5_ld(US, row0, g, lane, u0, u1);
        const f32x4 uu = *(const f32x4*)(US + (size_t)(row0 + (lane & 15)) * WSSM + g * GS + 4 * (lane >> 4));
        s5_consts(F, g, HB, k);
        s5_bu(u0, u1, lane, k, HB);
        float br[16], bi[16];
#pragma unroll
        for (int t = 0; t < 16; ++t) { br[t] = HB[t * 132 + lane]; bi[t] = HB[t * 132 + 64 + lane]; }
#pragma unroll
        for (int sq = 0; sq < 4; ++sq) {
            const size_t so = ((size_t)(4 * j + sq) * NG + g) * NP + lane;
            float hr = F.a->in[3][so], hi = F.a->in[4][so];
#pragma unroll
            for (int t = 4 * sq; t < 4 * sq + 4; ++t) { const float nr = k.lbr * hr - k.lbi * hi + br[t], ni = k.lbr * hi + k.lbi * hr + bi[t]; hr = nr; hi = ni; br[t] = hr; bi[t] = hi; }
            F.out[O_RS + so] = hr; F.out[O_IS + so] = hi;
        }
#pragma unroll
        for (int t = 0; t < 16; ++t) { HB[t * 132 + lane] = br[t]; HB[t * 132 + 64 + lane] = bi[t]; }
        WSYNC();
        s5_out(uu, SG, row0, g, lane, k, HB);
    }
}

__device__ __forceinline__ void store_d(bf16_t* p, f32x4 d) { u32x2 w; w.x = cvt_pk_bf16(d[0], d[1]); w.y = cvt_pk_bf16(d[2], d[3]); *(u32x2*)p = w; }
template <int W, int T> __device__ __forceinline__ void pool_rows(const f32x4* cur, const f32x4* old, int skip, int avail0, bf16_t* dd) {
    f32x4 u[T], o[W - 1];
#pragma unroll
    for (int k = 0; k < W - 1; ++k) o[k] = (k >= skip) ? old[(size_t)k * 256] : (f32x4){0.f, 0.f, 0.f, 0.f};
#pragma unroll
    for (int t = 0; t < T; ++t) u[t] = cur[(size_t)t * 256];
    f32x4 s = (f32x4){0.f, 0.f, 0.f, 0.f};
#pragma unroll
    for (int k = 0; k < W - 1; ++k) s += o[k];
#pragma unroll
    for (int t = 0; t < T; ++t) {
        s += u[t];
        const int av = avail0 + t + 1; const float inv = 1.0f / (float)(av < W ? av : W);
        store_d(dd + (size_t)t * WPOOL, s * inv - u[t]);
        if (t - (W - 1) >= 0) s -= u[t - (W - 1) >= 0 ? t - (W - 1) : 0]; else s -= o[t < W - 1 ? t : 0];
    }
}
__device__ __forceinline__ void pool_phase(const Frame& F) {
    const f32x4* UP4 = (const f32x4*)(F.ws + WS_UP); bf16_t* DD = (bf16_t*)(F.ws + WS_DD);
    const int half = F.tid >> 8, q = F.tid & 255, grp = __builtin_amdgcn_readfirstlane(q >> 6);
    constexpr int NPI = NBP * NCH  , NSI = NBS;
    for (int it = blockIdx.x * 2 + half; it < NPI + NSI; it += F.G * 2) {
        if (it < NPI) {
            const int b = it / NCH, ch = it - b * NCH, t0 = 16 * ch, rb = b * LP;
            const f32x4* cur = UP4 + (size_t)(rb + t0) * 256 + q; bf16_t* dd = DD + (size_t)(rb + t0) * WPOOL + 4 * q;
            if (grp == 0)      pool_rows<2, 16>(cur, cur - (size_t)1 * 256, 1 - t0 > 0 ? 1 - t0 : 0, t0, dd);
            else if (grp == 1) pool_rows<4, 16>(cur, cur - (size_t)3 * 256, 3 - t0 > 0 ? 3 - t0 : 0, t0, dd);
            else if (grp == 2) pool_rows<8, 16>(cur, cur - (size_t)7 * 256, 7 - t0 > 0 ? 7 - t0 : 0, t0, dd);
            else               pool_rows<16, 16>(cur, cur - (size_t)15 * 256, 15 - t0 > 0 ? 15 - t0 : 0, t0, dd);
        } else {
            const int bs = it - NPI, rs = MPR + 4 * bs; const f32x4* hist = (const f32x4*)F.a->in[2] + (size_t)bs * 15 * 256 + q;
            const f32x4* cur = UP4 + (size_t)rs * 256 + q; bf16_t* dd = DD + (size_t)rs * WPOOL + 4 * q;
            if (grp == 0)      pool_rows<2, 4>(cur, hist + (size_t)14 * 256, 0, 1 << 20, dd);
            else if (grp == 1) pool_rows<4, 4>(cur, hist + (size_t)12 * 256, 0, 1 << 20, dd);
            else if (grp == 2) pool_rows<8, 4>(cur, hist + (size_t)8 * 256, 0, 1 << 20, dd);
            else               pool_rows<16, 4>(cur, hist, 0, 1 << 20, dd);
        }
    }
    const int gt = blockIdx.x * 512 + F.tid, NT = F.G * 512;
    f32x4* pp = (f32x4*)(F.out + O_PP); f32x4* ps = (f32x4*)(F.out + O_PS);
    for (int i = gt; i < NBP * 15 * 256; i += NT) { const int c = i & 255, j = (i >> 8) % 15, b = i / (15 * 256); pp[i] = UP4[(size_t)(b * LP + LP - 15 + j) * 256 + c]; }
    for (int i = gt; i < NBS * 15 * 256; i += NT) { const int c = i & 255, j = (i >> 8) % 15, b = i / (15 * 256);
        ps[i] = (j < 11) ? ((const f32x4*)F.a->in[2])[((size_t)b * 15 + j + 4) * 256 + c] : UP4[(size_t)(MPR + 4 * b + j - 11) * 256 + c]; }
}


#define XB_TMO      128
#define XB_XCNT(j)  (256  + 64 * (j))
#define XB_XSUB(j)  (1280 + 64 * (j))
#define XB_XGEN(j)  (2304 + 64 * (j))
#define XB_TOP      3328
#define XB_TOPGEN   3392
#define XCD_BAR_WORDS 3456
#define XB_SPIN_CAP (1u << 20)
__device__ __forceinline__ unsigned xb_ld(unsigned* p)              { return __hip_atomic_load(p, __ATOMIC_RELAXED, __HIP_MEMORY_SCOPE_AGENT); }
__device__ __forceinline__ unsigned xb_add(unsigned* p, unsigned v) { return __hip_atomic_fetch_add(p, v, __ATOMIC_RELAXED, __HIP_MEMORY_SCOPE_AGENT); }
__device__ __forceinline__ unsigned xb_xcc_id() { return (unsigned)__builtin_amdgcn_s_getreg((3 << 11) | 20) & 0xFu; }
#define XB_SPIN(cond, bar) do { unsigned _sp = 0; while (cond) { __builtin_amdgcn_s_sleep(1); \
    if ((++_sp & 255u) == 0u) { if (xb_ld(&(bar)[XB_TMO])) break; if (_sp > XB_SPIN_CAP) { atomicAdd(&(bar)[XB_TMO], 1u); break; } } } } while (0)
__device__ __forceinline__ void xcd_barrier_complete(unsigned* bar, unsigned x, unsigned& nloc, unsigned& nx) {
    const unsigned G = gridDim.x;
    unsigned sum, cnt, mine, sp = 0u;
    for (;;) {
        sum = 0u; cnt = 0u; mine = 0u;
#pragma unroll
        for (unsigned j = 0; j < 16; ++j) { const unsigned c = xb_ld(&bar[XB_XCNT(j)]); sum += c; cnt += (c > 0u) ? 1u : 0u; mine = (j == x) ? c : mine; }
        if (sum == G) break;
        __builtin_amdgcn_s_sleep(1);
        if ((++sp & 255u) == 0u) { if (xb_ld(&bar[XB_TMO])) break; if (sp > XB_SPIN_CAP) { atomicAdd(&bar[XB_TMO], 1u); break; } }
    }
    nloc = mine > 0u ? mine : 1u; nx = cnt > 0u ? cnt : 1u;
}
__device__ __forceinline__ void xcd_barrier(unsigned* bar, volatile LAS unsigned* st) {
    asm volatile("s_waitcnt vmcnt(0)" ::: "memory");
    __syncthreads();
    if (threadIdx.x == 0) {
        __builtin_amdgcn_s_waitcnt(0);
        const unsigned x = xb_xcc_id();
        unsigned nloc = st[0], nx = st[1];
        if (nloc == 0u) { xcd_barrier_complete(bar, x, nloc, nx); st[0] = nloc; st[1] = nx; }
        const unsigned old = xb_add(&bar[XB_XSUB(x)], 1u);
        const unsigned gen = old / nloc;
        if (old + 1u == (gen + 1u) * nloc) {
            __builtin_amdgcn_fence(__ATOMIC_RELEASE, "agent");
            asm volatile("s_waitcnt vmcnt(0)" ::: "memory");
            const unsigned og = xb_add(&bar[XB_TOP], 1u);
            const unsigned tg = og / nx;
            if (og + 1u == (tg + 1u) * nx) xb_add(&bar[XB_TOPGEN], 1u);
            else XB_SPIN(xb_ld(&bar[XB_TOPGEN]) == tg, bar);
            __builtin_amdgcn_fence(__ATOMIC_ACQUIRE, "agent");
            xb_add(&bar[XB_XGEN(x)], 1u);
            asm volatile("s_waitcnt vmcnt(0)" ::: "memory");
        } else {
            XB_SPIN(xb_ld(&bar[XB_XGEN(x)]) == gen, bar);
            __builtin_amdgcn_fence(__ATOMIC_ACQUIRE, "agent");
            asm volatile("s_waitcnt vmcnt(0)" ::: "memory");
        }
    }
    __syncthreads();
}
constexpr int LDS_BARST = LDS_BYTES - 64;

constexpr int N_PHASES = 14;
#ifndef DBG_STOP
#define DBG_STOP 99
#endif
#ifndef DBG_SRC
#define DBG_SRC WS_UP
#endif

__device__ __forceinline__ Frame make_frame(LAS unsigned char* lds) {
    Frame F;
    ArgsP a = (ArgsP)__builtin_amdgcn_kernarg_segment_ptr(); asm volatile("" : "+s"(a));
    int t = threadIdx.x; asm volatile("" : "+v"(t));
    F.a = a; F.ws = a->ws; F.out = a->out; F.lds = lds;
    F.tid = t; F.lane = t & 63; F.wave = __builtin_amdgcn_readfirstlane(t >> 6); F.G = gridDim.x;
    F.gw = blockIdx.x * 8 + F.wave; F.NGW = F.G * 8;
    return F;
}
#define XN_(F) ((bf16_t*)((F).ws + WS_XN))
#define X_(F) ((float*)((F).ws + WS_X))
#define H_(F) ((bf16_t*)((F).ws + WS_H))
#define VCU_(F) (((F).G & 7) == 0 ? (int)((blockIdx.x & 7) * ((F).G >> 3) + (blockIdx.x >> 3)) : (int)blockIdx.x)
#define PB_(F) ((float*)((F).ws + WS_PB))
#define X0_(F) (X0Src{(F).a->in[5], (F).a->in[0], (F).a->in[1]})

__global__ void __launch_bounds__(512, 2) mk_fwd(Args args) {
    extern __shared__ __attribute__((aligned(16))) unsigned char lds_raw[];
    LAS unsigned char* const lds = (LAS unsigned char*)lds_raw;
    const int lo = args.ph_lo, hi = args.ph_hi;
    if (threadIdx.x < 2) ((volatile LAS unsigned*)(lds + LDS_BARST))[threadIdx.x] = 0u;
    if (threadIdx.x == 0) (void)xb_add((unsigned*)(args.ws + WS_CTL) + XB_XCNT(xb_xcc_id()), 1u);
    __syncthreads();
#define IN(k) (lo <= (k) && (k) < hi && ((k) < DBG_STOP || (k) == 13))
#define SEAM(k) do { if (lo <= (k) && (k) + 1 < hi) { if (hi > 1000) cg::this_grid().sync();   ArgsP a_ = (ArgsP)__builtin_amdgcn_kernarg_segment_ptr(); asm volatile("" : "+s"(a_)); xcd_barrier((unsigned*)(a_->ws + WS_CTL), (volatile LAS unsigned*)(lds + LDS_BARST)); } } while (0)

    if (IN(0)) { const Frame F = make_frame(lds);
        cvt_ffn(F, 7, F.gw, F.NGW);
        const X0Src x0 = X0_(F); bf16_t* XN = XN_(F);
        for (int r = F.gw; r < MP; r += F.NGW) { const float* xr = x0_row(x0, r); if (xr) rms_row(xr, F.a->in[6], XN + (size_t)r * D, nullptr, F.lane); else zero_row_bf16(XN + (size_t)r * D, F.lane); }
    }
    SEAM(0);
    if (IN(1)) { const Frame F = make_frame(lds);
        pg8::Gemm g{XN_(F), (const bf16_t*)(F.ws + WS_WGU), D, D, MP, 2 * FF, D, 0}; pg8::PadOrder S; S.init(2 * FF, D, F.G, blockIdx.x);
        pg8::EpiSwiGLU E{H_(F)}; pg8::gemm_phase(lds, g, S, E); }
    SEAM(1);
    if (IN(2)) { const Frame F = make_frame(lds);
        pg8::Gemm g{H_(F), (const bf16_t*)(F.ws + WS_WD), FF, FF, MP, D, FF, 0}; pg8::TailSplitOrder S; S.init(D, FF, F.G, blockIdx.x, 1);
        pg8::EpiDownFinal<1, true> E{X0_(F), X_(F), 0.5f, F.a->in[10], nullptr, XN_(F), (unsigned*)(F.ws + WS_CTL + CTL_XBUF), (unsigned*)(F.ws + WS_CTL + CTL_CNT)}; pg8::gemm_phase(lds, g, S, E);
        if ((int)blockIdx.x < 24 * pg8::TS_NSPLIT) { const Frame F3 = make_frame(lds);
            pg8::Gemm g3{H_(F3), (const bf16_t*)(F3.ws + WS_WD), FF, FF, MP, D, FF, 0}; pg8::TailSplitOrder S3; S3.init(D, FF, F3.G, blockIdx.x, 2);
            pg8::EpiAdd<true> E3{X0_(F3), X_(F3), PB_(F3), 0.5f}; pg8::gemm_phase(lds, g3, S3, E3); }
        if (lo == 0) { const Frame F2 = make_frame(lds); const int nb = 24 * pg8::TS_NSPLIT;
            if ((int)blockIdx.x >= nb) cvt_mixer(F2, ((int)blockIdx.x - nb) * 8 + F2.wave, (F2.G - nb) * 8, 0, 3904); } }
    SEAM(2);
    if (IN(3)) { const Frame F = make_frame(lds); bf16_t* XN = XN_(F); float* X = X_(F); const float* PB = PB_(F);
        for (int r = pg8::TS_ROWS0 + F.gw; r < MP; r += F.NGW) { if (r < MV) {
                rms_row(X + (size_t)r * D, F.a->in[10], XN + (size_t)r * D, nullptr, F.lane, r >= pg8::TS_ROWS0 ? X + (size_t)r * D : nullptr, r >= pg8::TS_ROWS0 ? PB + (size_t)(r - pg8::TS_ROWS0) * D : nullptr, (size_t)(MP - pg8::TS_ROWS0) * D); }
            else zero_row_bf16(XN + (size_t)r * D, F.lane); } }
    SEAM(3);
    if (IN(4)) { const Frame F = make_frame(lds);
        pg8::Gemm g{XN_(F), (const bf16_t*)(F.ws + WS_WIN), D, D, MP, WIN, D, 0}; pg8::StaticOrder S; S.init(MP, WIN, F.G, blockIdx.x, D);
        pg8::EpiWin E{(float*)(F.ws + WS_UP), (float*)(F.ws + WS_US), (bf16_t*)(F.ws + WS_G), F.a->in[12]}; pg8::gemm_phase(lds, g, S, E);
        { const Frame F2 = make_frame(lds); const int nb = (MP / 256) * (WIN / 256) - 3 * F2.G;
          if ((int)blockIdx.x >= nb) { cvt_ffn(F2, 29, ((int)blockIdx.x - nb) * 8 + F2.wave, (F2.G - nb) * 8, 0, 4); cvt_ffn(F2, 29, ((int)blockIdx.x - nb) * 8 + F2.wave, (F2.G - nb) * 8, 1, 4); } } }
    SEAM(4);
    if (IN(5)) { __syncthreads();
        { const Frame F = make_frame(lds); s5_phase(F); }
        { const Frame F = make_frame(lds); pool_phase(F); }
        __syncthreads(); }
    SEAM(5);
    if (IN(6)) {
        { const Frame F = make_frame(lds);
          pg8::Gemm g{(const bf16_t*)(F.ws + WS_DD), (const bf16_t*)(F.ws + WS_PW), WPOOL, 256, MP, WPOOL, 256, 512}; pg8::StaticOrder S; S.init(MP, WPOOL, F.G, blockIdx.x, 256);
          pg8::EpiPool E{XN_(F), F.a->in[14]}; pg8::gemm_phase(lds, g, S, E); }
        { const Frame F = make_frame(lds);
          pg8::Gemm g{(const bf16_t*)(F.ws + WS_SG), (const bf16_t*)(F.ws + WS_GLU), WSSM, WSSM, MP, WSSM, WSSM, 0}; pg8::StaticOrder S; S.init(MP, WSSM, F.G, (blockIdx.x + F.G / 2) % F.G, WSSM);
          pg8::EpiGLU E{XN_(F), (const bf16_t*)(F.ws + WS_SG), F.a->in[24]}; pg8::gemm_phase(lds, g, S, E); }
    }
    SEAM(6);
    if (IN(7)) { const Frame F = make_frame(lds);
        pg8::Gemm g{XN_(F), (const bf16_t*)(F.ws + WS_WA), 2048, 1024, MP, D, 1024, 0}; pg8::StaticOrder S; S.init(MP, D, F.G, blockIdx.x, 1024);
        pg8::EpiBr1 E{(bf16_t*)(F.ws + WS_T1), (const bf16_t*)(F.ws + WS_G)}; pg8::gemm_phase(lds, g, S, E);
        { const Frame F2 = make_frame(lds); if ((int)blockIdx.x >= 24) { cvt_mixer(F2, ((int)blockIdx.x - 24) * 8 + F2.wave, (F2.G - 24) * 8, 3904, 4416);
              cvt_ffn(F2, 29, ((int)blockIdx.x - 24) * 8 + F2.wave, (F2.G - 24) * 8, 2, 4); } } }
    SEAM(7);
    if (IN(8)) { const Frame F = make_frame(lds);
        pg8::Gemm g{XN_(F) + 1024, (const bf16_t*)(F.ws + WS_WB), 2048, 1024, MP, D, 1024, 0}; pg8::StaticOrder S; S.init(MP, D, F.G, blockIdx.x, 1024);
        pg8::EpiBr2 E{(const bf16_t*)(F.ws + WS_T1), (const bf16_t*)(F.ws + WS_G), (bf16_t*)(F.ws + WS_MRG)}; pg8::gemm_phase(lds, g, S, E);
        { const Frame F2 = make_frame(lds); if ((int)blockIdx.x >= 24) { cvt_mixer(F2, ((int)blockIdx.x - 24) * 8 + F2.wave, (F2.G - 24) * 8, 4416, 5440);
              cvt_ffn(F2, 29, ((int)blockIdx.x - 24) * 8 + F2.wave, (F2.G - 24) * 8, 3, 4); } } }
    SEAM(8);
    if (IN(9)) { const Frame F = make_frame(lds);
        pg8::Gemm g{(const bf16_t*)(F.ws + WS_MRG), (const bf16_t*)(F.ws + WS_WOUT), D, D, MP, D, D, 0}; pg8::TailSplitOrder S; S.init(D, D, F.G, blockIdx.x, 1);
        pg8::EpiDownFinal<1, false> E{X0_(F), X_(F), 1.0f, F.a->in[28], nullptr, XN_(F), (unsigned*)(F.ws + WS_CTL + CTL_XBUF + 262144), (unsigned*)(F.ws + WS_CTL + CTL_CNT) + 2048}; pg8::gemm_phase(lds, g, S, E);
        if ((int)blockIdx.x < 24 * pg8::TS_NSPLIT) { const Frame F3 = make_frame(lds);
            pg8::Gemm g3{(const bf16_t*)(F3.ws + WS_MRG), (const bf16_t*)(F3.ws + WS_WOUT), D, D, MP, D, D, 0}; pg8::TailSplitOrder S3; S3.init(D, D, F3.G, blockIdx.x, 2);
            pg8::EpiAdd<false> E3{X0_(F3), X_(F3), (float*)(F3.ws + WS_DD), 1.0f}; pg8::gemm_phase(lds, g3, S3, E3); } }
    SEAM(9);
    if (IN(10)) { const Frame F = make_frame(lds); bf16_t* XN = XN_(F); float* X = X_(F); const float* PB = (const float*)(F.ws + WS_DD);
        for (int r = pg8::TS_ROWS0 + F.gw; r < MP; r += F.NGW) { if (r < MV) {
                rms_row(X + (size_t)r * D, F.a->in[28], XN + (size_t)r * D, nullptr, F.lane, r >= pg8::TS_ROWS0 ? X + (size_t)r * D : nullptr, r >= pg8::TS_ROWS0 ? PB + (size_t)(r - pg8::TS_ROWS0) * D : nullptr, (size_t)(MP - pg8::TS_ROWS0) * D); }
            else zero_row_bf16(XN + (size_t)r * D, F.lane); } }
    SEAM(10);
    if (IN(11)) { const Frame F = make_frame(lds);
        pg8::Gemm g{XN_(F), (const bf16_t*)(F.ws + WS_WGU), D, D, MP, 2 * FF, D, 0}; pg8::PadOrder S; S.init(2 * FF, D, F.G, blockIdx.x);
        pg8::EpiSwiGLU E{H_(F)}; pg8::gemm_phase(lds, g, S, E); }
    SEAM(11);
    if (IN(12)) { { const Frame F = make_frame(lds);
        pg8::Gemm g{H_(F), (const bf16_t*)(F.ws + WS_WD), FF, FF, MP, D, FF, 0}; pg8::TailSplitOrder S; S.init(D, FF, F.G, blockIdx.x, 1);
        pg8::EpiDownFinal<0, false> E{X0_(F), X_(F), 0.5f, F.a->in[32], F.out, nullptr, (unsigned*)(F.ws + WS_CTL + CTL_XBUF + 2 * 262144), (unsigned*)(F.ws + WS_CTL + CTL_CNT) + 2 * 2048}; pg8::gemm_phase(lds, g, S, E); }
      if ((int)blockIdx.x < 24 * pg8::TS_NSPLIT) { const Frame F = make_frame(lds);
        pg8::Gemm g{H_(F), (const bf16_t*)(F.ws + WS_WD), FF, FF, MP, D, FF, 0}; pg8::TailSplitOrder S; S.init(D, FF, F.G, blockIdx.x, 2);
        pg8::EpiAdd<false> E{X0_(F), X_(F), PB_(F), 0.5f}; pg8::gemm_phase(lds, g, S, E); } }
    SEAM(12);
    if (IN(13) && DBG_STOP < 99) { const Frame F = make_frame(lds);
        const f32x4* src = (const f32x4*)(F.ws + DBG_SRC); f32x4* dst = (f32x4*)F.out;
        for (size_t i = (size_t)blockIdx.x * 512 + F.tid; i < O_PP / 4; i += (size_t)F.G * 512) dst[i] = src[i];
    } else
    if (IN(13)) { const Frame F = make_frame(lds); const float* X = X_(F);
        for (int r = pg8::TS_ROWS0 + F.gw; r < MV; r += F.NGW) {
            float* o;
            if (r < MPR) { const int b = r / LP, t = r - b * LP; if (t < NMETA) continue; o = F.out + O_YP + ((size_t)b * SEQ + (t - NMETA)) * D; }
            else o = F.out + O_YS + (size_t)(r - MPR) * D;
            rms_row(X + (size_t)r * D, F.a->in[32], nullptr, o, F.lane, nullptr, r >= pg8::TS_ROWS0 ? PB_(F) + (size_t)(r - pg8::TS_ROWS0) * D : nullptr, (size_t)(MP - pg8::TS_ROWS0) * D);
        }
    }
#undef IN
#undef SEAM
}

extern "C" void kernel_launch(void* const* d_in, const int* in_sizes, int n_in, void* d_out, int out_size, void* d_ws, size_t ws_size, hipStream_t stream) {
    static int grid = 0;
    if (grid == 0) {
        if (n_in != 33 || ws_size < WS_END) { fprintf(stderr, "kernel_launch: expected 33 inputs and >= %zu bytes of workspace; got %d, %zu\n", (size_t)WS_END, n_in, ws_size); grid = -1; return; }
        int dev = 0, cus = 0, per_cu = 0;
        if (hipGetDevice(&dev) != hipSuccess || hipDeviceGetAttribute(&cus, hipDeviceAttributeMultiprocessorCount, dev) != hipSuccess) { grid = -1; return; }
        if (hipFuncSetAttribute((const void*)mk_fwd, hipFuncAttributeMaxDynamicSharedMemorySize, LDS_BYTES) != hipSuccess) { fprintf(stderr, "kernel_launch: hipFuncSetAttribute failed\n"); grid = -1; return; }
        if (hipOccupancyMaxActiveBlocksPerMultiprocessor(&per_cu, (const void*)mk_fwd, 512, LDS_BYTES) != hipSuccess || per_cu < 1) { fprintf(stderr, "kernel_launch: occupancy query says %d\n", per_cu); per_cu = 1; }
        (void)hipGetLastError();
        grid = cus * per_cu;
        if (grid > 256) grid = 256;
        if (grid != 256) fprintf(stderr, "kernel_launch: this kernel needs a 256-workgroup cooperative grid; got capacity %d\n", grid);
    }
    if (grid < 0) return;
    Args a{};
    for (int i = 0; i < 33; ++i) a.in[i] = (const float*)d_in[i];
    a.out = (float*)d_out; a.ws = (unsigned char*)d_ws;
#if MK_N_LAUNCHES == 1
    if (hipMemsetAsync((char*)d_ws + WS_CTL, 0, CTL_BYTES, stream) != hipSuccess) { fprintf(stderr, "kernel_launch: hipMemsetAsync failed\n"); return; }
    a.ph_lo = 0; a.ph_hi = N_PHASES;
    void* kargs[] = {&a};
    hipError_t e = hipLaunchCooperativeKernel((const void*)mk_fwd, dim3(grid), dim3(512), kargs, LDS_BYTES, stream);
    if (e != hipSuccess) fprintf(stderr, "kernel_launch: cooperative launch failed: %s (grid %d)\n", hipGetErrorString(e), grid);
#else
    for (int p = 0; p < N_PHASES; ++p) { a.ph_lo = p; a.ph_hi = p + 1; hipLaunchKernelGGL(mk_fwd, dim3(grid), dim3(512), LDS_BYTES, stream, a); }
#endif
}
```

```cpp
#include <hip/hip_runtime.h>
#include <hip/hip_cooperative_groups.h>
#include <cstdio>
#include <cstdint>
namespace cg = cooperative_groups;

#ifndef MK_N_LAUNCHES
#define MK_N_LAUNCHES 1
#endif

#define LAS __attribute__((address_space(3)))
typedef unsigned short bf16_t;
typedef short bf16x8 __attribute__((ext_vector_type(8)));
typedef float f32x4 __attribute__((ext_vector_type(4)));
typedef float f32x2 __attribute__((ext_vector_type(2)));
typedef unsigned u32x4 __attribute__((ext_vector_type(4)));
typedef unsigned u32x2 __attribute__((ext_vector_type(2)));

constexpr int D = 2048, FF = 5632, NBP = 4, SEQ = 2048, NMETA = 16, LP = SEQ + NMETA  , NBS = 128, LS = 4;
constexpr int MPR = NBP * LP  , MSA = NBS * LS  , MV = MPR + MSA  , MP = 8960  ;
constexpr int WPOOL = 1024, WSSM = 1024, NG = 64, NP = 64, GS = 16, WIN = 6144, NCH = LP / 16  ;
constexpr float RMS_EPS = 1e-6f;
constexpr float LOG2E = 1.4426950408889634f;

constexpr size_t O_YP = 0, O_YS = 16777216, O_PP = 17825792, O_PS = 17887232, O_RP = 19853312, O_IP = 19869696, O_RS = 19886080, O_IS = 20410368;

constexpr size_t MiB = 1u << 20;
constexpr size_t WS_WGU = 0;
constexpr size_t WS_WD = 44 * MiB;
constexpr size_t WS_WIN = 66 * MiB;
constexpr size_t WS_PW = 90 * MiB;
constexpr size_t WS_GLU = 91 * MiB;
constexpr size_t WS_WA = 93 * MiB;
constexpr size_t WS_WB = 97 * MiB;
constexpr size_t WS_WOUT = 101 * MiB;
constexpr size_t WS_XN = 110 * MiB;
constexpr size_t WS_X = 145 * MiB;
constexpr size_t WS_R = 215 * MiB;
constexpr size_t WS_H = WS_R;
constexpr size_t WS_UP = WS_R;
constexpr size_t WS_US = WS_R + 35 * MiB;
constexpr size_t WS_T1 = WS_R;
constexpr size_t WS_PB = WS_R + 100 * MiB;
constexpr size_t WS_G = WS_R + 70 * MiB;
constexpr size_t WS_DD = WS_R + 140 * MiB;
constexpr size_t WS_SG = WS_DD + 18 * MiB;
constexpr size_t WS_MRG = WS_SG + 18 * MiB;
constexpr size_t WS_CTL = WS_MRG + 35 * MiB;
constexpr size_t CTL_BYTES = 65536 + 3 * 262144;
constexpr size_t CTL_CNT = 16384, CTL_XBUF = 65536;
constexpr size_t WS_END = WS_CTL + CTL_BYTES;
static_assert((size_t)MP * 2048 * 2 <= 35 * MiB && (size_t)MP * 1024 * 2 <= 18 * MiB && (size_t)MP * FF * 2 <= 140 * MiB, "ws map");

constexpr int LDS_BYTES = 147456;

__device__ __forceinline__ unsigned f2bf(float f) { unsigned u = __builtin_bit_cast(unsigned, f); return (u + 0x7fffu + ((u >> 16) & 1u)) >> 16; }
__device__ __forceinline__ float bf2f(unsigned b) { return __builtin_bit_cast(float, b << 16); }
typedef __bf16 bf16x2v __attribute__((ext_vector_type(2)));
__device__ __forceinline__ unsigned cvt_pk_bf16(float lo, float hi) { const f32x2 v = {lo, hi}; const bf16x2v b = __builtin_convertvector(v, bf16x2v); return __builtin_bit_cast(unsigned, b); }
__device__ __forceinline__ u32x4 pack8(f32x4 a, f32x4 b) { u32x4 w; w.x = cvt_pk_bf16(a[0], a[1]); w.y = cvt_pk_bf16(a[2], a[3]); w.z = cvt_pk_bf16(b[0], b[1]); w.w = cvt_pk_bf16(b[2], b[3]); return w; }
__device__ __forceinline__ void unpack8(u32x4 w, f32x4& a, f32x4& b) {
    a[0] = __builtin_bit_cast(float, w.x << 16); a[1] = __builtin_bit_cast(float, w.x & 0xffff0000u); a[2] = __builtin_bit_cast(float, w.y << 16); a[3] = __builtin_bit_cast(float, w.y & 0xffff0000u);
    b[0] = __builtin_bit_cast(float, w.z << 16); b[1] = __builtin_bit_cast(float, w.z & 0xffff0000u); b[2] = __builtin_bit_cast(float, w.w << 16); b[3] = __builtin_bit_cast(float, w.w & 0xffff0000u); }
__device__ __forceinline__ float sigm(float x) { return __builtin_amdgcn_rcpf(1.0f + __builtin_amdgcn_exp2f(-LOG2E * x)); }
__device__ __forceinline__ f32x4 sigm4(f32x4 x) { f32x4 r; r[0] = sigm(x[0]); r[1] = sigm(x[1]); r[2] = sigm(x[2]); r[3] = sigm(x[3]); return r; }
__device__ __forceinline__ float gelu_tanh(float x) { const float z = 1.5957691216057308f * (x + 0.044715f * x * x * x); return x * sigm(z); }
__device__ __forceinline__ float wave_sum(float v) {
#pragma unroll
    for (int o = 1; o < 64; o <<= 1) v += __shfl_xor(v, o);
    return v;
}

struct X0Src { const float* meta; const float* xp; const float* xs; };
__device__ __forceinline__ const float* x0_row(const X0Src& s, int r) {
    if (r < MPR) { const int b = r / LP, t = r - b * LP; return t < NMETA ? s.meta + (size_t)t * D : s.xp + ((size_t)b * SEQ + (t - NMETA)) * D; }
    if (r < MV) return s.xs + (size_t)(r - MPR) * D;
    return nullptr;
}

namespace pg8 {
constexpr int BM = 256, BK = 64, HALF = 128, HTB = HALF * BK * 2, NXCD = 8, WGM = 8;
__host__ __device__ __forceinline__ int lds_byte(int r, int c) { const int st = (r >> 4) * 2 + (c >> 5), rr = r & 15, cc = c & 31, ob = rr * 64 + cc * 2; return st * 1024 + (ob ^ (((ob >> 9) & 1) << 5)); }
__host__ __device__ __forceinline__ void stage_rc(int b, int& R, int& C) { const int st = b / 1024, sb = b % 1024, swz = sb ^ (((sb >> 9) & 1) << 5); R = (st >> 1) * 16 + swz / 64; C = (st & 1) * 32 + (swz % 64) / 2; }
__host__ __device__ __forceinline__ int perm32(int rho) { const int n = rho >> 4, i = rho & 15; return 8 * (i >> 2) + 4 * n + (i & 3); }

struct Unit { int pm, pn, kt0, nkt, full; };
struct Gemm { const bf16_t* A; const bf16_t* Bt; int lda, ldb, M, N, K, a_pn_bytes; };

struct StaticOrder {
    int nM, nN, nwg, G, c, nkt;
    __device__ void init(int M, int N, int G_, int c_, int K = 0) { nM = M / BM; nN = N / BM; nwg = nM * nN; G = G_; c = c_; nkt = K / BK; }
    __device__ bool next(int i, Unit& u) const {
        const long L = (long)i * G + c; if (L >= nwg) return false;
        int wgid = (int)L; { const int q = nwg / NXCD, r = nwg % NXCD, xcd = wgid % NXCD, off = wgid / NXCD; wgid = (xcd < r ? xcd * (q + 1) : r * (q + 1) + (xcd - r) * q) + off; }
        const int nig = WGM * nN, gid = wgid / nig, fm = gid * WGM, gsz = (nM - fm) < WGM ? (nM - fm) : WGM;
        u.pm = fm + ((wgid % nig) % gsz); u.pn = (wgid % nig) / gsz; u.kt0 = 0; u.nkt = nkt; u.full = 1; return true;
    }
};
struct PadOrder {
    StaticOrder so; int c, nN, nkt;
    __device__ void init(int N, int K, int G, int c_) { so.init((MP / BM - 1) * BM, N, G, c_, K); c = c_; nN = N / BM; nkt = K / BK; }
    __device__ bool next(int i, Unit& u) const {
        if (so.next(i, u)) return true;
        const int n0 = so.nwg / so.G, rem = so.nwg - n0 * so.G;
        if (i < n0 || c < rem) return false;
        const int f = (i - n0) * (so.G - rem) + (c - rem); if (f >= nN) return false;
        u.pm = MP / BM - 1; u.pn = f; u.kt0 = 0; u.nkt = nkt; u.full = 1; return true;
    }
};
constexpr int TS_ROWS0 = 8192, TS_NSPLIT = 4;
struct TailSplitOrder {
    StaticOrder so; int c, nkt, mode;
    __device__ void init(int N, int K, int G, int c_, int mode_ = 0) { so.init(TS_ROWS0, N, G, c_, K); c = c_; nkt = K / BK; mode = mode_; }
    __device__ bool next(int i, Unit& u) const {
        if (mode == 2) ++i;
        if (i == 0) return so.next(0, u);
        if (i > 1 || mode == 1 || c >= 24 * TS_NSPLIT) return false;
        const int t = c / TS_NSPLIT, kq = c % TS_NSPLIT;
        u.pm = TS_ROWS0 / BM + (t >> 3); u.pn = t & 7; u.nkt = nkt / TS_NSPLIT; u.kt0 = kq * u.nkt; u.full = 0; return true;
    }
};

template <class Epi, class Order>
__device__ __forceinline__ void gemm_phase(LAS unsigned char* lds, const Gemm g, const Order& S, const Epi& E) {
    int tid_ = threadIdx.x; asm volatile("" : "+v"(tid_));
    const int tid = tid_, wid = __builtin_amdgcn_readfirstlane(tid >> 6), lane = tid & 63, wr = wid >> 2, wc = wid & 3, fr = lane & 15, fq = lane >> 4;
    unsigned voffA[2], voffB[2];
#pragma unroll
    for (int i = 0; i < 2; ++i) { int R, C; stage_rc(tid * 16 + i * 8192, R, C); const int Rb = (R & ~31) + perm32(R & 31);
        voffA[i] = (unsigned)(R * g.lda + C) * 2u; voffB[i] = (unsigned)(Rb * g.ldb + C) * 2u; }
    const size_t kstep = (size_t)(BK * 2);
    const size_t hstepA = (size_t)HALF * g.lda * 2, hstepB = (size_t)HALF * g.ldb * 2;
    const size_t tstepA = 2 * hstepA, tstepB = 2 * hstepB;
    const unsigned ldsw = (unsigned)wid * 1024u;
    const int aoff = lds_byte(wr * 64 + fr, fq * 8), boff = lds_byte(wc * 32 + fr, fq * 8);
#define PG8_SA(b, h) (((b) * 2 + (h)) * HTB)
#define PG8_SB(b, h) ((4 + (b) * 2 + (h)) * HTB)
#define PG8_STAGE(bufoff, gbase, voff) do { _Pragma("unroll") for (int _i = 0; _i < 2; ++_i) \
        __builtin_amdgcn_global_load_lds((const unsigned*)((const char*)(gbase) + (voff)[_i]), (LAS unsigned*)(lds + (bufoff) + ldsw + _i * 8192), 16, 0, 0); } while (0)
#define PG8_LDA(dst, b, h) do { _Pragma("unroll") for (int m = 0; m < 4; ++m) _Pragma("unroll") for (int k = 0; k < 2; ++k) dst[m][k] = *(const LAS bf16x8*)(lds + PG8_SA(b, h) + aoff + m * 2048 + k * 1024); } while (0)
#define PG8_LDB(dst, b, h) do { _Pragma("unroll") for (int n = 0; n < 2; ++n) _Pragma("unroll") for (int k = 0; k < 2; ++k) dst[n][k] = *(const LAS bf16x8*)(lds + PG8_SB(b, h) + boff + n * 2048 + k * 1024); } while (0)
#define PG8_MMA(ai, bj, At, Bt) do { __builtin_amdgcn_s_setprio(1); _Pragma("unroll") for (int m = 0; m < 4; ++m) _Pragma("unroll") for (int n = 0; n < 2; ++n) _Pragma("unroll") for (int k = 0; k < 2; ++k) \
        acc[ai][bj][m][n] = __builtin_amdgcn_mfma_f32_16x16x32_bf16(Bt[n][k], At[m][k], acc[ai][bj][m][n], 0, 0, 0); __builtin_amdgcn_s_setprio(0); } while (0)
#define PG8_WAIT_V(n) asm volatile("s_waitcnt vmcnt(" #n ")" ::: "memory")
#define PG8_WAIT_L(n) asm volatile("s_waitcnt lgkmcnt(" #n ")" ::: "memory")
#define PG8_BAR __builtin_amdgcn_s_barrier()
#define PG8_SCHED __builtin_amdgcn_sched_barrier(0)
    Unit cur, nxt; int ui = 0;
    if (!S.next(0, cur)) return;
    f32x4 acc[2][2][4][2];
#pragma unroll
    for (int a = 0; a < 2; ++a)
#pragma unroll
        for (int b = 0; b < 2; ++b)
#pragma unroll
            for (int m = 0; m < 4; ++m)
#pragma unroll
                for (int n = 0; n < 2; ++n) acc[a][b][m][n] = (f32x4){0.f, 0.f, 0.f, 0.f};
    bf16x8 At[4][2], B0[2][2], B1[2][2];
    const char* cA = (const char*)g.A + (size_t)cur.pm * tstepA + (size_t)cur.pn * g.a_pn_bytes + (size_t)cur.kt0 * kstep; const char* cB = (const char*)g.Bt + (size_t)cur.pn * tstepB + (size_t)cur.kt0 * kstep;
    PG8_STAGE(PG8_SB(0, 0), cB, voffB); PG8_STAGE(PG8_SB(0, 1), cB + hstepB, voffB); PG8_STAGE(PG8_SA(0, 0), cA, voffA); PG8_STAGE(PG8_SA(0, 1), cA + hstepA, voffA);
    if (wr == 1) PG8_BAR;
    PG8_WAIT_V(2); PG8_BAR;
    PG8_STAGE(PG8_SB(1, 0), cB + kstep, voffB); PG8_STAGE(PG8_SA(1, 0), cA + kstep, voffA); PG8_STAGE(PG8_SB(1, 1), cB + hstepB + kstep, voffB);
    PG8_WAIT_V(6); PG8_BAR;
    for (;;) {
        const bool has_next = S.next(ui + 1, nxt);
        const char* nA = has_next ? (const char*)g.A + (size_t)nxt.pm * tstepA + (size_t)nxt.pn * g.a_pn_bytes + (size_t)nxt.kt0 * kstep : cA; const char* nB = has_next ? (const char*)g.Bt + (size_t)nxt.pn * tstepB + (size_t)nxt.kt0 * kstep : cB;
        const int nt = cur.nkt;
        const int row_w = __builtin_amdgcn_readfirstlane(cur.pm) * BM + wr * 64;
        const bool do0 = row_w < MV, do1 = row_w + HALF < MV;
        if (do0 && do1) {
        for (int t = 0; t < nt; t += 2) {
            const bool last = (t == nt - 2);
            const char* a1 = cA + (size_t)(t + 1) * kstep;
            const char* a2 = last ? nA : cA + (size_t)(t + 2) * kstep; const char* b2 = last ? nB : cB + (size_t)(t + 2) * kstep;
            const char* a3 = a2 + kstep; const char* b3 = b2 + kstep;
            PG8_LDB(B0, 0, 0); PG8_LDB(B1, 0, 1); PG8_SCHED; PG8_LDA(At, 0, 0); PG8_STAGE(PG8_SA(1, 1), a1 + hstepA, voffA);
            PG8_WAIT_V(8); PG8_WAIT_L(0); PG8_BAR; { PG8_MMA(0, 0, At, B0); PG8_MMA(0, 1, At, B1); } PG8_BAR; PG8_SCHED;
            PG8_LDA(At, 0, 1); PG8_STAGE(PG8_SB(0, 0), b2, voffB); PG8_STAGE(PG8_SB(0, 1), b2 + hstepB, voffB); PG8_STAGE(PG8_SA(0, 0), a2, voffA);
            PG8_WAIT_V(8); PG8_WAIT_L(0); PG8_BAR; { PG8_MMA(1, 0, At, B0); PG8_MMA(1, 1, At, B1); } PG8_BAR; PG8_SCHED;
            PG8_LDB(B0, 1, 0); PG8_LDB(B1, 1, 1); PG8_SCHED; PG8_LDA(At, 1, 0); PG8_STAGE(PG8_SA(0, 1), a2 + hstepA, voffA);
            PG8_WAIT_V(8); PG8_WAIT_L(0); PG8_BAR; { PG8_MMA(0, 0, At, B0); PG8_MMA(0, 1, At, B1); } PG8_BAR; PG8_SCHED;
            PG8_LDA(At, 1, 1); PG8_STAGE(PG8_SB(1, 0), b3, voffB); PG8_STAGE(PG8_SB(1, 1), b3 + hstepB, voffB); PG8_STAGE(PG8_SA(1, 0), a3, voffA);
            PG8_WAIT_V(8); PG8_WAIT_L(0); PG8_BAR; { PG8_MMA(1, 0, At, B0); PG8_MMA(1, 1, At, B1); } PG8_BAR; PG8_SCHED;
        }
        } else {
        for (int t = 0; t < nt; t += 2) {
            const bool last = (t == nt - 2);
            const char* a1 = cA + (size_t)(t + 1) * kstep;
            const char* a2 = last ? nA : cA + (size_t)(t + 2) * kstep; const char* b2 = last ? nB : cB + (size_t)(t + 2) * kstep;
            const char* a3 = a2 + kstep; const char* b3 = b2 + kstep;
            PG8_LDB(B0, 0, 0); PG8_LDB(B1, 0, 1); PG8_SCHED; PG8_LDA(At, 0, 0); PG8_STAGE(PG8_SA(1, 1), a1 + hstepA, voffA);
            PG8_WAIT_V(8); PG8_WAIT_L(0); PG8_BAR; if (do0) { PG8_MMA(0, 0, At, B0); PG8_MMA(0, 1, At, B1); } PG8_BAR; PG8_SCHED;
            PG8_LDA(At, 0, 1); PG8_STAGE(PG8_SB(0, 0), b2, voffB); PG8_STAGE(PG8_SB(0, 1), b2 + hstepB, voffB); PG8_STAGE(PG8_SA(0, 0), a2, voffA);
            PG8_WAIT_V(8); PG8_WAIT_L(0); PG8_BAR; if (do1) { PG8_MMA(1, 0, At, B0); PG8_MMA(1, 1, At, B1); } PG8_BAR; PG8_SCHED;
            PG8_LDB(B0, 1, 0); PG8_LDB(B1, 1, 1); PG8_SCHED; PG8_LDA(At, 1, 0); PG8_STAGE(PG8_SA(0, 1), a2 + hstepA, voffA);
            PG8_WAIT_V(8); PG8_WAIT_L(0); PG8_BAR; if (do0) { PG8_MMA(0, 0, At, B0); PG8_MMA(0, 1, At, B1); } PG8_BAR; PG8_SCHED;
            PG8_LDA(At, 1, 1); PG8_STAGE(PG8_SB(1, 0), b3, voffB); PG8_STAGE(PG8_SB(1, 1), b3 + hstepB, voffB); PG8_STAGE(PG8_SA(1, 0), a3, voffA);
            PG8_WAIT_V(8); PG8_WAIT_L(0); PG8_BAR; if (do1) { PG8_MMA(1, 0, At, B0); PG8_MMA(1, 1, At, B1); } PG8_BAR; PG8_SCHED;
        }
        }
        if (wr == 0) PG8_BAR;
        if constexpr (Epi::FUSED) E.fused(acc, cur, wr, wc, fr, fq, lds, wid, lane); else E(acc, cur, wr, wc, fr, fq);
        if (!has_next) break;
#pragma unroll
        for (int a = 0; a < 2; ++a)
#pragma unroll
            for (int b = 0; b < 2; ++b)
#pragma unroll
                for (int m = 0; m < 4; ++m)
#pragma unroll
                    for (int n = 0; n < 2; ++n) acc[a][b][m][n] = (f32x4){0.f, 0.f, 0.f, 0.f};
        cur = nxt; cA = nA; cB = nB; ++ui;
        if (wr == 1) PG8_BAR;
    }
    PG8_WAIT_V(0);
    PG8_BAR;
#undef PG8_SA
#undef PG8_SB
#undef PG8_STAGE
#undef PG8_LDA
#undef PG8_LDB
#undef PG8_MMA
#undef PG8_WAIT_V
#undef PG8_WAIT_L
#undef PG8_BAR
#undef PG8_SCHED
}

typedef const f32x4 (&AccRef)[2][2][4][2];
#define EPI_ROWS(...) _Pragma("unroll") for (int ai = 0; ai < 2; ++ai) _Pragma("unroll") for (int m = 0; m < 4; ++m) { const int r = u.pm * BM + ai * HALF + wr * 64 + m * 16 + fr; __VA_ARGS__; asm volatile("" ::: "memory"); }

struct EpiSwiGLU { static constexpr bool FUSED = false;
    bf16_t* H;
    __device__ __forceinline__ void operator()(AccRef acc, const Unit& u, int wr, int wc, int fr, int fq) const {
        const int col0 = u.pn * 128 + wc * 32 + 8 * fq;
        EPI_ROWS({
            const f32x4 g0 = acc[ai][0][m][0], g1 = acc[ai][0][m][1];
            const f32x4 v0 = g0 * sigm4(g0) * acc[ai][1][m][0], v1 = g1 * sigm4(g1) * acc[ai][1][m][1];
            *(u32x4*)(H + (size_t)r * FF + col0) = pack8(v0, v1);
        })
    }
};
template <bool X0> struct EpiAdd { static constexpr bool FUSED = false;
    X0Src src; float* out; float* pb; float scale;
    __device__ __forceinline__ void operator()(AccRef acc, const Unit& u, int wr, int wc, int fr, int fq) const {
        const int col0 = u.pn * BM + wc * 32 + 8 * fq;
        if (u.kt0 == 0) {
            EPI_ROWS({
                float* op = out + (size_t)r * D + col0; const float* bp = X0 ? x0_row(src, r) : out + (size_t)r * D;
                _Pragma("unroll") for (int bj = 0; bj < 2; ++bj) {
                    f32x4 b0 = (f32x4){0.f, 0.f, 0.f, 0.f}, b1 = b0;
                    if (!X0 || bp) { b0 = *(const f32x4*)(bp + col0 + bj * HALF); b1 = *(const f32x4*)(bp + col0 + bj * HALF + 4); }
                    *(f32x4*)(op + bj * HALF) = b0 + scale * acc[ai][bj][m][0]; *(f32x4*)(op + bj * HALF + 4) = b1 + scale * acc[ai][bj][m][1]; }
            })
        } else {
            float* pbq = pb + (size_t)(u.kt0 / u.nkt - 1) * ((size_t)(MP - TS_ROWS0) * D) - (size_t)TS_ROWS0 * D;
            EPI_ROWS({
                float* op = pbq + (size_t)r * D + col0;
                _Pragma("unroll") for (int bj = 0; bj < 2; ++bj) { *(f32x4*)(op + bj * HALF) = scale * acc[ai][bj][m][0]; *(f32x4*)(op + bj * HALF + 4) = scale * acc[ai][bj][m][1]; }
            })
        }
    }
};
template <int MODE  , bool X0> struct EpiDownFinal { static constexpr bool FUSED = true;
    X0Src src; float* X; float scale; const float* gain; float* out; bf16_t* XN; unsigned* xbuf; unsigned* cnt;
    __device__ __forceinline__ void fused(f32x4 (&acc)[2][2][4][2], const Unit& u, int wr, int wc, int fr, int fq, LAS unsigned char* lds, int wid, int lane) const {
        const int col0 = u.pn * BM + wc * 32 + 8 * fq;
        int c1 = col0, pm1 = u.pm, rb1 = wr * 64 + fr, wc1 = wc; asm volatile("" : "+v"(c1), "+s"(pm1), "+v"(rb1), "+v"(wc1));
        LAS float* P = (LAS float*)(lds + 131072);
        LAS float* S = (LAS float*)(lds + 131072 + 4096);
#pragma unroll
        for (int ai = 0; ai < 2; ++ai)
#pragma unroll
            for (int m = 0; m < 4; ++m) { const int r = pm1 * BM + ai * HALF + m * 16 + rb1; const float* xp = (X0 ? x0_row(src, r) : X + (size_t)r * D) + c1; float* xo = X + (size_t)r * D + c1; float q = 0.f;
#pragma unroll
                for (int bj = 0; bj < 2; ++bj)
#pragma unroll
                    for (int n = 0; n < 2; ++n) { const f32x4 b = *(const f32x4*)(xp + bj * HALF + 4 * n); const f32x4 v = b + scale * acc[ai][bj][m][n]; acc[ai][bj][m][n] = v;
                        if (MODE == 1) *(f32x4*)(xo + bj * HALF + 4 * n) = v;
                        q += (v[0] * v[0] + v[1] * v[1]) + (v[2] * v[2] + v[3] * v[3]); }
                q += __shfl_xor(q, 16); q += __shfl_xor(q, 32);
                if (fq == 0) P[(ai * HALF + m * 16 + rb1) * 4 + wc1] = q;
                asm volatile("" ::: "memory"); }
        asm volatile("s_waitcnt lgkmcnt(0)" ::: "memory"); __builtin_amdgcn_s_barrier(); asm volatile("" ::: "memory");
        int row = wid * 32 + (lane & 31); asm volatile("" : "+v"(row));
        if (lane < 32) { const float t = (P[row * 4 + 0] + P[row * 4 + 1]) + (P[row * 4 + 2] + P[row * 4 + 3]);
            __hip_atomic_store(xbuf + ((size_t)(u.pm * BM + row) * 8 + u.pn), __builtin_bit_cast(unsigned, t), __ATOMIC_RELAXED, __HIP_MEMORY_SCOPE_AGENT); }
        asm volatile("s_waitcnt vmcnt(0)" ::: "memory");
        if (lane == 0) (void)__hip_atomic_fetch_add(cnt + 64 * u.pm, 1u, __ATOMIC_RELAXED, __HIP_MEMORY_SCOPE_AGENT);
        if (wid == 0) { unsigned sp = 0;
            _Pragma("unroll 1") while ((unsigned)__builtin_amdgcn_readfirstlane(__hip_atomic_load(cnt + 64 * u.pm, __ATOMIC_RELAXED, __HIP_MEMORY_SCOPE_AGENT)) < 64u) { __builtin_amdgcn_s_sleep(2); if (++sp > (1u << 22)) break; }
            __builtin_amdgcn_fence(__ATOMIC_ACQUIRE, "agent"); }
        asm volatile("s_waitcnt vmcnt(0) lgkmcnt(0)" ::: "memory"); __builtin_amdgcn_s_barrier(); asm volatile("" ::: "memory");
        if (lane < 32) { const unsigned* sl = xbuf + (size_t)(u.pm * BM + row) * 8; float t = 0.f;
#pragma unroll
            for (int k = 0; k < 8; ++k) t += __builtin_bit_cast(float, __hip_atomic_load(sl + k, __ATOMIC_RELAXED, __HIP_MEMORY_SCOPE_AGENT));
            S[row] = 1.0f / sqrtf(t * (1.0f / D) + RMS_EPS); }
        asm volatile("s_waitcnt vmcnt(0) lgkmcnt(0)" ::: "memory"); __builtin_amdgcn_s_barrier(); asm volatile("" ::: "memory");
        int c5 = col0, pm5 = u.pm, rb5 = wr * 64 + fr; asm volatile("" : "+v"(c5), "+s"(pm5), "+v"(rb5));
        const int b0 = (pm5 * BM) / LP, t0 = pm5 * BM - b0 * LP;
#pragma unroll
        for (int ai = 0; ai < 2; ++ai)
#pragma unroll
            for (int m = 0; m < 4; ++m) { const int rl = ai * HALF + m * 16 + rb5; const float rs = S[rl];
                if (MODE == 0) { int t = t0 + rl, b = b0; if (t >= LP) { t -= LP; ++b; }
                    if (t >= NMETA) { float* op = out + O_YP + ((size_t)b * SEQ + (t - NMETA)) * D + c5;
#pragma unroll
                        for (int bj = 0; bj < 2; ++bj) { const f32x4 g0 = *(const f32x4*)(gain + c5 + bj * HALF), g1 = *(const f32x4*)(gain + c5 + bj * HALF + 4);
                            *(f32x4*)(op + bj * HALF) = acc[ai][bj][m][0] * rs * g0; *(f32x4*)(op + bj * HALF + 4) = acc[ai][bj][m][1] * rs * g1; } } }
                else { bf16_t* op = XN + (size_t)(pm5 * BM + rl) * D + c5;
#pragma unroll
                    for (int bj = 0; bj < 2; ++bj) { const f32x4 g0 = *(const f32x4*)(gain + c5 + bj * HALF), g1 = *(const f32x4*)(gain + c5 + bj * HALF + 4);
                        *(u32x4*)(op + bj * HALF) = pack8(acc[ai][bj][m][0] * rs * g0, acc[ai][bj][m][1] * rs * g1); } }
                asm volatile("" ::: "memory"); }
    }
};
struct EpiWin { static constexpr bool FUSED = false;
    float* UP; float* US; bf16_t* G; const float* bg;
    __device__ __forceinline__ void operator()(AccRef acc, const Unit& u, int wr, int wc, int fr, int fq) const {
        if (u.pn < 8) {
            float* O = (u.pn < 4 ? UP : US); const int col0 = (u.pn & 3) * BM + wc * 32 + 8 * fq;
            EPI_ROWS({
                float* op = O + (size_t)r * 1024 + col0;
                _Pragma("unroll") for (int bj = 0; bj < 2; ++bj) { *(f32x4*)(op + bj * HALF) = acc[ai][bj][m][0]; *(f32x4*)(op + bj * HALF + 4) = acc[ai][bj][m][1]; }
            })
        } else {
            const int col0 = (u.pn - 8) * BM + wc * 32 + 8 * fq;
            f32x4 bv[2][2];
#pragma unroll
            for (int bj = 0; bj < 2; ++bj) { bv[bj][0] = *(const f32x4*)(bg + col0 + bj * HALF); bv[bj][1] = *(const f32x4*)(bg + col0 + bj * HALF + 4); }
            EPI_ROWS({
                bf16_t* op = G + (size_t)r * 4096 + col0;
                _Pragma("unroll") for (int bj = 0; bj < 2; ++bj) *(u32x4*)(op + bj * HALF) = pack8(sigm4(acc[ai][bj][m][0] + bv[bj][0]), sigm4(acc[ai][bj][m][1] + bv[bj][1]));
            })
        }
    }
};
struct EpiPool { static constexpr bool FUSED = false;
    bf16_t* AB; const float* sc;
    __device__ __forceinline__ void operator()(AccRef acc, const Unit& u, int wr, int wc, int fr, int fq) const {
        const int col0 = u.pn * BM + wc * 32 + 8 * fq;
        f32x4 sv[2][2];
#pragma unroll
        for (int bj = 0; bj < 2; ++bj) { sv[bj][0] = *(const f32x4*)(sc + col0 + bj * HALF); sv[bj][1] = *(const f32x4*)(sc + col0 + bj * HALF + 4); }
        EPI_ROWS({
            bf16_t* op = AB + (size_t)r * 2048 + col0;
            _Pragma("unroll") for (int bj = 0; bj < 2; ++bj) *(u32x4*)(op + bj * HALF) = pack8(acc[ai][bj][m][0] * sv[bj][0], acc[ai][bj][m][1] * sv[bj][1]);
        })
    }
};
struct EpiGLU { static constexpr bool FUSED = false;
    bf16_t* AB; const bf16_t* SG; const float* gb;
    __device__ __forceinline__ void operator()(AccRef acc, const Unit& u, int wr, int wc, int fr, int fq) const {
        const int col0 = u.pn * BM + wc * 32 + 8 * fq;
        f32x4 bv[2][2];
#pragma unroll
        for (int bj = 0; bj < 2; ++bj) { bv[bj][0] = *(const f32x4*)(gb + col0 + bj * HALF); bv[bj][1] = *(const f32x4*)(gb + col0 + bj * HALF + 4); }
        EPI_ROWS({
            bf16_t* op = AB + (size_t)r * 2048 + 1024 + col0; const bf16_t* sp = SG + (size_t)r * 1024 + col0;
            _Pragma("unroll") for (int bj = 0; bj < 2; ++bj) { f32x4 s0, s1; unpack8(*(const u32x4*)(sp + bj * HALF), s0, s1);
                *(u32x4*)(op + bj * HALF) = pack8(s0 * sigm4(acc[ai][bj][m][0] + bv[bj][0]), s1 * sigm4(acc[ai][bj][m][1] + bv[bj][1])); }
        })
    }
};
struct EpiBr1 { static constexpr bool FUSED = false;
    bf16_t* T1; const bf16_t* G;
    __device__ __forceinline__ void operator()(AccRef acc, const Unit& u, int wr, int wc, int fr, int fq) const {
        const int col0 = u.pn * BM + wc * 32 + 8 * fq;
        EPI_ROWS({
            bf16_t* op = T1 + (size_t)r * 2048 + col0; const bf16_t* gp = G + (size_t)r * 4096 + col0;
            _Pragma("unroll") for (int bj = 0; bj < 2; ++bj) { f32x4 g0, g1; unpack8(*(const u32x4*)(gp + bj * HALF), g0, g1);
                *(u32x4*)(op + bj * HALF) = pack8(g0 * acc[ai][bj][m][0], g1 * acc[ai][bj][m][1]); }
        })
    }
};
struct EpiBr2 { static constexpr bool FUSED = false;
    const bf16_t* T1; const bf16_t* G; bf16_t* MRG;
    __device__ __forceinline__ void operator()(AccRef acc, const Unit& u, int wr, int wc, int fr, int fq) const {
        const int col0 = u.pn * BM + wc * 32 + 8 * fq;
        EPI_ROWS({
            const bf16_t* tp = T1 + (size_t)r * 2048 + col0; const bf16_t* gp = G + (size_t)r * 4096 + 2048 + col0; bf16_t* op = MRG + (size_t)r * 2048 + col0;
            _Pragma("unroll") for (int bj = 0; bj < 2; ++bj) { f32x4 g0, g1; unpack8(*(const u32x4*)(gp + bj * HALF), g0, g1);
                f32x4 t0, t1; unpack8(*(const u32x4*)(tp + bj * HALF), t0, t1);
                *(u32x4*)(op + bj * HALF) = pack8(t0 + g0 * acc[ai][bj][m][0], t1 + g1 * acc[ai][bj][m][1]); }
        })
    }
};
}

__device__ __forceinline__ void cvt_item(const float* W, int K, int N, bf16_t* WT, int mode, int item, int lane) {
    const int nblk = N >> 6, kb = item / nblk, nb = item - kb * nblk, k0 = kb << 6, n0 = nb << 6;
    const int rg = lane >> 4, nq = lane & 15;
    const float* src = W + (size_t)(k0 + 16 * rg) * N + n0 + 4 * nq;
    f32x4 v[16];
#pragma unroll
    for (int i = 0; i < 16; ++i) v[i] = __builtin_nontemporal_load((const f32x4*)(src + (size_t)i * N));
    const int drow0 = (mode == 0 ? n0 : ((n0 >> 7) * 256 + (mode == 2 ? 128 : 0) + (n0 & 127))) + 4 * nq;
    bf16_t* dst = WT + (size_t)drow0 * K + k0 + 16 * rg;
#pragma unroll
    for (int j = 0; j < 4; ++j)
#pragma unroll
        for (int h = 0; h < 2; ++h) {
            u32x4 w; w.x = cvt_pk_bf16(v[8 * h + 0][j], v[8 * h + 1][j]); w.y = cvt_pk_bf16(v[8 * h + 2][j], v[8 * h + 3][j]);
            w.z = cvt_pk_bf16(v[8 * h + 4][j], v[8 * h + 5][j]); w.w = cvt_pk_bf16(v[8 * h + 6][j], v[8 * h + 7][j]);
            *(u32x4*)(dst + (size_t)j * K + 8 * h) = w; }
}
struct Args { const float* in[33]; float* out; unsigned char* ws; int ph_lo, ph_hi; };
typedef const __attribute__((address_space(4))) Args* ArgsP;
struct Frame {
    ArgsP a; unsigned char* ws; float* out;
    LAS unsigned char* lds; int tid, lane, wave, G, gw, NGW;
};
__device__ __forceinline__ void cvt_ffn(const Frame& F, int i0, int w0, int nw, int part = 0, int nparts = 1) {
    constexpr int IG = (D / 64) * (FF / 64);
    bf16_t* wgu = (bf16_t*)(F.ws + WS_WGU); bf16_t* wd = (bf16_t*)(F.ws + WS_WD);
    const int ib = (int)((long)part * (3 * IG) / nparts), ie = (int)((long)(part + 1) * (3 * IG) / nparts);
    for (int it = ib + w0; it < ie; it += nw) {
        if (it < IG) cvt_item(F.a->in[i0], D, FF, wgu, 1, it, F.lane);
        else if (it < 2 * IG) cvt_item(F.a->in[i0 + 1], D, FF, wgu, 2, it - IG, F.lane);
        else cvt_item(F.a->in[i0 + 2], FF, D, wd, 0, it - 2 * IG, F.lane);
    }
}
__device__ __forceinline__ void cvt_mixer(const Frame& F, int w0, int nw, int it0, int it1) {
    constexpr int I_IN = (D / 64) * (WIN / 64)  , I_PW = 4 * 16, I_GLU = 256, I_A = 16 * 32, I_O = 32 * 32;
    constexpr int TOT = I_IN + I_PW + I_GLU + 2 * I_A + I_O;
    static_assert(TOT == 5440, "mixer conversion items");
    for (int it = it0 + w0; it < it1; it += nw) {
        int r = it;
        if (r < I_IN) { cvt_item(F.a->in[11], D, WIN, (bf16_t*)(F.ws + WS_WIN), 0, r, F.lane); continue; } r -= I_IN;
        if (r < I_PW) { const int g = r >> 4; cvt_item(F.a->in[13] + (size_t)g * 65536, 256, 256, (bf16_t*)(F.ws + WS_PW) + (size_t)g * 65536, 0, r & 15, F.lane); continue; } r -= I_PW;
        if (r < I_GLU) { cvt_item(F.a->in[23], 1024, 1024, (bf16_t*)(F.ws + WS_GLU), 0, r, F.lane); continue; } r -= I_GLU;
        if (r < I_A) { cvt_item(F.a->in[25], 1024, 2048, (bf16_t*)(F.ws + WS_WA), 0, r, F.lane); continue; } r -= I_A;
        if (r < I_A) { cvt_item(F.a->in[26], 1024, 2048, (bf16_t*)(F.ws + WS_WB), 0, r, F.lane); continue; } r -= I_A;
        cvt_item(F.a->in[27], 2048, 2048, (bf16_t*)(F.ws + WS_WOUT), 0, r, F.lane);
    }
}

__device__ __forceinline__ void rms_row(const float* xrow, const float* gain, bf16_t* orow, float* frow, int lane, float* copy = nullptr, const float* pbrow = nullptr, size_t pbstride = 0) {
    f32x4 v[8]; float s = 0.f;
#pragma unroll
    for (int j = 0; j < 8; ++j) { v[j] = ((const f32x4*)xrow)[64 * j + lane]; if (pbrow) { v[j] += ((const f32x4*)pbrow)[64 * j + lane]; v[j] += ((const f32x4*)(pbrow + pbstride))[64 * j + lane]; v[j] += ((const f32x4*)(pbrow + 2 * pbstride))[64 * j + lane]; } s += (v[j][0] * v[j][0] + v[j][1] * v[j][1]) + (v[j][2] * v[j][2] + v[j][3] * v[j][3]); }
    if (copy) {
#pragma unroll
        for (int j = 0; j < 8; ++j) ((f32x4*)copy)[64 * j + lane] = v[j]; }
    const float rs = 1.0f / sqrtf(wave_sum(s) * (1.0f / D) + RMS_EPS);
#pragma unroll
    for (int j = 0; j < 8; ++j) { const f32x4 gg = ((const f32x4*)gain)[64 * j + lane]; const f32x4 o = v[j] * rs * gg;
        if (orow) { u32x2 w; w.x = cvt_pk_bf16(o[0], o[1]); w.y = cvt_pk_bf16(o[2], o[3]); ((u32x2*)orow)[64 * j + lane] = w; }
        else ((f32x4*)frow)[64 * j + lane] = o; }
}
__device__ __forceinline__ void zero_row_bf16(bf16_t* orow, int lane) {
#pragma unroll
    for (int j = 0; j < 8; ++j) ((u32x2*)orow)[64 * j + lane] = (u32x2){0u, 0u};
}

__device__ __forceinline__ void sincos_r(float x, float& s, float& c) {
    const float k = rintf(x * 0.6366197723675814f);
    float r = fmaf(-k, 1.5707963705062866f, x); r = fmaf(-k, -4.371139000186241e-8f, r);
    const float z = r * r;
    const float sp = r + r * z * (-1.6666654611e-1f + z * (8.3321608736e-3f + z * (-1.9515295891e-4f)));
    const float cp = 1.0f - 0.5f * z + z * z * (4.166664568298827e-2f + z * (-1.388731625493765e-3f + z * 2.443315711809948e-5f));
    const int q = ((int)k) & 3;
    s = (q == 0) ? sp : (q == 1) ? cp : (q == 2) ? -sp : -cp;
    c = (q == 0) ? cp : (q == 1) ? -sp : (q == 2) ? -cp : sp;
}
__device__ __forceinline__ bf16x8 pack8s(f32x4 a, f32x4 b) { const u32x4 w = pack8(a, b); return __builtin_bit_cast(bf16x8, w); }

#define WSYNC() asm volatile("s_waitcnt lgkmcnt(0)" ::: "memory")
struct S5K { float lbr, lbi; bf16x8 bb[8]; bf16x8 cm[4]; f32x4 dsk; };

__device__ __forceinline__ void s5_consts(const Frame& F, int g, LAS float* tab, S5K& k) {
    const int lane = F.lane, i16 = lane & 15, kq = lane >> 4;
    const float lre = F.a->in[15][g * NP + lane], lim = F.a->in[16][g * NP + lane], dt = expf(F.a->in[17][g]);
    const float a = lre * dt, b = lim * dt;
    const float em1 = a * (1.0f + a * (0.5f + a * (1.0f / 6.0f + a * (1.0f / 24.0f + a * (1.0f / 120.0f + a * (1.0f / 720.0f))))));
    const float ea = 1.0f + em1;
    float sh, ch; sincos_r(0.5f * b, sh, ch);
    const float sb = 2.0f * sh * ch, cbm1 = -2.0f * sh * sh, cb = 1.0f + cbm1;
    k.lbr = ea * cb; k.lbi = ea * sb;
    const float rm1 = em1 * cb + cbm1, im1 = ea * sb;
    const float inv = 1.0f / (lre * lre + lim * lim);
    tab[2 * lane] = (rm1 * lre + im1 * lim) * inv; tab[2 * lane + 1] = (im1 * lre - rm1 * lim) * inv;
    WSYNC();
#pragma unroll
    for (int n4 = 0; n4 < 4; ++n4) {
        const int p = 16 * n4 + i16; const float qr = tab[2 * p], qi = tab[2 * p + 1];
        const float* br = F.a->in[18] + ((size_t)g * NP + p) * GS + 8 * (kq & 1); const float* bi = F.a->in[19] + ((size_t)g * NP + p) * GS + 8 * (kq & 1);
        const f32x4 r0 = *(const f32x4*)br, r1 = *(const f32x4*)(br + 4), i0 = *(const f32x4*)bi, i1 = *(const f32x4*)(bi + 4);
        k.bb[n4] = pack8s(qr * r0 - qi * i0, qr * r1 - qi * i1);
        k.bb[4 + n4] = pack8s(qr * i0 + qi * r0, qr * i1 + qi * r1);
    }
#pragma unroll
    for (int s = 0; s < 4; ++s) {
        const float* cp = (s < 2 ? F.a->in[20] : F.a->in[21]) + ((size_t)g * GS + i16) * NP + 32 * (s & 1) + 8 * kq;
        f32x4 c0 = *(const f32x4*)cp, c1 = *(const f32x4*)(cp + 4);
        if (s >= 2) { c0 = -c0; c1 = -c1; }
        k.cm[s] = pack8s(c0, c1);
    }
    k.dsk = *(const f32x4*)(F.a->in[22] + g * GS + 4 * kq);
    WSYNC();
}
__device__ __forceinline__ void s5_ld(const float* US, int row0, int g, int lane, f32x4& u0, f32x4& u1) {
    const float* up = US + (size_t)(row0 + (lane & 15)) * WSSM + g * GS + 8 * ((lane >> 4) & 1);
    u0 = *(const f32x4*)up; u1 = *(const f32x4*)(up + 4);
}
__device__ __forceinline__ void s5_bu(const f32x4 u0, const f32x4 u1, int lane, const S5K& k, LAS float* HB) {
    const int t = lane & 15, kq = lane >> 4;
    u32x4 hi = pack8(u0, u1);
    f32x4 h0, h1; unpack8(hi, h0, h1);
    const u32x4 lo = pack8(u0 - h0, u1 - h1);
    const bf16x8 uop = __builtin_bit_cast(bf16x8, (kq >= 2) ? lo : hi);
#pragma unroll
    for (int n = 0; n < 8; ++n) {
        const f32x4 d = __builtin_amdgcn_mfma_f32_16x16x32_bf16(k.bb[n], uop, (f32x4){0.f, 0.f, 0.f, 0.f}, 0, 0, 0);
        *(LAS f32x4*)(HB + t * 132 + 16 * n + 4 * kq) = d;
    }
    WSYNC();
}
__device__ __forceinline__ void s5_out(const f32x4 uu, bf16_t* SG, int row0, int g, int lane, const S5K& k, const LAS float* HB) {
    const int t = lane & 15, kq = lane >> 4;
    f32x4 acc = (f32x4){0.f, 0.f, 0.f, 0.f};
#pragma unroll
    for (int s = 0; s < 4; ++s) {
        const LAS float* hp = HB + t * 132 + 32 * s + 8 * kq;
        const f32x4 h0 = *(const LAS f32x4*)hp, h1 = *(const LAS f32x4*)(hp + 4);
        acc = __builtin_amdgcn_mfma_f32_16x16x32_bf16(k.cm[s], pack8s(h0, h1), acc, 0, 0, 0);
    }
    const f32x4 y = acc + k.dsk * uu;
    u32x2 w; w.x = cvt_pk_bf16(gelu_tanh(y[0]), gelu_tanh(y[1])); w.y = cvt_pk_bf16(gelu_tanh(y[2]), gelu_tanh(y[3]));
    *(u32x2*)(SG + (size_t)(row0 + t) * WSSM + g * GS + 4 * kq) = w;
    WSYNC();
}

__device__ __forceinline__ void s5_phase(const Frame& F) {
    const float* US = (const float*)(F.ws + WS_US); bf16_t* SG = (bf16_t*)(F.ws + WS_SG);
    LAS f32x2* EB = (LAS f32x2*)F.lds;
    LAS float* HB = (LAS float*)(F.lds + 66048 + F.wave * 8448);
    const int lane = F.lane;
    S5K k;
    for (int item = blockIdx.x; item < NBP * NG; item += F.G) {
        const int b = item >> 6, g = item & 63, rb = b * LP;
        s5_consts(F, g, HB, k);
        f32x4 nu0, nu1; s5_ld(US, rb + 16 * F.wave, g, lane, nu0, nu1);
        for (int c = F.wave; c < NCH; c += 8) {
            const f32x4 u0 = nu0, u1 = nu1; if (c + 8 < NCH) s5_ld(US, rb + 16 * (c + 8), g, lane, nu0, nu1);
            s5_bu(u0, u1, lane, k, HB);
            float br[16], bi[16];
#pragma unroll
            for (int t = 0; t < 16; ++t) { br[t] = HB[t * 132 + lane]; bi[t] = HB[t * 132 + 64 + lane]; }
            float hr = 0.f, hi = 0.f;
#pragma unroll
            for (int t = 0; t < 16; ++t) { const float nr = k.lbr * hr - k.lbi * hi + br[t], ni = k.lbr * hi + k.lbi * hr + bi[t]; hr = nr; hi = ni; }
            EB[c * 64 + lane] = (f32x2){hr, hi};
            WSYNC();
        }
        __syncthreads();
        if (F.wave == 0) {
            float pr = k.lbr, pi = k.lbi;
#pragma unroll
            for (int q = 0; q < 4; ++q) { const float nr = pr * pr - pi * pi, ni = 2.0f * pr * pi; pr = nr; pi = ni; }
            float hr = 0.f, hi = 0.f;
            for (int c0 = 0; c0 < NCH; c0 += 8) {
                f32x2 e[8];
#pragma unroll
                for (int j = 0; j < 8; ++j) e[j] = (c0 + j < NCH) ? EB[(c0 + j) * 64 + lane] : (f32x2){0.f, 0.f};
#pragma unroll
                for (int j = 0; j < 8; ++j) { const float nr = pr * hr - pi * hi + e[j][0], ni = pr * hi + pi * hr + e[j][1]; hr = nr; hi = ni; e[j] = (f32x2){hr, hi}; }
#pragma unroll
                for (int j = 0; j < 8; ++j) if (c0 + j < NCH) EB[(c0 + j) * 64 + lane] = e[j];
            }
            const f32x2 fin = EB[(NCH - 1) * 64 + lane];
            F.out[O_RP + (size_t)(b * NG + g) * NP + lane] = fin[0]; F.out[O_IP + (size_t)(b * NG + g) * NP + lane] = fin[1];
        }
        __syncthreads();
        s5_ld(US, rb + 16 * F.wave, g, lane, nu0, nu1);
        for (int c = F.wave; c < NCH; c += 8) {
            const f32x4 u0 = nu0, u1 = nu1; if (c + 8 < NCH) s5_ld(US, rb + 16 * (c + 8), g, lane, nu0, nu1);
            const f32x4 uu = *(const f32x4*)(US + (size_t)(rb + 16 * c + (lane & 15)) * WSSM + g * GS + 4 * (lane >> 4));
            s5_bu(u0, u1, lane, k, HB);
            float br[16], bi[16];
#pragma unroll
            for (int t = 0; t < 16; ++t) { br[t] = HB[t * 132 + lane]; bi[t] = HB[t * 132 + 64 + lane]; }
            f32x2 h0 = (f32x2){0.f, 0.f}; if (c > 0) h0 = EB[(c - 1) * 64 + lane];
            float hr = h0[0], hi = h0[1];
#pragma unroll
            for (int t = 0; t < 16; ++t) { const float nr = k.lbr * hr - k.lbi * hi + br[t], ni = k.lbr * hi + k.lbi * hr + bi[t]; hr = nr; hi = ni; br[t] = hr; bi[t] = hi; }
#pragma unroll
            for (int t = 0; t < 16; ++t) { HB[t * 132 + lane] = br[t]; HB[t * 132 + 64 + lane] = bi[t]; }
            WSYNC();
            s5_out(uu, SG, rb + 16 * c, g, lane, k, HB);
        }
        __syncthreads();
    }
    for (int it = F.gw; it < NG * (MSA / 16); it += F.NGW) {
        const int g = it >> 5, j = it & 31, row0 = MPR + 16 * j;
        f32x4 u0, u1; s5_ld(US, row0, g, lane, u0, u1);
        const f32x4 uu = *(const f32x4*)(US + (size_t)(row0 + (lane & 15)) * WSSM + g * GS + 4 * (lane >> 4));
        s5_consts(F, g, HB, k);
        s5_bu(u0, u1, lane, k, HB);
        float br[16], bi[16];
#pragma unroll
        for (int t = 0; t < 16; ++t) { br[t] = HB[t * 132 + lane]; bi[t] = HB[t * 132 + 64 + lane]; }
#pragma unroll
        for (int sq = 0; sq < 4; ++sq) {
            const size_t so = ((size_t)(4 * j + sq) * NG + g) * NP + lane;
            float hr = F.a->in[3][so], hi = F.a->in[4][so];
#pragma unroll
            for (int t = 4 * sq; t < 4 * sq + 4; ++t) { const float nr = k.lbr * hr - k.lbi * hi + br[t], ni = k.lbr * hi + k.lbi * hr + bi[t]; hr = nr; hi = ni; br[t] = hr; bi[t] = hi; }
            F.out[O_RS + so] = hr; F.out[O_IS + so] = hi;
        }
#pragma unroll
        for (int t = 0; t < 16; ++t) { HB[t * 132 + lane] = br[t]; HB[t * 132 + 64 + lane] = bi[t]; }
        WSYNC();
        s5_out(uu, SG, row0, g, lane, k, HB);
    }
}

__device__ __forceinline__ void store_d(bf16_t* p, f32x4 d) { u32x2 w; w.x = cvt_pk_bf16(d[0], d[1]); w.y = cvt_pk_bf16(d[2], d[3]); *(u32x2*)p = w; }
template <int W, int T> __device__ __forceinline__ void pool_rows(const f32x4* cur, const f32x4* old, int skip, int avail0, bf16_t* dd) {
    f32x4 u[T], o[W - 1];
#pragma unroll
    for (int k = 0; k < W - 1; ++k) o[k] = (k >= skip) ? old[(size_t)k * 256] : (f32x4){0.f, 0.f, 0.f, 0.f};
#pragma unroll
    for (int t = 0; t < T; ++t) u[t] = cur[(size_t)t * 256];
    f32x4 s = (f32x4){0.f, 0.f, 0.f, 0.f};
#pragma unroll
    for (int k = 0; k < W - 1; ++k) s += o[k];
#pragma unroll
    for (int t = 0; t < T; ++t) {
        s += u[t];
        const int av = avail0 + t + 1; const float inv = 1.0f / (float)(av < W ? av : W);
        store_d(dd + (size_t)t * WPOOL, s * inv - u[t]);
        if (t - (W - 1) >= 0) s -= u[t - (W - 1) >= 0 ? t - (W - 1) : 0]; else s -= o[t < W - 1 ? t : 0];
    }
}
__device__ __forceinline__ void pool_phase(const Frame& F) {
    const f32x4* UP4 = (const f32x4*)(F.ws + WS_UP); bf16_t* DD = (bf16_t*)(F.ws + WS_DD);
    const int half = F.tid >> 8, q = F.tid & 255, grp = __builtin_amdgcn_readfirstlane(q >> 6);
    constexpr int NPI = NBP * NCH  , NSI = NBS;
    for (int it = blockIdx.x * 2 + half; it < NPI + NSI; it += F.G * 2) {
        if (it < NPI) {
            const int b = it / NCH, ch = it - b * NCH, t0 = 16 * ch, rb = b * LP;
            const f32x4* cur = UP4 + (size_t)(rb + t0) * 256 + q; bf16_t* dd = DD + (size_t)(rb + t0) * WPOOL + 4 * q;
            if (grp == 0)      pool_rows<2, 16>(cur, cur - (size_t)1 * 256, 1 - t0 > 0 ? 1 - t0 : 0, t0, dd);
            else if (grp == 1) pool_rows<4, 16>(cur, cur - (size_t)3 * 256, 3 - t0 > 0 ? 3 - t0 : 0, t0, dd);
            else if (grp == 2) pool_rows<8, 16>(cur, cur - (size_t)7 * 256, 7 - t0 > 0 ? 7 - t0 : 0, t0, dd);
            else               pool_rows<16, 16>(cur, cur - (size_t)15 * 256, 15 - t0 > 0 ? 15 - t0 : 0, t0, dd);
        } else {
            const int bs = it - NPI, rs = MPR + 4 * bs; const f32x4* hist = (const f32x4*)F.a->in[2] + (size_t)bs * 15 * 256 + q;
            const f32x4* cur = UP4 + (size_t)rs * 256 + q; bf16_t* dd = DD + (size_t)rs * WPOOL + 4 * q;
            if (grp == 0)      pool_rows<2, 4>(cur, hist + (size_t)14 * 256, 0, 1 << 20, dd);
            else if (grp == 1) pool_rows<4, 4>(cur, hist + (size_t)12 * 256, 0, 1 << 20, dd);
            else if (grp == 2) pool_rows<8, 4>(cur, hist + (size_t)8 * 256, 0, 1 << 20, dd);
            else               pool_rows<16, 4>(cur, hist, 0, 1 << 20, dd);
        }
    }
    const int gt = blockIdx.x * 512 + F.tid, NT = F.G * 512;
    f32x4* pp = (f32x4*)(F.out + O_PP); f32x4* ps = (f32x4*)(F.out + O_PS);
    for (int i = gt; i < NBP * 15 * 256; i += NT) { const int c = i & 255, j = (i >> 8) % 15, b = i / (15 * 256); pp[i] = UP4[(size_t)(b * LP + LP - 15 + j) * 256 + c]; }
    for (int i = gt; i < NBS * 15 * 256; i += NT) { const int c = i & 255, j = (i >> 8) % 15, b = i / (15 * 256);
        ps[i] = (j < 11) ? ((const f32x4*)F.a->in[2])[((size_t)b * 15 + j + 4) * 256 + c] : UP4[(size_t)(MPR + 4 * b + j - 11) * 256 + c]; }
}


#define XB_TMO      128
#define XB_XCNT(j)  (256  + 64 * (j))
#define XB_XSUB(j)  (1280 + 64 * (j))
#define XB_XGEN(j)  (2304 + 64 * (j))
#define XB_TOP      3328
#define XB_TOPGEN   3392
#define XCD_BAR_WORDS 3456
#define XB_SPIN_CAP (1u << 20)
__device__ __forceinline__ unsigned xb_ld(unsigned* p)              { return __hip_atomic_load(p, __ATOMIC_RELAXED, __HIP_MEMORY_SCOPE_AGENT); }
__device__ __forceinline__ unsigned xb_add(unsigned* p, unsigned v) { return __hip_atomic_fetch_add(p, v, __ATOMIC_RELAXED, __HIP_MEMORY_SCOPE_AGENT); }
__device__ __forceinline__ unsigned xb_xcc_id() { return (unsigned)__builtin_amdgcn_s_getreg((3 << 11) | 20) & 0xFu; }
#define XB_SPIN(cond, bar) do { unsigned _sp = 0; while (cond) { __builtin_amdgcn_s_sleep(1); \
    if ((++_sp & 255u) == 0u) { if (xb_ld(&(bar)[XB_TMO])) break; if (_sp > XB_SPIN_CAP) { atomicAdd(&(bar)[XB_TMO], 1u); break; } } } } while (0)
__device__ __forceinline__ void xcd_barrier_complete(unsigned* bar, unsigned x, unsigned& nloc, unsigned& nx) {
    const unsigned G = gridDim.x;
    unsigned sum, cnt, mine, sp = 0u;
    for (;;) {
        sum = 0u; cnt = 0u; mine = 0u;
#pragma unroll
        for (unsigned j = 0; j < 16; ++j) { const unsigned c = xb_ld(&bar[XB_XCNT(j)]); sum += c; cnt += (c > 0u) ? 1u : 0u; mine = (j == x) ? c : mine; }
        if (sum == G) break;
        __builtin_amdgcn_s_sleep(1);
        if ((++sp & 255u) == 0u) { if (xb_ld(&bar[XB_TMO])) break; if (sp > XB_SPIN_CAP) { atomicAdd(&bar[XB_TMO], 1u); break; } }
    }
    nloc = mine > 0u ? mine : 1u; nx = cnt > 0u ? cnt : 1u;
}
__device__ __forceinline__ void xcd_barrier(unsigned* bar, volatile LAS unsigned* st) {
    asm volatile("s_waitcnt vmcnt(0)" ::: "memory");
    __syncthreads();
    if (threadIdx.x == 0) {
        __builtin_amdgcn_s_waitcnt(0);
        const unsigned x = xb_xcc_id();
        unsigned nloc = st[0], nx = st[1];
        if (nloc == 0u) { xcd_barrier_complete(bar, x, nloc, nx); st[0] = nloc; st[1] = nx; }
        const unsigned old = xb_add(&bar[XB_XSUB(x)], 1u);
        const unsigned gen = old / nloc;
        if (old + 1u == (gen + 1u) * nloc) {
            __builtin_amdgcn_fence(__ATOMIC_RELEASE, "agent");
            asm volatile("s_waitcnt vmcnt(0)" ::: "memory");
            const unsigned og = xb_add(&bar[XB_TOP], 1u);
            const unsigned tg = og / nx;
            if (og + 1u == (tg + 1u) * nx) xb_add(&bar[XB_TOPGEN], 1u);
            else XB_SPIN(xb_ld(&bar[XB_TOPGEN]) == tg, bar);
            __builtin_amdgcn_fence(__ATOMIC_ACQUIRE, "agent");
            xb_add(&bar[XB_XGEN(x)], 1u);
            asm volatile("s_waitcnt vmcnt(0)" ::: "memory");
        } else {
            XB_SPIN(xb_ld(&bar[XB_XGEN(x)]) == gen, bar);
            __builtin_amdgcn_fence(__ATOMIC_ACQUIRE, "agent");
            asm volatile("s_waitcnt vmcnt(0)" ::: "memory");
        }
    }
    __syncthreads();
}
constexpr int LDS_BARST = LDS_BYTES - 64;

constexpr int N_PHASES = 14;
#ifndef DBG_STOP
#define DBG_STOP 99
#endif
#ifndef DBG_SRC
#define DBG_SRC WS_UP
#endif

__device__ __forceinline__ Frame make_frame(LAS unsigned char* lds) {
    Frame F;
    ArgsP a = (ArgsP)__builtin_amdgcn_kernarg_segment_ptr(); asm volatile("" : "+s"(a));
    int t = threadIdx.x; asm volatile("" : "+v"(t));
    F.a = a; F.ws = a->ws; F.out = a->out; F.lds = lds;
    F.tid = t; F.lane = t & 63; F.wave = __builtin_amdgcn_readfirstlane(t >> 6); F.G = gridDim.x;
    F.gw = blockIdx.x * 8 + F.wave; F.NGW = F.G * 8;
    return F;
}
#define XN_(F) ((bf16_t*)((F).ws + WS_XN))
#define X_(F) ((float*)((F).ws + WS_X))
#define H_(F) ((bf16_t*)((F).ws + WS_H))
#define VCU_(F) (((F).G & 7) == 0 ? (int)((blockIdx.x & 7) * ((F).G >> 3) + (blockIdx.x >> 3)) : (int)blockIdx.x)
#define PB_(F) ((float*)((F).ws + WS_PB))
#define X0_(F) (X0Src{(F).a->in[5], (F).a->in[0], (F).a->in[1]})

__global__ void __launch_bounds__(512, 2) mk_fwd(Args args) {
    extern __shared__ __attribute__((aligned(16))) unsigned char lds_raw[];
    LAS unsigned char* const lds = (LAS unsigned char*)lds_raw;
    const int lo = args.ph_lo, hi = args.ph_hi;
    if (threadIdx.x < 2) ((volatile LAS unsigned*)(lds + LDS_BARST))[threadIdx.x] = 0u;
    if (threadIdx.x == 0) (void)xb_add((unsigned*)(args.ws + WS_CTL) + XB_XCNT(xb_xcc_id()), 1u);
    __syncthreads();
#define IN(k) (lo <= (k) && (k) < hi && ((k) < DBG_STOP || (k) == 13))
#define SEAM(k) do { if (lo <= (k) && (k) + 1 < hi) { if (hi > 1000) cg::this_grid().sync();   ArgsP a_ = (ArgsP)__builtin_amdgcn_kernarg_segment_ptr(); asm volatile("" : "+s"(a_)); xcd_barrier((unsigned*)(a_->ws + WS_CTL), (volatile LAS unsigned*)(lds + LDS_BARST)); } } while (0)

    if (IN(0)) { const Frame F = make_frame(lds);
        cvt_ffn(F, 7, F.gw, F.NGW);
        const X0Src x0 = X0_(F); bf16_t* XN = XN_(F);
        for (int r = F.gw; r < MP; r += F.NGW) { const float* xr = x0_row(x0, r); if (xr) rms_row(xr, F.a->in[6], XN + (size_t)r * D, nullptr, F.lane); else zero_row_bf16(XN + (size_t)r * D, F.lane); }
    }
    SEAM(0);
    if (IN(1)) { const Frame F = make_frame(lds);
        pg8::Gemm g{XN_(F), (const bf16_t*)(F.ws + WS_WGU), D, D, MP, 2 * FF, D, 0}; pg8::PadOrder S; S.init(2 * FF, D, F.G, blockIdx.x);
        pg8::EpiSwiGLU E{H_(F)}; pg8::gemm_phase(lds, g, S, E); }
    SEAM(1);
    if (IN(2)) { const Frame F = make_frame(lds);
        pg8::Gemm g{H_(F), (const bf16_t*)(F.ws + WS_WD), FF, FF, MP, D, FF, 0}; pg8::TailSplitOrder S; S.init(D, FF, F.G, blockIdx.x, 1);
        pg8::EpiDownFinal<1, true> E{X0_(F), X_(F), 0.5f, F.a->in[10], nullptr, XN_(F), (unsigned*)(F.ws + WS_CTL + CTL_XBUF), (unsigned*)(F.ws + WS_CTL + CTL_CNT)}; pg8::gemm_phase(lds, g, S, E);
        if ((int)blockIdx.x < 24 * pg8::TS_NSPLIT) { const Frame F3 = make_frame(lds);
            pg8::Gemm g3{H_(F3), (const bf16_t*)(F3.ws + WS_WD), FF, FF, MP, D, FF, 0}; pg8::TailSplitOrder S3; S3.init(D, FF, F3.G, blockIdx.x, 2);
            pg8::EpiAdd<true> E3{X0_(F3), X_(F3), PB_(F3), 0.5f}; pg8::gemm_phase(lds, g3, S3, E3); }
        if (lo == 0) { const Frame F2 = make_frame(lds); const int nb = 24 * pg8::TS_NSPLIT;
            if ((int)blockIdx.x >= nb) cvt_mixer(F2, ((int)blockIdx.x - nb) * 8 + F2.wave, (F2.G - nb) * 8, 0, 3904); } }
    SEAM(2);
    if (IN(3)) { const Frame F = make_frame(lds); bf16_t* XN = XN_(F); float* X = X_(F); const float* PB = PB_(F);
        for (int r = pg8::TS_ROWS0 + F.gw; r < MP; r += F.NGW) { if (r < MV) {
                rms_row(X + (size_t)r * D, F.a->in[10], XN + (size_t)r * D, nullptr, F.lane, r >= pg8::TS_ROWS0 ? X + (size_t)r * D : nullptr, r >= pg8::TS_ROWS0 ? PB + (size_t)(r - pg8::TS_ROWS0) * D : nullptr, (size_t)(MP - pg8::TS_ROWS0) * D); }
            else zero_row_bf16(XN + (size_t)r * D, F.lane); } }
    SEAM(3);
    if (IN(4)) { const Frame F = make_frame(lds);
        pg8::Gemm g{XN_(F), (const bf16_t*)(F.ws + WS_WIN), D, D, MP, WIN, D, 0}; pg8::StaticOrder S; S.init(MP, WIN, F.G, blockIdx.x, D);
        pg8::EpiWin E{(float*)(F.ws + WS_UP), (float*)(F.ws + WS_US), (bf16_t*)(F.ws + WS_G), F.a->in[12]}; pg8::gemm_phase(lds, g, S, E);
        { const Frame F2 = make_frame(lds); const int nb = (MP / 256) * (WIN / 256) - 3 * F2.G;
          if ((int)blockIdx.x >= nb) { cvt_ffn(F2, 29, ((int)blockIdx.x - nb) * 8 + F2.wave, (F2.G - nb) * 8, 0, 4); cvt_ffn(F2, 29, ((int)blockIdx.x - nb) * 8 + F2.wave, (F2.G - nb) * 8, 1, 4); } } }
    SEAM(4);
    if (IN(5)) { __syncthreads();
        { const Frame F = make_frame(lds); s5_phase(F); }
        { const Frame F = make_frame(lds); pool_phase(F); }
        __syncthreads(); }
    SEAM(5);
    if (IN(6)) {
        { const Frame F = make_frame(lds);
          pg8::Gemm g{(const bf16_t*)(F.ws + WS_DD), (const bf16_t*)(F.ws + WS_PW), WPOOL, 256, MP, WPOOL, 256, 512}; pg8::StaticOrder S; S.init(MP, WPOOL, F.G, blockIdx.x, 256);
          pg8::EpiPool E{XN_(F), F.a->in[14]}; pg8::gemm_phase(lds, g, S, E); }
        { const Frame F = make_frame(lds);
          pg8::Gemm g{(const bf16_t*)(F.ws + WS_SG), (const bf16_t*)(F.ws + WS_GLU), WSSM, WSSM, MP, WSSM, WSSM, 0}; pg8::StaticOrder S; S.init(MP, WSSM, F.G, (blockIdx.x + F.G / 2) % F.G, WSSM);
          pg8::EpiGLU E{XN_(F), (const bf16_t*)(F.ws + WS_SG), F.a->in[24]}; pg8::gemm_phase(lds, g, S, E); }
    }
    SEAM(6);
    if (IN(7)) { const Frame F = make_frame(lds);
        pg8::Gemm g{XN_(F), (const bf16_t*)(F.ws + WS_WA), 2048, 1024, MP, D, 1024, 0}; pg8::StaticOrder S; S.init(MP, D, F.G, blockIdx.x, 1024);
        pg8::EpiBr1 E{(bf16_t*)(F.ws + WS_T1), (const bf16_t*)(F.ws + WS_G)}; pg8::gemm_phase(lds, g, S, E);
        { const Frame F2 = make_frame(lds); if ((int)blockIdx.x >= 24) { cvt_mixer(F2, ((int)blockIdx.x - 24) * 8 + F2.wave, (F2.G - 24) * 8, 3904, 4416);
              cvt_ffn(F2, 29, ((int)blockIdx.x - 24) * 8 + F2.wave, (F2.G - 24) * 8, 2, 4); } } }
    SEAM(7);
    if (IN(8)) { const Frame F = make_frame(lds);
        pg8::Gemm g{XN_(F) + 1024, (const bf16_t*)(F.ws + WS_WB), 2048, 1024, MP, D, 1024, 0}; pg8::StaticOrder S; S.init(MP, D, F.G, blockIdx.x, 1024);
        pg8::EpiBr2 E{(const bf16_t*)(F.ws + WS_T1), (const bf16_t*)(F.ws + WS_G), (bf16_t*)(F.ws + WS_MRG)}; pg8::gemm_phase(lds, g, S, E);
        { const Frame F2 = make_frame(lds); if ((int)blockIdx.x >= 24) { cvt_mixer(F2, ((int)blockIdx.x - 24) * 8 + F2.wave, (F2.G - 24) * 8, 4416, 5440);
              cvt_ffn(F2, 29, ((int)blockIdx.x - 24) * 8 + F2.wave, (F2.G - 24) * 8, 3, 4); } } }
    SEAM(8);
    if (IN(9)) { const Frame F = make_frame(lds);
        pg8::Gemm g{(const bf16_t*)(F.ws + WS_MRG), (const bf16_t*)(F.ws + WS_WOUT), D, D, MP, D, D, 0}; pg8::TailSplitOrder S; S.init(D, D, F.G, blockIdx.x, 1);
        pg8::EpiDownFinal<1, false> E{X0_(F), X_(F), 1.0f, F.a->in[28], nullptr, XN_(F), (unsigned*)(F.ws + WS_CTL + CTL_XBUF + 262144), (unsigned*)(F.ws + WS_CTL + CTL_CNT) + 2048}; pg8::gemm_phase(lds, g, S, E);
        if ((int)blockIdx.x < 24 * pg8::TS_NSPLIT) { const Frame F3 = make_frame(lds);
            pg8::Gemm g3{(const bf16_t*)(F3.ws + WS_MRG), (const bf16_t*)(F3.ws + WS_WOUT), D, D, MP, D, D, 0}; pg8::TailSplitOrder S3; S3.init(D, D, F3.G, blockIdx.x, 2);
            pg8::EpiAdd<false> E3{X0_(F3), X_(F3), (float*)(F3.ws + WS_DD), 1.0f}; pg8::gemm_phase(lds, g3, S3, E3); } }
    SEAM(9);
    if (IN(10)) { const Frame F = make_frame(lds); bf16_t* XN = XN_(F); float* X = X_(F); const float* PB = (const float*)(F.ws + WS_DD);
        for (int r = pg8::TS_ROWS0 + F.gw; r < MP; r += F.NGW) { if (r < MV) {
                rms_row(X + (size_t)r * D, F.a->in[28], XN + (size_t)r * D, nullptr, F.lane, r >= pg8::TS_ROWS0 ? X + (size_t)r * D : nullptr, r >= pg8::TS_ROWS0 ? PB + (size_t)(r - pg8::TS_ROWS0) * D : nullptr, (size_t)(MP - pg8::TS_ROWS0) * D); }
            else zero_row_bf16(XN + (size_t)r * D, F.lane); } }
    SEAM(10);
    if (IN(11)) { const Frame F = make_frame(lds);
        pg8::Gemm g{XN_(F), (const bf16_t*)(F.ws + WS_WGU), D, D, MP, 2 * FF, D, 0}; pg8::PadOrder S; S.init(2 * FF, D, F.G, blockIdx.x);
        pg8::EpiSwiGLU E{H_(F)}; pg8::gemm_phase(lds, g, S, E); }
    SEAM(11);
    if (IN(12)) { { const Frame F = make_frame(lds);
        pg8::Gemm g{H_(F), (const bf16_t*)(F.ws + WS_WD), FF, FF, MP, D, FF, 0}; pg8::TailSplitOrder S; S.init(D, FF, F.G, blockIdx.x, 1);
        pg8::EpiDownFinal<0, false> E{X0_(F), X_(F), 0.5f, F.a->in[32], F.out, nullptr, (unsigned*)(F.ws + WS_CTL + CTL_XBUF + 2 * 262144), (unsigned*)(F.ws + WS_CTL + CTL_CNT) + 2 * 2048}; pg8::gemm_phase(lds, g, S, E); }
      if ((int)blockIdx.x < 24 * pg8::TS_NSPLIT) { const Frame F = make_frame(lds);
        pg8::Gemm g{H_(F), (const bf16_t*)(F.ws + WS_WD), FF, FF, MP, D, FF, 0}; pg8::TailSplitOrder S; S.init(D, FF, F.G, blockIdx.x, 2);
        pg8::EpiAdd<false> E{X0_(F), X_(F), PB_(F), 0.5f}; pg8::gemm_phase(lds, g, S, E); } }
    SEAM(12);
    if (IN(13) && DBG_STOP < 99) { const Frame F = make_frame(lds);
        const f32x4* src = (const f32x4*)(F.ws + DBG_SRC); f32x4* dst = (f32x4*)F.out;
        for (size_t i = (size_t)blockIdx.x * 512 + F.tid; i < O_PP / 4; i += (size_t)F.G * 512) dst[i] = src[i];
    } else
    if (IN(13)) { const Frame F = make_frame(lds); const float* X = X_(F);
        for (int r = pg8::TS_ROWS0 + F.gw; r < MV; r += F.NGW) {
            float* o;
            if (r < MPR) { const int b = r / LP, t = r - b * LP; if (t < NMETA) continue; o = F.out + O_YP + ((size_t)b * SEQ + (t - NMETA)) * D; }
            else o = F.out + O_YS + (size_t)(r - MPR) * D;
            rms_row(X + (size_t)r * D, F.a->in[32], nullptr, o, F.lane, nullptr, r >= pg8::TS_ROWS0 ? PB_(F) + (size_t)(r - pg8::TS_ROWS0) * D : nullptr, (size_t)(MP - pg8::TS_ROWS0) * D);
        }
    }
#undef IN
#undef SEAM
}

extern "C" void kernel_launch(void* const* d_in, const int* in_sizes, int n_in, void* d_out, int out_size, void* d_ws, size_t ws_size, hipStream_t stream) {
    static int grid = 0;
    if (grid == 0) {
        if (n_in != 33 || ws_size < WS_END) { fprintf(stderr, "kernel_launch: expected 33 inputs and >= %zu bytes of workspace; got %d, %zu\n", (size_t)WS_END, n_in, ws_size); grid = -1; return; }
        int dev = 0, cus = 0, per_cu = 0;
        if (hipGetDevice(&dev) != hipSuccess || hipDeviceGetAttribute(&cus, hipDeviceAttributeMultiprocessorCount, dev) != hipSuccess) { grid = -1; return; }
        if (hipFuncSetAttribute((const void*)mk_fwd, hipFuncAttributeMaxDynamicSharedMemorySize, LDS_BYTES) != hipSuccess) { fprintf(stderr, "kernel_launch: hipFuncSetAttribute failed\n"); grid = -1; return; }
        if (hipOccupancyMaxActiveBlocksPerMultiprocessor(&per_cu, (const void*)mk_fwd, 512, LDS_BYTES) != hipSuccess || per_cu < 1) { fprintf(stderr, "kernel_launch: occupancy query says %d\n", per_cu); per_cu = 1; }
        (void)hipGetLastError();
        grid = cus * per_cu;
        if (grid > 256) grid = 256;
        if (grid != 256) fprintf(stderr, "kernel_launch: this kernel needs a 256-workgroup cooperative grid; got capacity %d\n", grid);
    }
    if (grid < 0) return;
    Args a{};
    for (int i = 0; i < 33; ++i) a.in[i] = (const float*)d_in[i];
    a.out = (float*)d_out; a.ws = (unsigned char*)d_ws;
#if MK_N_LAUNCHES == 1
    if (hipMemsetAsync((char*)d_ws + WS_CTL, 0, CTL_BYTES, stream) != hipSuccess) { fprintf(stderr, "kernel_launch: hipMemsetAsync failed\n"); return; }
    a.ph_lo = 0; a.ph_hi = N_PHASES;
    void* kargs[] = {&a};
    hipError_t e = hipLaunchCooperativeKernel((const void*)mk_fwd, dim3(grid), dim3(512), kargs, LDS_BYTES, stream);
    if (e != hipSuccess) fprintf(stderr, "kernel_launch: cooperative launch failed: %s (grid %d)\n", hipGetErrorString(e), grid);
#else
    for (int p = 0; p < N_PHASES; ++p) { a.ph_lo = p; a.ph_hi = p + 1; hipLaunchKernelGGL(mk_fwd, dim3(grid), dim3(512), LDS_BYTES, stream, a); }
#endif
}
```

```cpp
#include <hip/hip_runtime.h>
#include <hip/hip_cooperative_groups.h>
#include <cstdio>
#include <cstdint>
namespace cg = cooperative_groups;

#ifndef MK_N_LAUNCHES
#define MK_N_LAUNCHES 1
#endif

#define LAS __attribute__((address_space(3)))
typedef unsigned short bf16_t;
typedef short bf16x8 __attribute__((ext_vector_type(8)));
typedef float f32x4 __attribute__((ext_vector_type(4)));
typedef float f32x2 __attribute__((ext_vector_type(2)));
typedef unsigned u32x4 __attribute__((ext_vector_type(4)));
typedef unsigned u32x2 __attribute__((ext_vector_type(2)));

constexpr int D = 2048, FF = 5632, NBP = 4, SEQ = 2048, NMETA = 16, LP = SEQ + NMETA  , NBS = 128, LS = 4;
constexpr int MPR = NBP * LP  , MSA = NBS * LS  , MV = MPR + MSA  , MP = 8960  ;
constexpr int WPOOL = 1024, WSSM = 1024, NG = 64, NP = 64, GS = 16, WIN = 6144, NCH = LP / 16  ;
constexpr float RMS_EPS = 1e-6f;
constexpr float LOG2E = 1.4426950408889634f;

constexpr size_t O_YP = 0, O_YS = 16777216, O_PP = 17825792, O_PS = 17887232, O_RP = 19853312, O_IP = 19869696, O_RS = 19886080, O_IS = 20410368;

constexpr size_t MiB = 1u << 20;
constexpr size_t WS_WGU = 0;
constexpr size_t WS_WD = 44 * MiB;
constexpr size_t WS_WIN = 66 * MiB;
constexpr size_t WS_PW = 90 * MiB;
constexpr size_t WS_GLU = 91 * MiB;
constexpr size_t WS_WA = 93 * MiB;
constexpr size_t WS_WB = 97 * MiB;
constexpr size_t WS_WOUT = 101 * MiB;
constexpr size_t WS_XN = 110 * MiB;
constexpr size_t WS_X = 145 * MiB;
constexpr size_t WS_R = 215 * MiB;
constexpr size_t WS_H = WS_R;
constexpr size_t WS_UP = WS_R;
constexpr size_t WS_US = WS_R + 35 * MiB;
constexpr size_t WS_T1 = WS_R;
constexpr size_t WS_PB = WS_R + 100 * MiB;
constexpr size_t WS_G = WS_R + 70 * MiB;
constexpr size_t WS_DD = WS_R + 140 * MiB;
constexpr size_t WS_SG = WS_DD + 18 * MiB;
constexpr size_t WS_MRG = WS_SG + 18 * MiB;
constexpr size_t WS_CTL = WS_MRG + 35 * MiB;
constexpr size_t CTL_BYTES = 65536 + 3 * 262144;
constexpr size_t CTL_CNT = 16384, CTL_XBUF = 65536;
constexpr size_t WS_END = WS_CTL + CTL_BYTES;
static_assert((size_t)MP * 2048 * 2 <= 35 * MiB && (size_t)MP * 1024 * 2 <= 18 * MiB && (size_t)MP * FF * 2 <= 140 * MiB, "ws map");

constexpr int LDS_BYTES = 147456;

__device__ __forceinline__ unsigned f2bf(float f) { unsigned u = __builtin_bit_cast(unsigned, f); return (u + 0x7fffu + ((u >> 16) & 1u)) >> 16; }
__device__ __forceinline__ float bf2f(unsigned b) { return __builtin_bit_cast(float, b << 16); }
typedef __bf16 bf16x2v __attribute__((ext_vector_type(2)));
__device__ __forceinline__ unsigned cvt_pk_bf16(float lo, float hi) { const f32x2 v = {lo, hi}; const bf16x2v b = __builtin_convertvector(v, bf16x2v); return __builtin_bit_cast(unsigned, b); }
__device__ __forceinline__ u32x4 pack8(f32x4 a, f32x4 b) { u32x4 w; w.x = cvt_pk_bf16(a[0], a[1]); w.y = cvt_pk_bf16(a[2], a[3]); w.z = cvt_pk_bf16(b[0], b[1]); w.w = cvt_pk_bf16(b[2], b[3]); return w; }
__device__ __forceinline__ void unpack8(u32x4 w, f32x4& a, f32x4& b) {
    a[0] = __builtin_bit_cast(float, w.x << 16); a[1] = __builtin_bit_cast(float, w.x & 0xffff0000u); a[2] = __builtin_bit_cast(float, w.y << 16); a[3] = __builtin_bit_cast(float, w.y & 0xffff0000u);
    b[0] = __builtin_bit_cast(float, w.z << 16); b[1] = __builtin_bit_cast(float, w.z & 0xffff0000u); b[2] = __builtin_bit_cast(float, w.w << 16); b[3] = __builtin_bit_cast(float, w.w & 0xffff0000u); }
__device__ __forceinline__ float sigm(float x) { return __builtin_amdgcn_rcpf(1.0f + __builtin_amdgcn_exp2f(-LOG2E * x)); }
__device__ __forceinline__ f32x4 sigm4(f32x4 x) { f32x4 r; r[0] = sigm(x[0]); r[1] = sigm(x[1]); r[2] = sigm(x[2]); r[3] = sigm(x[3]); return r; }
__device__ __forceinline__ float gelu_tanh(float x) { const float z = 1.5957691216057308f * (x + 0.044715f * x * x * x); return x * sigm(z); }
__device__ __forceinline__ float wave_sum(float v) {
#pragma unroll
    for (int o = 1; o < 64; o <<= 1) v += __shfl_xor(v, o);
    return v;
}

struct X0Src { const float* meta; const float* xp; const float* xs; };
__device__ __forceinline__ const float* x0_row(const X0Src& s, int r) {
    if (r < MPR) { const int b = r / LP, t = r - b * LP; return t < NMETA ? s.meta + (size_t)t * D : s.xp + ((size_t)b * SEQ + (t - NMETA)) * D; }
    if (r < MV) return s.xs + (size_t)(r - MPR) * D;
    return nullptr;
}

namespace pg8 {
constexpr int BM = 256, BK = 64, HALF = 128, HTB = HALF * BK * 2, NXCD = 8, WGM = 8;
__host__ __device__ __forceinline__ int lds_byte(int r, int c) { const int st = (r >> 4) * 2 + (c >> 5), rr = r & 15, cc = c & 31, ob = rr * 64 + cc * 2; return st * 1024 + (ob ^ (((ob >> 9) & 1) << 5)); }
__host__ __device__ __forceinline__ void stage_rc(int b, int& R, int& C) { const int st = b / 1024, sb = b % 1024, swz = sb ^ (((sb >> 9) & 1) << 5); R = (st >> 1) * 16 + swz / 64; C = (st & 1) * 32 + (swz % 64) / 2; }
__host__ __device__ __forceinline__ int perm32(int rho) { const int n = rho >> 4, i = rho & 15; return 8 * (i >> 2) + 4 * n + (i & 3); }

struct Unit { int pm, pn, kt0, nkt, full; };
struct Gemm { const bf16_t* A; const bf16_t* Bt; int lda, ldb, M, N, K, a_pn_bytes; };

struct StaticOrder {
    int nM, nN, nwg, G, c, nkt;
    __device__ void init(int M, int N, int G_, int c_, int K = 0) { nM = M / BM; nN = N / BM; nwg = nM * nN; G = G_; c = c_; nkt = K / BK; }
    __device__ bool next(int i, Unit& u) const {
        const long L = (long)i * G + c; if (L >= nwg) return false;
        int wgid = (int)L; { const int q = nwg / NXCD, r = nwg % NXCD, xcd = wgid % NXCD, off = wgid / NXCD; wgid = (xcd < r ? xcd * (q + 1) : r * (q + 1) + (xcd - r) * q) + off; }
        const int nig = WGM * nN, gid = wgid / nig, fm = gid * WGM, gsz = (nM - fm) < WGM ? (nM - fm) : WGM;
        u.pm = fm + ((wgid % nig) % gsz); u.pn = (wgid % nig) / gsz; u.kt0 = 0; u.nkt = nkt; u.full = 1; return true;
    }
};
struct PadOrder {
    StaticOrder so; int c, nN, nkt;
    __device__ void init(int N, int K, int G, int c_) { so.init((MP / BM - 1) * BM, N, G, c_, K); c = c_; nN = N / BM; nkt = K / BK; }
    __device__ bool next(int i, Unit& u) const {
        if (so.next(i, u)) return true;
        const int n0 = so.nwg / so.G, rem = so.nwg - n0 * so.G;
        if (i < n0 || c < rem) return false;
        const int f = (i - n0) * (so.G - rem) + (c - rem); if (f >= nN) return false;
        u.pm = MP / BM - 1; u.pn = f; u.kt0 = 0; u.nkt = nkt; u.full = 1; return true;
    }
};
constexpr int TS_ROWS0 = 8192, TS_NSPLIT = 4;
struct TailSplitOrder {
    StaticOrder so; int c, nkt, mode;
    __device__ void init(int N, int K, int G, int c_, int mode_ = 0) { so.init(TS_ROWS0, N, G, c_, K); c = c_; nkt = K / BK; mode = mode_; }
    __device__ bool next(int i, Unit& u) const {
        if (mode == 2) ++i;
        if (i == 0) return so.next(0, u);
        if (i > 1 || mode == 1 || c >= 24 * TS_NSPLIT) return false;
        const int t = c / TS_NSPLIT, kq = c % TS_NSPLIT;
        u.pm = TS_ROWS0 / BM + (t >> 3); u.pn = t & 7; u.nkt = nkt / TS_NSPLIT; u.kt0 = kq * u.nkt; u.full = 0; return true;
    }
};

template <class Epi, class Order>
__device__ __forceinline__ void gemm_phase(LAS unsigned char* lds, const Gemm g, const Order& S, const Epi& E) {
    int tid_ = threadIdx.x; asm volatile("" : "+v"(tid_));
    const int tid = tid_, wid = __builtin_amdgcn_readfirstlane(tid >> 6), lane = tid & 63, wr = wid >> 2, wc = wid & 3, fr = lane & 15, fq = lane >> 4;
    unsigned voffA[2], voffB[2];
#pragma unroll
    for (int i = 0; i < 2; ++i) { int R, C; stage_rc(tid * 16 + i * 8192, R, C); const int Rb = (R & ~31) + perm32(R & 31);
        voffA[i] = (unsigned)(R * g.lda + C) * 2u; voffB[i] = (unsigned)(Rb * g.ldb + C) * 2u; }
    const size_t kstep = (size_t)(BK * 2);
    const size_t hstepA = (size_t)HALF * g.lda * 2, hstepB = (size_t)HALF * g.ldb * 2;
    const size_t tstepA = 2 * hstepA, tstepB = 2 * hstepB;
    const unsigned ldsw = (unsigned)wid * 1024u;
    const int aoff = lds_byte(wr * 64 + fr, fq * 8), boff = lds_byte(wc * 32 + fr, fq * 8);
#define PG8_SA(b, h) (((b) * 2 + (h)) * HTB)
#define PG8_SB(b, h) ((4 + (b) * 2 + (h)) * HTB)
#define PG8_STAGE(bufoff, gbase, voff) do { _Pragma("unroll") for (int _i = 0; _i < 2; ++_i) \
        __builtin_amdgcn_global_load_lds((const unsigned*)((const char*)(gbase) + (voff)[_i]), (LAS unsigned*)(lds + (bufoff) + ldsw + _i * 8192), 16, 0, 0); } while (0)
#define PG8_LDA(dst, b, h) do { _Pragma("unroll") for (int m = 0; m < 4; ++m) _Pragma("unroll") for (int k = 0; k < 2; ++k) dst[m][k] = *(const LAS bf16x8*)(lds + PG8_SA(b, h) + aoff + m * 2048 + k * 1024); } while (0)
#define PG8_LDB(dst, b, h) do { _Pragma("unroll") for (int n = 0; n < 2; ++n) _Pragma("unroll") for (int k = 0; k < 2; ++k) dst[n][k] = *(const LAS bf16x8*)(lds + PG8_SB(b, h) + boff + n * 2048 + k * 1024); } while (0)
#define PG8_MMA(ai, bj, At, Bt) do { __builtin_amdgcn_s_setprio(1); _Pragma("unroll") for (int m = 0; m < 4; ++m) _Pragma("unroll") for (int n = 0; n < 2; ++n) _Pragma("unroll") for (int k = 0; k < 2; ++k) \
        acc[ai][bj][m][n] = __builtin_amdgcn_mfma_f32_16x16x32_bf16(Bt[n][k], At[m][k], acc[ai][bj][m][n], 0, 0, 0); __builtin_amdgcn_s_setprio(0); } while (0)
#define PG8_WAIT_V(n) asm volatile("s_waitcnt vmcnt(" #n ")" ::: "memory")
#define PG8_WAIT_L(n) asm volatile("s_waitcnt lgkmcnt(" #n ")" ::: "memory")
#define PG8_BAR __builtin_amdgcn_s_barrier()
#define PG8_SCHED __builtin_amdgcn_sched_barrier(0)
    Unit cur, nxt; int ui = 0;
    if (!S.next(0, cur)) return;
    f32x4 acc[2][2][4][2];
#pragma unroll
    for (int a = 0; a < 2; ++a)
#pragma unroll
        for (int b = 0; b < 2; ++b)
#pragma unroll
            for (int m = 0; m < 4; ++m)
#pragma unroll
                for (int n = 0; n < 2; ++n) acc[a][b][m][n] = (f32x4){0.f, 0.f, 0.f, 0.f};
    bf16x8 At[4][2], B0[2][2], B1[2][2];
    const char* cA = (const char*)g.A + (size_t)cur.pm * tstepA + (size_t)cur.pn * g.a_pn_bytes + (size_t)cur.kt0 * kstep; const char* cB = (const char*)g.Bt + (size_t)cur.pn * tstepB + (size_t)cur.kt0 * kstep;
    PG8_STAGE(PG8_SB(0, 0), cB, voffB); PG8_STAGE(PG8_SB(0, 1), cB + hstepB, voffB); PG8_STAGE(PG8_SA(0, 0), cA, voffA); PG8_STAGE(PG8_SA(0, 1), cA + hstepA, voffA);
    if (wr == 1) PG8_BAR;
    PG8_WAIT_V(2); PG8_BAR;
    PG8_STAGE(PG8_SB(1, 0), cB + kstep, voffB); PG8_STAGE(PG8_SA(1, 0), cA + kstep, voffA); PG8_STAGE(PG8_SB(1, 1), cB + hstepB + kstep, voffB);
    PG8_WAIT_V(6); PG8_BAR;
    for (;;) {
        const bool has_next = S.next(ui + 1, nxt);
        const char* nA = has_next ? (const char*)g.A + (size_t)nxt.pm * tstepA + (size_t)nxt.pn * g.a_pn_bytes + (size_t)nxt.kt0 * kstep : cA; const char* nB = has_next ? (const char*)g.Bt + (size_t)nxt.pn * tstepB + (size_t)nxt.kt0 * kstep : cB;
        const int nt = cur.nkt;
        const int row_w = __builtin_amdgcn_readfirstlane(cur.pm) * BM + wr * 64;
        const bool do0 = row_w < MV, do1 = row_w + HALF < MV;
        if (do0 && do1) {
        for (int t = 0; t < nt; t += 2) {
            const bool last = (t == nt - 2);
            const char* a1 = cA + (size_t)(t + 1) * kstep;
            const char* a2 = last ? nA : cA + (size_t)(t + 2) * kstep; const char* b2 = last ? nB : cB + (size_t)(t + 2) * kstep;
            const char* a3 = a2 + kstep; const char* b3 = b2 + kstep;
            PG8_LDB(B0, 0, 0); PG8_LDB(B1, 0, 1); PG8_SCHED; PG8_LDA(At, 0, 0); PG8_STAGE(PG8_SA(1, 1), a1 + hstepA, voffA);
            PG8_WAIT_V(8); PG8_WAIT_L(0); PG8_BAR; { PG8_MMA(0, 0, At, B0); PG8_MMA(0, 1, At, B1); } PG8_BAR; PG8_SCHED;
            PG8_LDA(At, 0, 1); PG8_STAGE(PG8_SB(0, 0), b2, voffB); PG8_STAGE(PG8_SB(0, 1), b2 + hstepB, voffB); PG8_STAGE(PG8_SA(0, 0), a2, voffA);
            PG8_WAIT_V(8); PG8_WAIT_L(0); PG8_BAR; { PG8_MMA(1, 0, At, B0); PG8_MMA(1, 1, At, B1); } PG8_BAR; PG8_SCHED;
            PG8_LDB(B0, 1, 0); PG8_LDB(B1, 1, 1); PG8_SCHED; PG8_LDA(At, 1, 0); PG8_STAGE(PG8_SA(0, 1), a2 + hstepA, voffA);
            PG8_WAIT_V(8); PG8_WAIT_L(0); PG8_BAR; { PG8_MMA(0, 0, At, B0); PG8_MMA(0, 1, At, B1); } PG8_BAR; PG8_SCHED;
            PG8_LDA(At, 1, 1); PG8_STAGE(PG8_SB(1, 0), b3, voffB); PG8_STAGE(PG8_SB(1, 1), b3 + hstepB, voffB); PG8_STAGE(PG8_SA(1, 0), a3, voffA);
            PG8_WAIT_V(8); PG8_WAIT_L(0); PG8_BAR; { PG8_MMA(1, 0, At, B0); PG8_MMA(1, 1, At, B1); } PG8_BAR; PG8_SCHED;
        }
        } else {
        for (int t = 0; t < nt; t += 2) {
            const bool last = (t == nt - 2);
            const char* a1 = cA + (size_t)(t + 1) * kstep;
            const char* a2 = last ? nA : cA + (size_t)(t + 2) * kstep; const char* b2 = last ? nB : cB + (size_t)(t + 2) * kstep;
            const char* a3 = a2 + kstep; const char* b3 = b2 + kstep;
            PG8_LDB(B0, 0, 0); PG8_LDB(B1, 0, 1); PG8_SCHED; PG8_LDA(At, 0, 0); PG8_STAGE(PG8_SA(1, 1), a1 + hstepA, voffA);
            PG8_WAIT_V(8); PG8_WAIT_L(0); PG8_BAR; if (do0) { PG8_MMA(0, 0, At, B0); PG8_MMA(0, 1, At, B1); } PG8_BAR; PG8_SCHED;
            PG8_LDA(At, 0, 1); PG8_STAGE(PG8_SB(0, 0), b2, voffB); PG8_STAGE(PG8_SB(0, 1), b2 + hstepB, voffB); PG8_STAGE(PG8_SA(0, 0), a2, voffA);
            PG8_WAIT_V(8); PG8_WAIT_L(0); PG8_BAR; if (do1) { PG8_MMA(1, 0, At, B0); PG8_MMA(1, 1, At, B1); } PG8_BAR; PG8_SCHED;
            PG8_LDB(B0, 1, 0); PG8_LDB(B1, 1, 1); PG8_SCHED; PG8_LDA(At, 1, 0); PG8_STAGE(PG8_SA(0, 1), a2 + hstepA, voffA);
            PG8_WAIT_V(8); PG8_WAIT_L(0); PG8_BAR; if (do0) { PG8_MMA(0, 0, At, B0); PG8_MMA(0, 1, At, B1); } PG8_BAR; PG8_SCHED;
            PG8_LDA(At, 1, 1); PG8_STAGE(PG8_SB(1, 0), b3, voffB); PG8_STAGE(PG8_SB(1, 1), b3 + hstepB, voffB); PG8_STAGE(PG8_SA(1, 0), a3, voffA);
            PG8_WAIT_V(8); PG8_WAIT_L(0); PG8_BAR; if (do1) { PG8_MMA(1, 0, At, B0); PG8_MMA(1, 1, At, B1); } PG8_BAR; PG8_SCHED;
        }
        }
        if (wr == 0) PG8_BAR;
        if constexpr (Epi::FUSED) E.fused(acc, cur, wr, wc, fr, fq, lds, wid, lane); else E(acc, cur, wr, wc, fr, fq);
        if (!has_next) break;
#pragma unroll
        for (int a = 0; a < 2; ++a)
#pragma unroll
            for (int b = 0; b < 2; ++b)
#pragma unroll
                for (int m = 0; m < 4; ++m)
#pragma unroll
                    for (int n = 0; n < 2; ++n) acc[a][b][m][n] = (f32x4){0.f, 0.f, 0.f, 0.f};
        cur = nxt; cA = nA; cB = nB; ++ui;
        if (wr == 1) PG8_BAR;
    }
    PG8_WAIT_V(0);
    PG8_BAR;
#undef PG8_SA
#undef PG8_SB
#undef PG8_STAGE
#undef PG8_LDA
#undef PG8_LDB
#undef PG8_MMA
#undef PG8_WAIT_V
#undef PG8_WAIT_L
#undef PG8_BAR
#undef PG8_SCHED
}

typedef const f32x4 (&AccRef)[2][2][4][2];
#define EPI_ROWS(...) _Pragma("unroll") for (int ai = 0; ai < 2; ++ai) _Pragma("unroll") for (int m = 0; m < 4; ++m) { const int r = u.pm * BM + ai * HALF + wr * 64 + m * 16 + fr; __VA_ARGS__; asm volatile("" ::: "memory"); }

struct EpiSwiGLU { static constexpr bool FUSED = false;
    bf16_t* H;
    __device__ __forceinline__ void operator()(AccRef acc, const Unit& u, int wr, int wc, int fr, int fq) const {
        const int col0 = u.pn * 128 + wc * 32 + 8 * fq;
        EPI_ROWS({
            const f32x4 g0 = acc[ai][0][m][0], g1 = acc[ai][0][m][1];
            const f32x4 v0 = g0 * sigm4(g0) * acc[ai][1][m][0], v1 = g1 * sigm4(g1) * acc[ai][1][m][1];
            *(u32x4*)(H + (size_t)r * FF + col0) = pack8(v0, v1);
        })
    }
};
template <bool X0> struct EpiAdd { static constexpr bool FUSED = false;
    X0Src src; float* out; float* pb; float scale;
    __device__ __forceinline__ void operator()(AccRef acc, const Unit& u, int wr, int wc, int fr, int fq) const {
        const int col0 = u.pn * BM + wc * 32 + 8 * fq;
        if (u.kt0 == 0) {
            EPI_ROWS({
                float* op = out + (size_t)r * D + col0; const float* bp = X0 ? x0_row(src, r) : out + (size_t)r * D;
                _Pragma("unroll") for (int bj = 0; bj < 2; ++bj) {
                    f32x4 b0 = (f32x4){0.f, 0.f, 0.f, 0.f}, b1 = b0;
                    if (!X0 || bp) { b0 = *(const f32x4*)(bp + col0 + bj * HALF); b1 = *(const f32x4*)(bp + col0 + bj * HALF + 4); }
                    *(f32x4*)(op + bj * HALF) = b0 + scale * acc[ai][bj][m][0]; *(f32x4*)(op + bj * HALF + 4) = b1 + scale * acc[ai][bj][m][1]; }
            })
        } else {
            float* pbq = pb + (size_t)(u.kt0 / u.nkt - 1) * ((size_t)(MP - TS_ROWS0) * D) - (size_t)TS_ROWS0 * D;
            EPI_ROWS({
                float* op = pbq + (size_t)r * D + col0;
                _Pragma("unroll") for (int bj = 0; bj < 2; ++bj) { *(f32x4*)(op + bj * HALF) = scale * acc[ai][bj][m][0]; *(f32x4*)(op + bj * HALF + 4) = scale * acc[ai][bj][m][1]; }
            })
        }
    }
};
template <int MODE  , bool X0> struct EpiDownFinal { static constexpr bool FUSED = true;
    X0Src src; float* X; float scale; const float* gain; float* out; bf16_t* XN; unsigned* xbuf; unsigned* cnt;
    __device__ __forceinline__ void fused(f32x4 (&acc)[2][2][4][2], const Unit& u, int wr, int wc, int fr, int fq, LAS unsigned char* lds, int wid, int lane) const {
        const int col0 = u.pn * BM + wc * 32 + 8 * fq;
        int c1 = col0, pm1 = u.pm, rb1 = wr * 64 + fr, wc1 = wc; asm volatile("" : "+v"(c1), "+s"(pm1), "+v"(rb1), "+v"(wc1));
        LAS float* P = (LAS float*)(lds + 131072);
        LAS float* S = (LAS float*)(lds + 131072 + 4096);
#pragma unroll
        for (int ai = 0; ai < 2; ++ai)
#pragma unroll
            for (int m = 0; m < 4; ++m) { const int r = pm1 * BM + ai * HALF + m * 16 + rb1; const float* xp = (X0 ? x0_row(src, r) : X + (size_t)r * D) + c1; float* xo = X + (size_t)r * D + c1; float q = 0.f;
#pragma unroll
                for (int bj = 0; bj < 2; ++bj)
#pragma unroll
                    for (int n = 0; n < 2; ++n) { const f32x4 b = *(const f32x4*)(xp + bj * HALF + 4 * n); const f32x4 v = b + scale * acc[ai][bj][m][n]; acc[ai][bj][m][n] = v;
                        if (MODE == 1) *(f32x4*)(xo + bj * HALF + 4 * n) = v;
                        q += (v[0] * v[0] + v[1] * v[1]) + (v[2] * v[2] + v[3] * v[3]); }
                q += __shfl_xor(q, 16); q += __shfl_xor(q, 32);
                if (fq == 0) P[(ai * HALF + m * 16 + rb1) * 4 + wc1] = q;
                asm volatile("" ::: "memory"); }
        asm volatile("s_waitcnt lgkmcnt(0)" ::: "memory"); __builtin_amdgcn_s_barrier(); asm volatile("" ::: "memory");
        int row = wid * 32 + (lane & 31); asm volatile("" : "+v"(row));
        if (lane < 32) { const float t = (P[row * 4 + 0] + P[row * 4 + 1]) + (P[row * 4 + 2] + P[row * 4 + 3]);
            __hip_atomic_store(xbuf + ((size_t)(u.pm * BM + row) * 8 + u.pn), __builtin_bit_cast(unsigned, t), __ATOMIC_RELAXED, __HIP_MEMORY_SCOPE_AGENT); }
        asm volatile("s_waitcnt vmcnt(0)" ::: "memory");
        if (lane == 0) (void)__hip_atomic_fetch_add(cnt + 64 * u.pm, 1u, __ATOMIC_RELAXED, __HIP_MEMORY_SCOPE_AGENT);
        if (wid == 0) { unsigned sp = 0;
            _Pragma("unroll 1") while ((unsigned)__builtin_amdgcn_readfirstlane(__hip_atomic_load(cnt + 64 * u.pm, __ATOMIC_RELAXED, __HIP_MEMORY_SCOPE_AGENT)) < 64u) { __builtin_amdgcn_s_sleep(2); if (++sp > (1u << 22)) break; }
            __builtin_amdgcn_fence(__ATOMIC_ACQUIRE, "agent"); }
        asm volatile("s_waitcnt vmcnt(0) lgkmcnt(0)" ::: "memory"); __builtin_amdgcn_s_barrier(); asm volatile("" ::: "memory");
        if (lane < 32) { const unsigned* sl = xbuf + (size_t)(u.pm * BM + row) * 8; float t = 0.f;
#pragma unroll
            for (int k = 0; k < 8; ++k) t += __builtin_bit_cast(float, __hip_atomic_load(sl + k, __ATOMIC_RELAXED, __HIP_MEMORY_SCOPE_AGENT));
            S[row] = 1.0f / sqrtf(t * (1.0f / D) + RMS_EPS); }
        asm volatile("s_waitcnt vmcnt(0) lgkmcnt(0)" ::: "memory"); __builtin_amdgcn_s_barrier(); asm volatile("" ::: "memory");
        int c5 = col0, pm5 = u.pm, rb5 = wr * 64 + fr; asm volatile("" : "+v"(c5), "+s"(pm5), "+v"(rb5));
        const int b0 = (pm5 * BM) / LP, t0 = pm5 * BM - b0 * LP;
#pragma unroll
        for (int ai = 0; ai < 2; ++ai)
#pragma unroll
            for (int m = 0; m < 4; ++m) { const int rl = ai * HALF + m * 16 + rb5; const float rs = S[rl];
                if (MODE == 0) { int t = t0 + rl, b = b0; if (t >= LP) { t -= LP; ++b; }
                    if (t >= NMETA) { float* op = out + O_YP + ((size_t)b * SEQ + (t - NMETA)) * D + c5;
#pragma unroll
                        for (int bj = 0; bj < 2; ++bj) { const f32x4 g0 = *(const f32x4*)(gain + c5 + bj * HALF), g1 = *(const f32x4*)(gain + c5 + bj * HALF + 4);
                            *(f32x4*)(op + bj * HALF) = acc[ai][bj][m][0] * rs * g0; *(f32x4*)(op + bj * HALF + 4) = acc[ai][bj][m][1] * rs * g1; } } }
                else { bf16_t* op = XN + (size_t)(pm5 * BM + rl) * D + c5;
#pragma unroll
                    for (int bj = 0; bj < 2; ++bj) { const f32x4 g0 = *(const f32x4*)(gain + c5 + bj * HALF), g1 = *(const f32x4*)(gain + c5 + bj * HALF + 4);
                        *(u32x4*)(op + bj * HALF) = pack8(acc[ai][bj][m][0] * rs * g0, acc[ai][bj][m][1] * rs * g1); } }
                asm volatile("" ::: "memory"); }
    }
};
struct EpiWin { static constexpr bool FUSED = false;
    float* UP; float* US; bf16_t* G; const float* bg;
    __device__ __forceinline__ void operator()(AccRef acc, const Unit& u, int wr, int wc, int fr, int fq) const {
        if (u.pn < 8) {
            float* O = (u.pn < 4 ? UP : US); const int col0 = (u.pn & 3) * BM + wc * 32 + 8 * fq;
            EPI_ROWS({
                float* op = O + (size_t)r * 1024 + col0;
                _Pragma("unroll") for (int bj = 0; bj < 2; ++bj) { *(f32x4*)(op + bj * HALF) = acc[ai][bj][m][0]; *(f32x4*)(op + bj * HALF + 4) = acc[ai][bj][m][1]; }
            })
        } else {
            const int col0 = (u.pn - 8) * BM + wc * 32 + 8 * fq;
            f32x4 bv[2][2];
#pragma unroll
            for (int bj = 0; bj < 2; ++bj) { bv[bj][0] = *(const f32x4*)(bg + col0 + bj * HALF); bv[bj][1] = *(const f32x4*)(bg + col0 + bj * HALF + 4); }
            EPI_ROWS({
                bf16_t* op = G + (size_t)r * 4096 + col0;
                _Pragma("unroll") for (int bj = 0; bj < 2; ++bj) *(u32x4*)(op + bj * HALF) = pack8(sigm4(acc[ai][bj][m][0] + bv[bj][0]), sigm4(acc[ai][bj][m][1] + bv[bj][1]));
            })
        }
    }
};
struct EpiPool { static constexpr bool FUSED = false;
    bf16_t* AB; const float* sc;
    __device__ __forceinline__ void operator()(AccRef acc, const Unit& u, int wr, int wc, int fr, int fq) const {
        const int col0 = u.pn * BM + wc * 32 + 8 * fq;
        f32x4 sv[2][2];
#pragma unroll
        for (int bj = 0; bj < 2; ++bj) { sv[bj][0] = *(const f32x4*)(sc + col0 + bj * HALF); sv[bj][1] = *(const f32x4*)(sc + col0 + bj * HALF + 4); }
        EPI_ROWS({
            bf16_t* op = AB + (size_t)r * 2048 + col0;
            _Pragma("unroll") for (int bj = 0; bj < 2; ++bj) *(u32x4*)(op + bj * HALF) = pack8(acc[ai][bj][m][0] * sv[bj][0], acc[ai][bj][m][1] * sv[bj][1]);
        })
    }
};
struct EpiGLU { static constexpr bool FUSED = false;
    bf16_t* AB; const bf16_t* SG; const float* gb;
    __device__ __forceinline__ void operator()(AccRef acc, const Unit& u, int wr, int wc, int fr, int fq) const {
        const int col0 = u.pn * BM + wc * 32 + 8 * fq;
        f32x4 bv[2][2];
#pragma unroll
        for (int bj = 0; bj < 2; ++bj) { bv[bj][0] = *(const f32x4*)(gb + col0 + bj * HALF); bv[bj][1] = *(const f32x4*)(gb + col0 + bj * HALF + 4); }
        EPI_ROWS({
            bf16_t* op = AB + (size_t)r * 2048 + 1024 + col0; const bf16_t* sp = SG + (size_t)r * 1024 + col0;
            _Pragma("unroll") for (int bj = 0; bj < 2; ++bj) { f32x4 s0, s1; unpack8(*(const u32x4*)(sp + bj * HALF), s0, s1);
                *(u32x4*)(op + bj * HALF) = pack8(s0 * sigm4(acc[ai][bj][m][0] + bv[bj][0]), s1 * sigm4(acc[ai][bj][m][1] + bv[bj][1])); }
        })
    }
};
struct EpiBr1 { static constexpr bool FUSED = false;
    bf16_t* T1; const bf16_t* G;
    __device__ __forceinline__ void operator()(AccRef acc, const Unit& u, int wr, int wc, int fr, int fq) const {
        const int col0 = u.pn * BM + wc * 32 + 8 * fq;
        EPI_ROWS({
            bf16_t* op = T1 + (size_t)r * 2048 + col0; const bf16_t* gp = G + (size_t)r * 4096 + col0;
            _Pragma("unroll") for (int bj = 0; bj < 2; ++bj) { f32x4 g0, g1; unpack8(*(const u32x4*)(gp + bj * HALF), g0, g1);
                *(u32x4*)(op + bj * HALF) = pack8(g0 * acc[ai][bj][m][0], g1 * acc[ai][bj][m][1]); }
        })
    }
};
struct EpiBr2 { static constexpr bool FUSED = false;
    const bf16_t* T1; const bf16_t* G; bf16_t* MRG;
    __device__ __forceinline__ void operator()(AccRef acc, const Unit& u, int wr, int wc, int fr, int fq) const {
        const int col0 = u.pn * BM + wc * 32 + 8 * fq;
        EPI_ROWS({
            const bf16_t* tp = T1 + (size_t)r * 2048 + col0; const bf16_t* gp = G + (size_t)r * 4096 + 2048 + col0; bf16_t* op = MRG + (size_t)r * 2048 + col0;
            _Pragma("unroll") for (int bj = 0; bj < 2; ++bj) { f32x4 g0, g1; unpack8(*(const u32x4*)(gp + bj * HALF), g0, g1);
                f32x4 t0, t1; unpack8(*(const u32x4*)(tp + bj * HALF), t0, t1);
                *(u32x4*)(op + bj * HALF) = pack8(t0 + g0 * acc[ai][bj][m][0], t1 + g1 * acc[ai][bj][m][1]); }
        })
    }
};
}

__device__ __forceinline__ void cvt_item(const float* W, int K, int N, bf16_t* WT, int mode, int item, int lane) {
    const int nblk = N >> 6, kb = item / nblk, nb = item - kb * nblk, k0 = kb << 6, n0 = nb << 6;
    const int rg = lane >> 4, nq = lane & 15;
    const float* src = W + (size_t)(k0 + 16 * rg) * N + n0 + 4 * nq;
    f32x4 v[16];
#pragma unroll
    for (int i = 0; i < 16; ++i) v[i] = __builtin_nontemporal_load((const f32x4*)(src + (size_t)i * N));
    const int drow0 = (mode == 0 ? n0 : ((n0 >> 7) * 256 + (mode == 2 ? 128 : 0) + (n0 & 127))) + 4 * nq;
    bf16_t* dst = WT + (size_t)drow0 * K + k0 + 16 * rg;
#pragma unroll
    for (int j = 0; j < 4; ++j)
#pragma unroll
        for (int h = 0; h < 2; ++h) {
            u32x4 w; w.x = cvt_pk_bf16(v[8 * h + 0][j], v[8 * h + 1][j]); w.y = cvt_pk_bf16(v[8 * h + 2][j], v[8 * h + 3][j]);
            w.z = cvt_pk_bf16(v[8 * h + 4][j], v[8 * h + 5][j]); w.w = cvt_pk_bf16(v[8 * h + 6][j], v[8 * h + 7][j]);
            *(u32x4*)(dst + (size_t)j * K + 8 * h) = w; }
}
struct Args { const float* in[33]; float* out; unsigned char* ws; int ph_lo, ph_hi; };
typedef const __attribute__((address_space(4))) Args* ArgsP;
struct Frame {
    ArgsP a; unsigned char* ws; float* out;
    LAS unsigned char* lds; int tid, lane, wave, G, gw, NGW;
};
__device__ __forceinline__ void cvt_ffn(const Frame& F, int i0, int w0, int nw, int part = 0, int nparts = 1) {
    constexpr int IG = (D / 64) * (FF / 64);
    bf16_t* wgu = (bf16_t*)(F.ws + WS_WGU); bf16_t* wd = (bf16_t*)(F.ws + WS_WD);
    const int ib = (int)((long)part * (3 * IG) / nparts), ie = (int)((long)(part + 1) * (3 * IG) / nparts);
    for (int it = ib + w0; it < ie; it += nw) {
        if (it < IG) cvt_item(F.a->in[i0], D, FF, wgu, 1, it, F.lane);
        else if (it < 2 * IG) cvt_item(F.a->in[i0 + 1], D, FF, wgu, 2, it - IG, F.lane);
        else cvt_item(F.a->in[i0 + 2], FF, D, wd, 0, it - 2 * IG, F.lane);
    }
}
__device__ __forceinline__ void cvt_mixer(const Frame& F, int w0, int nw, int it0, int it1) {
    constexpr int I_IN = (D / 64) * (WIN / 64)  , I_PW = 4 * 16, I_GLU = 256, I_A = 16 * 32, I_O = 32 * 32;
    constexpr int TOT = I_IN + I_PW + I_GLU + 2 * I_A + I_O;
    static_assert(TOT == 5440, "mixer conversion items");
    for (int it = it0 + w0; it < it1; it += nw) {
        int r = it;
        if (r < I_IN) { cvt_item(F.a->in[11], D, WIN, (bf16_t*)(F.ws + WS_WIN), 0, r, F.lane); continue; } r -= I_IN;
        if (r < I_PW) { const int g = r >> 4; cvt_item(F.a->in[13] + (size_t)g * 65536, 256, 256, (bf16_t*)(F.ws + WS_PW) + (size_t)g * 65536, 0, r & 15, F.lane); continue; } r -= I_PW;
        if (r < I_GLU) { cvt_item(F.a->in[23], 1024, 1024, (bf16_t*)(F.ws + WS_GLU), 0, r, F.lane); continue; } r -= I_GLU;
        if (r < I_A) { cvt_item(F.a->in[25], 1024, 2048, (bf16_t*)(F.ws + WS_WA), 0, r, F.lane); continue; } r -= I_A;
        if (r < I_A) { cvt_item(F.a->in[26], 1024, 2048, (bf16_t*)(F.ws + WS_WB), 0, r, F.lane); continue; } r -= I_A;
        cvt_item(F.a->in[27], 2048, 2048, (bf16_t*)(F.ws + WS_WOUT), 0, r, F.lane);
    }
}

__device__ __forceinline__ void rms_row(const float* xrow, const float* gain, bf16_t* orow, float* frow, int lane, float* copy = nullptr, const float* pbrow = nullptr, size_t pbstride = 0) {
    f32x4 v[8]; float s = 0.f;
#pragma unroll
    for (int j = 0; j < 8; ++j) { v[j] = ((const f32x4*)xrow)[64 * j + lane]; if (pbrow) { v[j] += ((const f32x4*)pbrow)[64 * j + lane]; v[j] += ((const f32x4*)(pbrow + pbstride))[64 * j + lane]; v[j] += ((const f32x4*)(pbrow + 2 * pbstride))[64 * j + lane]; } s += (v[j][0] * v[j][0] + v[j][1] * v[j][1]) + (v[j][2] * v[j][2] + v[j][3] * v[j][3]); }
    if (copy) {
#pragma unroll
        for (int j = 0; j < 8; ++j) ((f32x4*)copy)[64 * j + lane] = v[j]; }
    const float rs = 1.0f / sqrtf(wave_sum(s) * (1.0f / D) + RMS_EPS);
#pragma unroll
    for (int j = 0; j < 8; ++j) { const f32x4 gg = ((const f32x4*)gain)[64 * j + lane]; const f32x4 o = v[j] * rs * gg;
        if (orow) { u32x2 w; w.x = cvt_pk_bf16(o[0], o[1]); w.y = cvt_pk_bf16(o[2], o[3]); ((u32x2*)orow)[64 * j + lane] = w; }
        else ((f32x4*)frow)[64 * j + lane] = o; }
}
__device__ __forceinline__ void zero_row_bf16(bf16_t* orow, int lane) {
#pragma unroll
    for (int j = 0; j < 8; ++j) ((u32x2*)orow)[64 * j + lane] = (u32x2){0u, 0u};
}

__device__ __forceinline__ void sincos_r(float x, float& s, float& c) {
    const float k = rintf(x * 0.6366197723675814f);
    float r = fmaf(-k, 1.5707963705062866f, x); r = fmaf(-k, -4.371139000186241e-8f, r);
    const float z = r * r;
    const float sp = r + r * z * (-1.6666654611e-1f + z * (8.3321608736e-3f + z * (-1.9515295891e-4f)));
    const float cp = 1.0f - 0.5f * z + z * z * (4.166664568298827e-2f + z * (-1.388731625493765e-3f + z * 2.443315711809948e-5f));
    const int q = ((int)k) & 3;
    s = (q == 0) ? sp : (q == 1) ? cp : (q == 2) ? -sp : -cp;
    c = (q == 0) ? cp : (q == 1) ? -sp : (q == 2) ? -cp : sp;
}
__device__ __forceinline__ bf16x8 pack8s(f32x4 a, f32x4 b) { const u32x4 w = pack8(a, b); return __builtin_bit_cast(bf16x8, w); }

#define WSYNC() asm volatile("s_waitcnt lgkmcnt(0)" ::: "memory")
struct S5K { float lbr, lbi; bf16x8 bb[8]; bf16x8 cm[4]; f32x4 dsk; };

__device__ __forceinline__ void s5_consts(const Frame& F, int g, LAS float* tab, S5K& k) {
    const int lane = F.lane, i16 = lane & 15, kq = lane >> 4;
    const float lre = F.a->in[15][g * NP + lane], lim = F.a->in[16][g * NP + lane], dt = expf(F.a->in[17][g]);
    const float a = lre * dt, b = lim * dt;
    const float em1 = a * (1.0f + a * (0.5f + a * (1.0f / 6.0f + a * (1.0f / 24.0f + a * (1.0f / 120.0f + a * (1.0f / 720.0f))))));
    const float ea = 1.0f + em1;
    float sh, ch; sincos_r(0.5f * b, sh, ch);
    const float sb = 2.0f * sh * ch, cbm1 = -2.0f * sh * sh, cb = 1.0f + cbm1;
    k.lbr = ea * cb; k.lbi = ea * sb;
    const float rm1 = em1 * cb + cbm1, im1 = ea * sb;
    const float inv = 1.0f / (lre * lre + lim * lim);
    tab[2 * lane] = (rm1 * lre + im1 * lim) * inv; tab[2 * lane + 1] = (im1 * lre - rm1 * lim) * inv;
    WSYNC();
#pragma unroll
    for (int n4 = 0; n4 < 4; ++n4) {
        const int p = 16 * n4 + i16; const float qr = tab[2 * p], qi = tab[2 * p + 1];
        const float* br = F.a->in[18] + ((size_t)g * NP + p) * GS + 8 * (kq & 1); const float* bi = F.a->in[19] + ((size_t)g * NP + p) * GS + 8 * (kq & 1);
        const f32x4 r0 = *(const f32x4*)br, r1 = *(const f32x4*)(br + 4), i0 = *(const f32x4*)bi, i1 = *(const f32x4*)(bi + 4);
        k.bb[n4] = pack8s(qr * r0 - qi * i0, qr * r1 - qi * i1);
        k.bb[4 + n4] = pack8s(qr * i0 + qi * r0, qr * i1 + qi * r1);
    }
#pragma unroll
    for (int s = 0; s < 4; ++s) {
        const float* cp = (s < 2 ? F.a->in[20] : F.a->in[21]) + ((size_t)g * GS + i16) * NP + 32 * (s & 1) + 8 * kq;
        f32x4 c0 = *(const f32x4*)cp, c1 = *(const f32x4*)(cp + 4);
        if (s >= 2) { c0 = -c0; c1 = -c1; }
        k.cm[s] = pack8s(c0, c1);
    }
    k.dsk = *(const f32x4*)(F.a->in[22] + g * GS + 4 * kq);
    WSYNC();
}
__device__ __forceinline__ void s5_ld(const float* US, int row0, int g, int lane, f32x4& u0, f32x4& u1) {
    const float* up = US + (size_t)(row0 + (lane & 15)) * WSSM + g * GS + 8 * ((lane >> 4) & 1);
    u0 = *(const f32x4*)up; u1 = *(const f32x4*)(up + 4);
}
__device__ __forceinline__ void s5_bu(const f32x4 u0, const f32x4 u1, int lane, const S5K& k, LAS float* HB) {
    const int t = lane & 15, kq = lane >> 4;
    u32x4 hi = pack8(u0, u1);
    f32x4 h0, h1; unpack8(hi, h0, h1);
    const u32x4 lo = pack8(u0 - h0, u1 - h1);
    const bf16x8 uop = __builtin_bit_cast(bf16x8, (kq >= 2) ? lo : hi);
#pragma unroll
    for (int n = 0; n < 8; ++n) {
        const f32x4 d = __builtin_amdgcn_mfma_f32_16x16x32_bf16(k.bb[n], uop, (f32x4){0.f, 0.f, 0.f, 0.f}, 0, 0, 0);
        *(LAS f32x4*)(HB + t * 132 + 16 * n + 4 * kq) = d;
    }
    WSYNC();
}
__device__ __forceinline__ void s5_out(const f32x4 uu, bf16_t* SG, int row0, int g, int lane, const S5K& k, const LAS float* HB) {
    const int t = lane & 15, kq = lane >> 4;
    f32x4 acc = (f32x4){0.f, 0.f, 0.f, 0.f};
#pragma unroll
    for (int s = 0; s < 4; ++s) {
        const LAS float* hp = HB + t * 132 + 32 * s + 8 * kq;
        const f32x4 h0 = *(const LAS f32x4*)hp, h1 = *(const LAS f32x4*)(hp + 4);
        acc = __builtin_amdgcn_mfma_f32_16x16x32_bf16(k.cm[s], pack8s(h0, h1), acc, 0, 0, 0);
    }
    const f32x4 y = acc + k.dsk * uu;
    u32x2 w; w.x = cvt_pk_bf16(gelu_tanh(y[0]), gelu_tanh(y[1])); w.y = cvt_pk_bf16(gelu_tanh(y[2]), gelu_tanh(y[3]));
    *(u32x2*)(SG + (size_t)(row0 + t) * WSSM + g * GS + 4 * kq) = w;
    WSYNC();
}

__device__ __forceinline__ void s5_phase(const Frame& F) {
    const float* US = (const float*)(F.ws + WS_US); bf16_t* SG = (bf16_t*)(F.ws + WS_SG);
    LAS f32x2* EB = (LAS f32x2*)F.lds;
    LAS float* HB = (LAS float*)(F.lds + 66048 + F.wave * 8448);
    const int lane = F.lane;
    S5K k;
    for (int item = blockIdx.x; item < NBP * NG; item += F.G) {
        const int b = item >> 6, g = item & 63, rb = b * LP;
        s5_consts(F, g, HB, k);
        f32x4 nu0, nu1; s5_ld(US, rb + 16 * F.wave, g, lane, nu0, nu1);
        for (int c = F.wave; c < NCH; c += 8) {
            const f32x4 u0 = nu0, u1 = nu1; if (c + 8 < NCH) s5_ld(US, rb + 16 * (c + 8), g, lane, nu0, nu1);
            s5_bu(u0, u1, lane, k, HB);
            float br[16], bi[16];
#pragma unroll
            for (int t = 0; t < 16; ++t) { br[t] = HB[t * 132 + lane]; bi[t] = HB[t * 132 + 64 + lane]; }
            float hr = 0.f, hi = 0.f;
#pragma unroll
            for (int t = 0; t < 16; ++t) { const float nr = k.lbr * hr - k.lbi * hi + br[t], ni = k.lbr * hi + k.lbi * hr + bi[t]; hr = nr; hi = ni; }
            EB[c * 64 + lane] = (f32x2){hr, hi};
            WSYNC();
        }
        __syncthreads();
        if (F.wave == 0) {
            float pr = k.lbr, pi = k.lbi;
#pragma unroll
            for (int q = 0; q < 4; ++q) { const float nr = pr * pr - pi * pi, ni = 2.0f * pr * pi; pr = nr; pi = ni; }
            float hr = 0.f, hi = 0.f;
            for (int c0 = 0; c0 < NCH; c0 += 8) {
                f32x2 e[8];
#pragma unroll
                for (int j = 0; j < 8; ++j) e[j] = (c0 + j < NCH) ? EB[(c0 + j) * 64 + lane] : (f32x2){0.f, 0.f};
#pragma unroll
                for (int j = 0; j < 8; ++j) { const float nr = pr * hr - pi * hi + e[j][0], ni = pr * hi + pi * hr + e[j][1]; hr = nr; hi = ni; e[j] = (f32x2){hr, hi}; }
#pragma unroll
                for (int j = 0; j < 8; ++j) if (c0 + j < NCH) EB[(c0 + j) * 64 + lane] = e[j];
            }
            const f32x2 fin = EB[(NCH - 1) * 64 + lane];
            F.out[O_RP + (size_t)(b * NG + g) * NP + lane] = fin[0]; F.out[O_IP + (size_t)(b * NG + g) * NP + lane] = fin[1];
        }
        __syncthreads();
        s5_ld(US, rb + 16 * F.wave, g, lane, nu0, nu1);
        for (int c = F.wave; c < NCH; c += 8) {
            const f32x4 u0 = nu0, u1 = nu1; if (c + 8 < NCH) s5_ld(US, rb + 16 * (c + 8), g, lane, nu0, nu1);
            const f32x4 uu = *(const f32x4*)(US + (size_t)(rb + 16 * c + (lane & 15)) * WSSM + g * GS + 4 * (lane >> 4));
            s5_bu(u0, u1, lane, k, HB);
            float br[16], bi[16];
#pragma unroll
            for (int t = 0; t < 16; ++t) { br[t] = HB[t * 132 + lane]; bi[t] = HB[t * 132 + 64 + lane]; }
            f32x2 h0 = (f32x2){0.f, 0.f}; if (c > 0) h0 = EB[(c - 1) * 64 + lane];
            float hr = h0[0], hi = h0[1];
#pragma unroll
            for (int t = 0; t < 16; ++t) { const float nr = k.lbr * hr - k.lbi * hi + br[t], ni = k.lbr * hi + k.lbi * hr + bi[t]; hr = nr; hi = ni; br[t] = hr; bi[t] = hi; }
#pragma unroll
            for (int t = 0; t < 16; ++t) { HB[t * 132 + lane] = br[t]; HB[t * 132 + 64 + lane] = bi[t]; }
            WSYNC();
            s5_out(uu, SG, rb + 16 * c, g, lane, k, HB);
        }
        __syncthreads();
    }
    for (int it = F.gw; it < NG * (MSA / 16); it += F.NGW) {
        const int g = it >> 5, j = it & 31, row0 = MPR + 16 * j;
        f32x4 u0, u1; s5_ld(US, row0, g, lane, u0, u1);
        const f32x4 uu = *(const f32x4*)(US + (size_t)(row0 + (lane & 15)) * WSSM + g * GS + 4 * (lane >> 4));
        s5_consts(F, g, HB, k);
        s5_bu(u0, u1, lane, k, HB);
        float br[16], bi[16];
#pragma unroll
        for (int t = 0; t < 16; ++t) { br[t] = HB[t * 132 + lane]; bi[t] = HB[t * 132 + 64 + lane]; }
#pragma unroll
        for (int sq = 0; sq < 4; ++sq) {
            const size_t so = ((size_t)(4 * j + sq) * NG + g) * NP + lane;
            float hr = F.a->in[3][so], hi = F.a->in[4][so];
#pragma unroll
            for (int t = 4 * sq; t < 4 * sq + 4; ++t) { const float nr = k.lbr * hr - k.lbi * hi + br[t], ni = k.lbr * hi + k.lbi * hr + bi[t]; hr = nr; hi = ni; br[t] = hr; bi[t] = hi; }
            F.out[O_RS + so] = hr; F.out[O_IS + so] = hi;
        }
#pragma unroll
        for (int t = 0; t < 16; ++t) { HB[t * 132 + lane] = br[t]; HB[t * 132 + 64 + lane] = bi[t]; }
        WSYNC();
        s5_out(uu, SG, row0, g, lane, k, HB);
    }
}

__device__ __forceinline__ void store_d(bf16_t* p, f32x4 d) { u32x2 w; w.x = cvt_pk_bf16(d[0], d[1]); w.y = cvt_pk_bf16(d[2], d[3]); *(u32x2*)p = w; }
template <int W, int T> __device__ __forceinline__ void pool_rows(const f32x4* cur, const f32x4* old, int skip, int avail0, bf16_t* dd) {
    f32x4 u[T], o[W - 1];
#pragma unroll
    for (int k = 0; k < W - 1; ++k) o[k] = (k >= skip) ? old[(size_t)k * 256] : (f32x4){0.f, 0.f, 0.f, 0.f};
#pragma unroll
    for (int t = 0; t < T; ++t) u[t] = cur[(size_t)t * 256];
    f32x4 s = (f32x4){0.f, 0.f, 0.f, 0.f};
#pragma unroll
    for (int k = 0; k < W - 1; ++k) s += o[k];
#pragma unroll
    for (int t = 0; t < T; ++t) {
        s += u[t];
        const int av = avail0 + t + 1; const float inv = 1.0f / (float)(av < W ? av : W);
        store_d(dd + (size_t)t * WPOOL, s * inv - u[t]);
        if (t - (W - 1) >= 0) s -= u[t - (W - 1) >= 0 ? t - (W - 1) : 0]; else s -= o[t < W - 1 ? t : 0];
    }
}
__device__ __forceinline__ void pool_phase(const Frame& F) {
    const f32x4* UP4 = (const f32x4*)(F.ws + WS_UP); bf16_t* DD = (bf16_t*)(F.ws + WS_DD);
    const int half = F.tid >> 8, q = F.tid & 255, grp = __builtin_amdgcn_readfirstlane(q >> 6);
    constexpr int NPI = NBP * NCH  , NSI = NBS;
    for (int it = blockIdx.x * 2 + half; it < NPI + NSI; it += F.G * 2) {
        if (it < NPI) {
            const int b = it / NCH, ch = it - b * NCH, t0 = 16 * ch, rb = b * LP;
            const f32x4* cur = UP4 + (size_t)(rb + t0) * 256 + q; bf16_t* dd = DD + (size_t)(rb + t0) * WPOOL + 4 * q;
            if (grp == 0)      pool_rows<2, 16>(cur, cur - (size_t)1 * 256, 1 - t0 > 0 ? 1 - t0 : 0, t0, dd);
            else if (grp == 1) pool_rows<4, 16>(cur, cur - (size_t)3 * 256, 3 - t0 > 0 ? 3 - t0 : 0, t0, dd);
            else if (grp == 2) pool_rows<8, 16>(cur, cur - (size_t)7 * 256, 7 - t0 > 0 ? 7 - t0 : 0, t0, dd);
            else               pool_rows<16, 16>(cur, cur - (size_t)15 * 256, 15 - t0 > 0 ? 15 - t0 : 0, t0, dd);
        } else {
            const int bs = it - NPI, rs = MPR + 4 * bs; const f32x4* hist = (const f32x4*)F.a->in[2] + (size_t)bs * 15 * 256 + q;
            const f32x4* cur = UP4 + (size_t)rs * 256 + q; bf16_t* dd = DD + (size_t)rs * WPOOL + 4 * q;
            if (grp == 0)      pool_rows<2, 4>(cur, hist + (size_t)14 * 256, 0, 1 << 20, dd);
            else if (grp == 1) pool_rows<4, 4>(cur, hist + (size_t)12 * 256, 0, 1 << 20, dd);
            else if (grp == 2) pool_rows<8, 4>(cur, hist + (size_t)8 * 256, 0, 1 << 20, dd);
            else               pool_rows<16, 4>(cur, hist, 0, 1 << 20, dd);
        }
    }
    const int gt = blockIdx.x * 512 + F.tid, NT = F.G * 512;
    f32x4* pp = (f32x4*)(F.out + O_PP); f32x4* ps = (f32x4*)(F.out + O_PS);
    for (int i = gt; i < NBP * 15 * 256; i += NT) { const int c = i & 255, j = (i >> 8) % 15, b = i / (15 * 256); pp[i] = UP4[(size_t)(b * LP + LP - 15 + j) * 256 + c]; }
    for (int i = gt; i < NBS * 15 * 256; i += NT) { const int c = i & 255, j = (i >> 8) % 15, b = i / (15 * 256);
        ps[i] = (j < 11) ? ((const f32x4*)F.a->in[2])[((size_t)b * 15 + j + 4) * 256 + c] : UP4[(size_t)(MPR + 4 * b + j - 11) * 256 + c]; }
}


#define XB_TMO      128
#define XB_XCNT(j)  (256  + 64 * (j))
#define XB_XSUB(j)  (1280 + 64 * (j))
#define XB_XGEN(j)  (2304 + 64 * (j))
#define XB_TOP      3328
#define XB_TOPGEN   3392
#define XCD_BAR_WORDS 3456
#define XB_SPIN_CAP (1u << 20)
__device__ __forceinline__ unsigned xb_ld(unsigned* p)              { return __hip_atomic_load(p, __ATOMIC_RELAXED, __HIP_MEMORY_SCOPE_AGENT); }
__device__ __forceinline__ unsigned xb_add(unsigned* p, unsigned v) { return __hip_atomic_fetch_add(p, v, __ATOMIC_RELAXED, __HIP_MEMORY_SCOPE_AGENT); }
__device__ __forceinline__ unsigned xb_xcc_id() { return (unsigned)__builtin_amdgcn_s_getreg((3 << 11) | 20) & 0xFu; }
#define XB_SPIN(cond, bar) do { unsigned _sp = 0; while (cond) { __builtin_amdgcn_s_sleep(1); \
    if ((++_sp & 255u) == 0u) { if (xb_ld(&(bar)[XB_TMO])) break; if (_sp > XB_SPIN_CAP) { atomicAdd(&(bar)[XB_TMO], 1u); break; } } } } while (0)
__device__ __forceinline__ void xcd_barrier_complete(unsigned* bar, unsigned x, unsigned& nloc, unsigned& nx) {
    const unsigned G = gridDim.x;
    unsigned sum, cnt, mine, sp = 0u;
    for (;;) {
        sum = 0u; cnt = 0u; mine = 0u;
#pragma unroll
        for (unsigned j = 0; j < 16; ++j) { const unsigned c = xb_ld(&bar[XB_XCNT(j)]); sum += c; cnt += (c > 0u) ? 1u : 0u; mine = (j == x) ? c : mine; }
        if (sum == G) break;
        __builtin_amdgcn_s_sleep(1);
        if ((++sp & 255u) == 0u) { if (xb_ld(&bar[XB_TMO])) break; if (sp > XB_SPIN_CAP) { atomicAdd(&bar[XB_TMO], 1u); break; } }
    }
    nloc = mine > 0u ? mine : 1u; nx = cnt > 0u ? cnt : 1u;
}
__device__ __forceinline__ void xcd_barrier(unsigned* bar, volatile LAS unsigned* st) {
    asm volatile("s_waitcnt vmcnt(0)" ::: "memory");
    __syncthreads();
    if (threadIdx.x == 0) {
        __builtin_amdgcn_s_waitcnt(0);
        const unsigned x = xb_xcc_id();
        unsigned nloc = st[0], nx = st[1];
        if (nloc == 0u) { xcd_barrier_complete(bar, x, nloc, nx); st[0] = nloc; st[1] = nx; }
        const unsigned old = xb_add(&bar[XB_XSUB(x)], 1u);
        const unsigned gen = old / nloc;
        if (old + 1u == (gen + 1u) * nloc) {
            __builtin_amdgcn_fence(__ATOMIC_RELEASE, "agent");
            asm volatile("s_waitcnt vmcnt(0)" ::: "memory");
            const unsigned og = xb_add(&bar[XB_TOP], 1u);
            const unsigned tg = og / nx;
            if (og + 1u == (tg + 1u) * nx) xb_add(&bar[XB_TOPGEN], 1u);
            else XB_SPIN(xb_ld(&bar[XB_TOPGEN]) == tg, bar);
            __builtin_amdgcn_fence(__ATOMIC_ACQUIRE, "agent");
            xb_add(&bar[XB_XGEN(x)], 1u);
            asm volatile("s_waitcnt vmcnt(0)" ::: "memory");
        } else {
            XB_SPIN(xb_ld(&bar[XB_XGEN(x)]) == gen, bar);
            __builtin_amdgcn_fence(__ATOMIC_ACQUIRE, "agent");
            asm volatile("s_waitcnt vmcnt(0)" ::: "memory");
        }
    }
    __syncthreads();
}
constexpr int LDS_BARST = LDS_BYTES - 64;

constexpr int N_PHASES = 14;
#ifndef DBG_STOP
#define DBG_STOP 99
#endif
#ifndef DBG_SRC
#define DBG_SRC WS_UP
#endif

__device__ __forceinline__ Frame make_frame(LAS unsigned char* lds) {
    Frame F;
    ArgsP a = (ArgsP)__builtin_amdgcn_kernarg_segment_ptr(); asm volatile("" : "+s"(a));
    int t = threadIdx.x; asm volatile("" : "+v"(t));
    F.a = a; F.ws = a->ws; F.out = a->out; F.lds = lds;
    F.tid = t; F.lane = t & 63; F.wave = __builtin_amdgcn_readfirstlane(t >> 6); F.G = gridDim.x;
    F.gw = blockIdx.x * 8 + F.wave; F.NGW = F.G * 8;
    return F;
}
#define XN_(F) ((bf16_t*)((F).ws + WS_XN))
#define X_(F) ((float*)((F).ws + WS_X))
#define H_(F) ((bf16_t*)((F).ws + WS_H))
#define VCU_(F) (((F).G & 7) == 0 ? (int)((blockIdx.x & 7) * ((F).G >> 3) + (blockIdx.x >> 3)) : (int)blockIdx.x)
#define PB_(F) ((float*)((F).ws + WS_PB))
#define X0_(F) (X0Src{(F).a->in[5], (F).a->in[0], (F).a->in[1]})

__global__ void __launch_bounds__(512, 2) mk_fwd(Args args) {
    extern __shared__ __attribute__((aligned(16))) unsigned char lds_raw[];
    LAS unsigned char* const lds = (LAS unsigned char*)lds_raw;
    const int lo = args.ph_lo, hi = args.ph_hi;
    if (threadIdx.x < 2) ((volatile LAS unsigned*)(lds + LDS_BARST))[threadIdx.x] = 0u;
    if (threadIdx.x == 0) (void)xb_add((unsigned*)(args.ws + WS_CTL) + XB_XCNT(xb_xcc_id()), 1u);
    __syncthreads();
#define IN(k) (lo <= (k) && (k) < hi && ((k) < DBG_STOP || (k) == 13))
#define SEAM(k) do { if (lo <= (k) && (k) + 1 < hi) { if (hi > 1000) cg::this_grid().sync();   ArgsP a_ = (ArgsP)__builtin_amdgcn_kernarg_segment_ptr(); asm volatile("" : "+s"(a_)); xcd_barrier((unsigned*)(a_->ws + WS_CTL), (volatile LAS unsigned*)(lds + LDS_BARST)); } } while (0)

    if (IN(0)) { const Frame F = make_frame(lds);
        cvt_ffn(F, 7, F.gw, F.NGW);
        const X0Src x0 = X0_(F); bf16_t* XN = XN_(F);
        for (int r = F.gw; r < MP; r += F.NGW) { const float* xr = x0_row(x0, r); if (xr) rms_row(xr, F.a->in[6], XN + (size_t)r * D, nullptr, F.lane); else zero_row_bf16(XN + (size_t)r * D, F.lane); }
    }
    SEAM(0);
    if (IN(1)) { const Frame F = make_frame(lds);
        pg8::Gemm g{XN_(F), (const bf16_t*)(F.ws + WS_WGU), D, D, MP, 2 * FF, D, 0}; pg8::PadOrder S; S.init(2 * FF, D, F.G, blockIdx.x);
        pg8::EpiSwiGLU E{H_(F)}; pg8::gemm_phase(lds, g, S, E); }
    SEAM(1);
    if (IN(2)) { const Frame F = make_frame(lds);
        pg8::Gemm g{H_(F), (const bf16_t*)(F.ws + WS_WD), FF, FF, MP, D, FF, 0}; pg8::TailSplitOrder S; S.init(D, FF, F.G, blockIdx.x, 1);
        pg8::EpiDownFinal<1, true> E{X0_(F), X_(F), 0.5f, F.a->in[10], nullptr, XN_(F), (unsigned*)(F.ws + WS_CTL + CTL_XBUF), (unsigned*)(F.ws + WS_CTL + CTL_CNT)}; pg8::gemm_phase(lds, g, S, E);
        if ((int)blockIdx.x < 24 * pg8::TS_NSPLIT) { const Frame F3 = make_frame(lds);
            pg8::Gemm g3{H_(F3), (const bf16_t*)(F3.ws + WS_WD), FF, FF, MP, D, FF, 0}; pg8::TailSplitOrder S3; S3.init(D, FF, F3.G, blockIdx.x, 2);
            pg8::EpiAdd<true> E3{X0_(F3), X_(F3), PB_(F3), 0.5f}; pg8::gemm_phase(lds, g3, S3, E3); }
        if (lo == 0) { const Frame F2 = make_frame(lds); const int nb = 24 * pg8::TS_NSPLIT;
            if ((int)blockIdx.x >= nb) cvt_mixer(F2, ((int)blockIdx.x - nb) * 8 + F2.wave, (F2.G - nb) * 8, 0, 3904); } }
    SEAM(2);
    if (IN(3)) { const Frame F = make_frame(lds); bf16_t* XN = XN_(F); float* X = X_(F); const float* PB = PB_(F);
        for (int r = pg8::TS_ROWS0 + F.gw; r < MP; r += F.NGW) { if (r < MV) {
                rms_row(X + (size_t)r * D, F.a->in[10], XN + (size_t)r * D, nullptr, F.lane, r >= pg8::TS_ROWS0 ? X + (size_t)r * D : nullptr, r >= pg8::TS_ROWS0 ? PB + (size_t)(r - pg8::TS_ROWS0) * D : nullptr, (size_t)(MP - pg8::TS_ROWS0) * D); }
            else zero_row_bf16(XN + (size_t)r * D, F.lane); } }
    SEAM(3);
    if (IN(4)) { const Frame F = make_frame(lds);
        pg8::Gemm g{XN_(F), (const bf16_t*)(F.ws + WS_WIN), D, D, MP, WIN, D, 0}; pg8::StaticOrder S; S.init(MP, WIN, F.G, blockIdx.x, D);
        pg8::EpiWin E{(float*)(F.ws + WS_UP), (float*)(F.ws + WS_US), (bf16_t*)(F.ws + WS_G), F.a->in[12]}; pg8::gemm_phase(lds, g, S, E);
        { const Frame F2 = make_frame(lds); const int nb = (MP / 256) * (WIN / 256) - 3 * F2.G;
          if ((int)blockIdx.x >= nb) { cvt_ffn(F2, 29, ((int)blockIdx.x - nb) * 8 + F2.wave, (F2.G - nb) * 8, 0, 4); cvt_ffn(F2, 29, ((int)blockIdx.x - nb) * 8 + F2.wave, (F2.G - nb) * 8, 1, 4); } } }
    SEAM(4);
    if (IN(5)) { __syncthreads();
        { const Frame F = make_frame(lds); s5_phase(F); }
        { const Frame F = make_frame(lds); pool_phase(F); }
        __syncthreads(); }
    SEAM(5);
    if (IN(6)) {
        { const Frame F = make_frame(lds);
          pg8::Gemm g{(const bf16_t*)(F.ws + WS_DD), (const bf16_t*)(F.ws + WS_PW), WPOOL, 256, MP, WPOOL, 256, 512}; pg8::StaticOrder S; S.init(MP, WPOOL, F.G, blockIdx.x, 256);
          pg8::EpiPool E{XN_(F), F.a->in[14]}; pg8::gemm_phase(lds, g, S, E); }
        { const Frame F = make_frame(lds);
          pg8::Gemm g{(const bf16_t*)(F.ws + WS_SG), (const bf16_t*)(F.ws + WS_GLU), WSSM, WSSM, MP, WSSM, WSSM, 0}; pg8::StaticOrder S; S.init(MP, WSSM, F.G, (blockIdx.x + F.G / 2) % F.G, WSSM);
          pg8::EpiGLU E{XN_(F), (const bf16_t*)(F.ws + WS_SG), F.a->in[24]}; pg8::gemm_phase(lds, g, S, E); }
    }
    SEAM(6);
    if (IN(7)) { const Frame F = make_frame(lds);
        pg8::Gemm g{XN_(F), (const bf16_t*)(F.ws + WS_WA), 2048, 1024, MP, D, 1024, 0}; pg8::StaticOrder S; S.init(MP, D, F.G, blockIdx.x, 1024);
        pg8::EpiBr1 E{(bf16_t*)(F.ws + WS_T1), (const bf16_t*)(F.ws + WS_G)}; pg8::gemm_phase(lds, g, S, E);
        { const Frame F2 = make_frame(lds); if ((int)blockIdx.x >= 24) { cvt_mixer(F2, ((int)blockIdx.x - 24) * 8 + F2.wave, (F2.G - 24) * 8, 3904, 4416);
              cvt_ffn(F2, 29, ((int)blockIdx.x - 24) * 8 + F2.wave, (F2.G - 24) * 8, 2, 4); } } }
    SEAM(7);
    if (IN(8)) { const Frame F = make_frame(lds);
        pg8::Gemm g{XN_(F) + 1024, (const bf16_t*)(F.ws + WS_WB), 2048, 1024, MP, D, 1024, 0}; pg8::StaticOrder S; S.init(MP, D, F.G, blockIdx.x, 1024);
        pg8::EpiBr2 E{(const bf16_t*)(F.ws + WS_T1), (const bf16_t*)(F.ws + WS_G), (bf16_t*)(F.ws + WS_MRG)}; pg8::gemm_phase(lds, g, S, E);
        { const Frame F2 = make_frame(lds); if ((int)blockIdx.x >= 24) { cvt_mixer(F2, ((int)blockIdx.x - 24) * 8 + F2.wave, (F2.G - 24) * 8, 4416, 5440);
              cvt_ffn(F2, 29, ((int)blockIdx.x - 24) * 8 + F2.wave, (F2.G - 24) * 8, 3, 4); } } }
    SEAM(8);
    if (IN(9)) { const Frame F = make_frame(lds);
        pg8::Gemm g{(const bf16_t*)(F.ws + WS_MRG), (const bf16_t*)(F.ws + WS_WOUT), D, D, MP, D, D, 0}; pg8::TailSplitOrder S; S.init(D, D, F.G, blockIdx.x, 1);
        pg8::EpiDownFinal<1, false> E{X0_(F), X_(F), 1.0f, F.a->in[28], nullptr, XN_(F), (unsigned*)(F.ws + WS_CTL + CTL_XBUF + 262144), (unsigned*)(F.ws + WS_CTL + CTL_CNT) + 2048}; pg8::gemm_phase(lds, g, S, E);
        if ((int)blockIdx.x < 24 * pg8::TS_NSPLIT) { const Frame F3 = make_frame(lds);
            pg8::Gemm g3{(const bf16_t*)(F3.ws + WS_MRG), (const bf16_t*)(F3.ws + WS_WOUT), D, D, MP, D, D, 0}; pg8::TailSplitOrder S3; S3.init(D, D, F3.G, blockIdx.x, 2);
            pg8::EpiAdd<false> E3{X0_(F3), X_(F3), (float*)(F3.ws + WS_DD), 1.0f}; pg8::gemm_phase(lds, g3, S3, E3); } }
    SEAM(9);
    if (IN(10)) { const Frame F = make_frame(lds); bf16_t* XN = XN_(F); float* X = X_(F); const float* PB = (const float*)(F.ws + WS_DD);
        for (int r = pg8::TS_ROWS0 + F.gw; r < MP; r += F.NGW) { if (r < MV) {
                rms_row(X + (size_t)r * D, F.a->in[28], XN + (size_t)r * D, nullptr, F.lane, r >= pg8::TS_ROWS0 ? X + (size_t)r * D : nullptr, r >= pg8::TS_ROWS0 ? PB + (size_t)(r - pg8::TS_ROWS0) * D : nullptr, (size_t)(MP - pg8::TS_ROWS0) * D); }
            else zero_row_bf16(XN + (size_t)r * D, F.lane); } }
    SEAM(10);
    if (IN(11)) { const Frame F = make_frame(lds);
        pg8::Gemm g{XN_(F), (const bf16_t*)(F.ws + WS_WGU), D, D, MP, 2 * FF, D, 0}; pg8::PadOrder S; S.init(2 * FF, D, F.G, blockIdx.x);
        pg8::EpiSwiGLU E{H_(F)}; pg8::gemm_phase(lds, g, S, E); }
    SEAM(11);
    if (IN(12)) { { const Frame F = make_frame(lds);
        pg8::Gemm g{H_(F), (const bf16_t*)(F.ws + WS_WD), FF, FF, MP, D, FF, 0}; pg8::TailSplitOrder S; S.init(D, FF, F.G, blockIdx.x, 1);
        pg8::EpiDownFinal<0, false> E{X0_(F), X_(F), 0.5f, F.a->in[32], F.out, nullptr, (unsigned*)(F.ws + WS_CTL + CTL_XBUF + 2 * 262144), (unsigned*)(F.ws + WS_CTL + CTL_CNT) + 2 * 2048}; pg8::gemm_phase(lds, g, S, E); }
      if ((int)blockIdx.x < 24 * pg8::TS_NSPLIT) { const Frame F = make_frame(lds);
        pg8::Gemm g{H_(F), (const bf16_t*)(F.ws + WS_WD), FF, FF, MP, D, FF, 0}; pg8::TailSplitOrder S; S.init(D, FF, F.G, blockIdx.x, 2);
        pg8::EpiAdd<false> E{X0_(F), X_(F), PB_(F), 0.5f}; pg8::gemm_phase(lds, g, S, E); } }
    SEAM(12);
    if (IN(13) && DBG_STOP < 99) { const Frame F = make_frame(lds);
        const f32x4* src = (const f32x4*)(F.ws + DBG_SRC); f32x4* dst = (f32x4*)F.out;
        for (size_t i = (size_t)blockIdx.x * 512 + F.tid; i < O_PP / 4; i += (size_t)F.G * 512) dst[i] = src[i];
    } else
    if (IN(13)) { const Frame F = make_frame(lds); const float* X = X_(F);
        for (int r = pg8::TS_ROWS0 + F.gw; r < MV; r += F.NGW) {
            float* o;
            if (r < MPR) { const int b = r / LP, t = r - b * LP; if (t < NMETA) continue; o = F.out + O_YP + ((size_t)b * SEQ + (t - NMETA)) * D; }
            else o = F.out + O_YS + (size_t)(r - MPR) * D;
            rms_row(X + (size_t)r * D, F.a->in[32], nullptr, o, F.lane, nullptr, r >= pg8::TS_ROWS0 ? PB_(F) + (size_t)(r - pg8::TS_ROWS0) * D : nullptr, (size_t)(MP - pg8::TS_ROWS0) * D);
        }
    }
#undef IN
#undef SEAM
}

extern "C" void kernel_launch(void* const* d_in, const int* in_sizes, int n_in, void* d_out, int out_size, void* d_ws, size_t ws_size, hipStream_t stream) {
    static int grid = 0;
    if (grid == 0) {
        if (n_in != 33 || ws_size < WS_END) { fprintf(stderr, "kernel_launch: expected 33 inputs and >= %zu bytes of workspace; got %d, %zu\n", (size_t)WS_END, n_in, ws_size); grid = -1; return; }
        int dev = 0, cus = 0, per_cu = 0;
        if (hipGetDevice(&dev) != hipSuccess || hipDeviceGetAttribute(&cus, hipDeviceAttributeMultiprocessorCount, dev) != hipSuccess) { grid = -1; return; }
        if (hipFuncSetAttribute((const void*)mk_fwd, hipFuncAttributeMaxDynamicSharedMemorySize, LDS_BYTES) != hipSuccess) { fprintf(stderr, "kernel_launch: hipFuncSetAttribute failed\n"); grid = -1; return; }
        if (hipOccupancyMaxActiveBlocksPerMultiprocessor(&per_cu, (const void*)mk_fwd, 512, LDS_BYTES) != hipSuccess || per_cu < 1) { fprintf(stderr, "kernel_launch: occupancy query says %d\n", per_cu); per_cu = 1; }
        (void)hipGetLastError();
        grid = cus * per_cu;
        if (grid > 256) grid = 256;
        if (grid != 256) fprintf(stderr, "kernel_launch: this kernel needs a 256-workgroup cooperative grid; got capacity %d\n", grid);
    }
    if (grid < 0) return;
    Args a{};
    for (int i = 0; i < 33; ++i) a.in[i] = (const float*)d_in[i];
    a.out = (float*)d_out; a.ws = (unsigned char*)d_ws;
#if MK_N_LAUNCHES == 1
    if (hipMemsetAsync((char*)d_ws + WS_CTL, 0, CTL_XBUF  , stream) != hipSuccess) { fprintf(stderr, "kernel_launch: hipMemsetAsync failed\n"); return; }
    a.ph_lo = 0; a.ph_hi = N_PHASES;
    void* kargs[] = {&a};
    hipError_t e = hipLaunchCooperativeKernel((const void*)mk_fwd, dim3(grid), dim3(512), kargs, LDS_BYTES, stream);
    if (e != hipSuccess) fprintf(stderr, "kernel_launch: cooperative launch failed: %s (grid %d)\n", hipGetErrorString(e), grid);
#else
    for (int p = 0; p < N_PHASES; ++p) { a.ph_lo = p; a.ph_hi = p + 1; hipLaunchKernelGGL(mk_fwd, dim3(grid), dim3(512), LDS_BYTES, stream, a); }
#endif
}
```

```cpp
#include <hip/hip_runtime.h>
#include <hip/hip_cooperative_groups.h>
#include <cstdio>
#include <cstdint>
namespace cg = cooperative_groups;

#ifndef MK_N_LAUNCHES
#define MK_N_LAUNCHES 1
#endif

#define LAS __attribute__((address_space(3)))
typedef unsigned short bf16_t;
typedef short bf16x8 __attribute__((ext_vector_type(8)));
typedef float f32x4 __attribute__((ext_vector_type(4)));
typedef float f32x2 __attribute__((ext_vector_type(2)));
typedef unsigned u32x4 __attribute__((ext_vector_type(4)));
typedef unsigned u32x2 __attribute__((ext_vector_type(2)));

constexpr int D = 2048, FF = 5632, NBP = 4, SEQ = 2048, NMETA = 16, LP = SEQ + NMETA  , NBS = 128, LS = 4;
constexpr int MPR = NBP * LP  , MSA = NBS * LS  , MV = MPR + MSA  , MP = 8960  ;
constexpr int WPOOL = 1024, WSSM = 1024, NG = 64, NP = 64, GS = 16, WIN = 6144, NCH = LP / 16  ;
constexpr float RMS_EPS = 1e-6f;
constexpr float LOG2E = 1.4426950408889634f;

constexpr size_t O_YP = 0, O_YS = 16777216, O_PP = 17825792, O_PS = 17887232, O_RP = 19853312, O_IP = 19869696, O_RS = 19886080, O_IS = 20410368;

constexpr size_t MiB = 1u << 20;
constexpr size_t WS_WGU = 0;
constexpr size_t WS_WD = 44 * MiB;
constexpr size_t WS_WIN = 66 * MiB;
constexpr size_t WS_PW = 90 * MiB;
constexpr size_t WS_GLU = 91 * MiB;
constexpr size_t WS_WA = 93 * MiB;
constexpr size_t WS_WB = 97 * MiB;
constexpr size_t WS_WOUT = 101 * MiB;
constexpr size_t WS_XN = 110 * MiB;
constexpr size_t WS_X = 145 * MiB;
constexpr size_t WS_R = 215 * MiB;
constexpr size_t WS_H = WS_R;
constexpr size_t WS_UP = WS_R;
constexpr size_t WS_US = WS_R + 35 * MiB;
constexpr size_t WS_T1 = WS_R;
constexpr size_t WS_PB = WS_R + 100 * MiB;
constexpr size_t WS_G = WS_R + 70 * MiB;
constexpr size_t WS_DD = WS_R + 140 * MiB;
constexpr size_t WS_SG = WS_DD + 18 * MiB;
constexpr size_t WS_MRG = WS_SG + 18 * MiB;
constexpr size_t WS_CTL = WS_MRG + 35 * MiB;
constexpr size_t CTL_BYTES = 65536 + 3 * 262144;
constexpr size_t CTL_CNT = 16384, CTL_XBUF = 65536;
constexpr size_t WS_END = WS_CTL + CTL_BYTES;
static_assert((size_t)MP * 2048 * 2 <= 35 * MiB && (size_t)MP * 1024 * 2 <= 18 * MiB && (size_t)MP * FF * 2 <= 140 * MiB, "ws map");

constexpr int LDS_BYTES = 147456;

__device__ __forceinline__ unsigned f2bf(float f) { unsigned u = __builtin_bit_cast(unsigned, f); return (u + 0x7fffu + ((u >> 16) & 1u)) >> 16; }
__device__ __forceinline__ float bf2f(unsigned b) { return __builtin_bit_cast(float, b << 16); }
typedef __bf16 bf16x2v __attribute__((ext_vector_type(2)));
__device__ __forceinline__ unsigned cvt_pk_bf16(float lo, float hi) { const f32x2 v = {lo, hi}; const bf16x2v b = __builtin_convertvector(v, bf16x2v); return __builtin_bit_cast(unsigned, b); }
__device__ __forceinline__ u32x4 pack8(f32x4 a, f32x4 b) { u32x4 w; w.x = cvt_pk_bf16(a[0], a[1]); w.y = cvt_pk_bf16(a[2], a[3]); w.z = cvt_pk_bf16(b[0], b[1]); w.w = cvt_pk_bf16(b[2], b[3]); return w; }
__device__ __forceinline__ void unpack8(u32x4 w, f32x4& a, f32x4& b) {
    a[0] = __builtin_bit_cast(float, w.x << 16); a[1] = __builtin_bit_cast(float, w.x & 0xffff0000u); a[2] = __builtin_bit_cast(float, w.y << 16); a[3] = __builtin_bit_cast(float, w.y & 0xffff0000u);
    b[0] = __builtin_bit_cast(float, w.z << 16); b[1] = __builtin_bit_cast(float, w.z & 0xffff0000u); b[2] = __builtin_bit_cast(float, w.w << 16); b[3] = __builtin_bit_cast(float, w.w & 0xffff0000u); }
__device__ __forceinline__ float sigm(float x) { return __builtin_amdgcn_rcpf(1.0f + __builtin_amdgcn_exp2f(-LOG2E * x)); }
__device__ __forceinline__ f32x4 sigm4(f32x4 x) { f32x4 r; r[0] = sigm(x[0]); r[1] = sigm(x[1]); r[2] = sigm(x[2]); r[3] = sigm(x[3]); return r; }
__device__ __forceinline__ float gelu_tanh(float x) { const float z = 1.5957691216057308f * (x + 0.044715f * x * x * x); return x * sigm(z); }
__device__ __forceinline__ float wave_sum(float v) {
#pragma unroll
    for (int o = 1; o < 64; o <<= 1) v += __shfl_xor(v, o);
    return v;
}

struct X0Src { const float* meta; const float* xp; const float* xs; };
__device__ __forceinline__ const float* x0_row(const X0Src& s, int r) {
    if (r < MPR) { const int b = r / LP, t = r - b * LP; return t < NMETA ? s.meta + (size_t)t * D : s.xp + ((size_t)b * SEQ + (t - NMETA)) * D; }
    if (r < MV) return s.xs + (size_t)(r - MPR) * D;
    return nullptr;
}

namespace pg8 {
constexpr int BM = 256, BK = 64, HALF = 128, HTB = HALF * BK * 2, NXCD = 8, WGM = 8;
__host__ __device__ __forceinline__ int lds_byte(int r, int c) { const int st = (r >> 4) * 2 + (c >> 5), rr = r & 15, cc = c & 31, ob = rr * 64 + cc * 2; return st * 1024 + (ob ^ (((ob >> 9) & 1) << 5)); }
__host__ __device__ __forceinline__ void stage_rc(int b, int& R, int& C) { const int st = b / 1024, sb = b % 1024, swz = sb ^ (((sb >> 9) & 1) << 5); R = (st >> 1) * 16 + swz / 64; C = (st & 1) * 32 + (swz % 64) / 2; }
__host__ __device__ __forceinline__ int perm32(int rho) { const int n = rho >> 4, i = rho & 15; return 8 * (i >> 2) + 4 * n + (i & 3); }

struct Unit { int pm, pn, kt0, nkt, full; };
struct Gemm { const bf16_t* A; const bf16_t* Bt; int lda, ldb, M, N, K, a_pn_bytes; };

struct StaticOrder {
    int nM, nN, nwg, G, c, nkt;
    __device__ void init(int M, int N, int G_, int c_, int K = 0) { nM = M / BM; nN = N / BM; nwg = nM * nN; G = G_; c = c_; nkt = K / BK; }
    __device__ bool next(int i, Unit& u) const {
        const long L = (long)i * G + c; if (L >= nwg) return false;
        int wgid = (int)L; { const int q = nwg / NXCD, r = nwg % NXCD, xcd = wgid % NXCD, off = wgid / NXCD; wgid = (xcd < r ? xcd * (q + 1) : r * (q + 1) + (xcd - r) * q) + off; }
        const int nig = WGM * nN, gid = wgid / nig, fm = gid * WGM, gsz = (nM - fm) < WGM ? (nM - fm) : WGM;
        u.pm = fm + ((wgid % nig) % gsz); u.pn = (wgid % nig) / gsz; u.kt0 = 0; u.nkt = nkt; u.full = 1; return true;
    }
};
struct PadOrder {
    StaticOrder so; int c, nN, nkt;
    __device__ void init(int N, int K, int G, int c_) { so.init((MP / BM - 1) * BM, N, G, c_, K); c = c_; nN = N / BM; nkt = K / BK; }
    __device__ bool next(int i, Unit& u) const {
        if (so.next(i, u)) return true;
        const int n0 = so.nwg / so.G, rem = so.nwg - n0 * so.G;
        if (i < n0 || c < rem) return false;
        const int f = (i - n0) * (so.G - rem) + (c - rem); if (f >= nN) return false;
        u.pm = MP / BM - 1; u.pn = f; u.kt0 = 0; u.nkt = nkt; u.full = 1; return true;
    }
};
constexpr int TS_ROWS0 = 8192, TS_NSPLIT = 4;
struct TailSplitOrder {
    StaticOrder so; int c, nkt, mode;
    __device__ void init(int N, int K, int G, int c_, int mode_ = 0) { so.init(TS_ROWS0, N, G, c_, K); c = c_; nkt = K / BK; mode = mode_; }
    __device__ bool next(int i, Unit& u) const {
        if (mode == 2) ++i;
        if (i == 0) return so.next(0, u);
        if (i > 1 || mode == 1 || c >= 24 * TS_NSPLIT) return false;
        const int t = c / TS_NSPLIT, kq = c % TS_NSPLIT;
        u.pm = TS_ROWS0 / BM + (t >> 3); u.pn = t & 7; u.nkt = nkt / TS_NSPLIT; u.kt0 = kq * u.nkt; u.full = 0; return true;
    }
};

template <class Epi, class Order>
__device__ __forceinline__ void gemm_phase(LAS unsigned char* lds, const Gemm g, const Order& S, const Epi& E) {
    int tid_ = threadIdx.x; asm volatile("" : "+v"(tid_));
    const int tid = tid_, wid = __builtin_amdgcn_readfirstlane(tid >> 6), lane = tid & 63, wr = wid >> 2, wc = wid & 3, fr = lane & 15, fq = lane >> 4;
    unsigned voffA[2], voffB[2];
#pragma unroll
    for (int i = 0; i < 2; ++i) { int R, C; stage_rc(tid * 16 + i * 8192, R, C); const int Rb = (R & ~31) + perm32(R & 31);
        voffA[i] = (unsigned)(R * g.lda + C) * 2u; voffB[i] = (unsigned)(Rb * g.ldb + C) * 2u; }
    const size_t kstep = (size_t)(BK * 2);
    const size_t hstepA = (size_t)HALF * g.lda * 2, hstepB = (size_t)HALF * g.ldb * 2;
    const size_t tstepA = 2 * hstepA, tstepB = 2 * hstepB;
    const unsigned ldsw = (unsigned)wid * 1024u;
    const int aoff = lds_byte(wr * 64 + fr, fq * 8), boff = lds_byte(wc * 32 + fr, fq * 8);
#define PG8_SA(b, h) (((b) * 2 + (h)) * HTB)
#define PG8_SB(b, h) ((4 + (b) * 2 + (h)) * HTB)
#define PG8_STAGE(bufoff, gbase, voff) do { _Pragma("unroll") for (int _i = 0; _i < 2; ++_i) \
        __builtin_amdgcn_global_load_lds((const unsigned*)((const char*)(gbase) + (voff)[_i]), (LAS unsigned*)(lds + (bufoff) + ldsw + _i * 8192), 16, 0, 0); } while (0)
#define PG8_LDA(dst, b, h) do { _Pragma("unroll") for (int m = 0; m < 4; ++m) _Pragma("unroll") for (int k = 0; k < 2; ++k) dst[m][k] = *(const LAS bf16x8*)(lds + PG8_SA(b, h) + aoff + m * 2048 + k * 1024); } while (0)
#define PG8_LDB(dst, b, h) do { _Pragma("unroll") for (int n = 0; n < 2; ++n) _Pragma("unroll") for (int k = 0; k < 2; ++k) dst[n][k] = *(const LAS bf16x8*)(lds + PG8_SB(b, h) + boff + n * 2048 + k * 1024); } while (0)
#define PG8_MMA(ai, bj, At, Bt) do { __builtin_amdgcn_s_setprio(1); _Pragma("unroll") for (int m = 0; m < 4; ++m) _Pragma("unroll") for (int n = 0; n < 2; ++n) _Pragma("unroll") for (int k = 0; k < 2; ++k) \
        acc[ai][bj][m][n] = __builtin_amdgcn_mfma_f32_16x16x32_bf16(Bt[n][k], At[m][k], acc[ai][bj][m][n], 0, 0, 0); __builtin_amdgcn_s_setprio(0); } while (0)
#define PG8_WAIT_V(n) asm volatile("s_waitcnt vmcnt(" #n ")" ::: "memory")
#define PG8_WAIT_L(n) asm volatile("s_waitcnt lgkmcnt(" #n ")" ::: "memory")
#define PG8_BAR __builtin_amdgcn_s_barrier()
#define PG8_SCHED __builtin_amdgcn_sched_barrier(0)
    Unit cur, nxt; int ui = 0;
    if (!S.next(0, cur)) return;
    f32x4 acc[2][2][4][2];
#pragma unroll
    for (int a = 0; a < 2; ++a)
#pragma unroll
        for (int b = 0; b < 2; ++b)
#pragma unroll
            for (int m = 0; m < 4; ++m)
#pragma unroll
                for (int n = 0; n < 2; ++n) acc[a][b][m][n] = (f32x4){0.f, 0.f, 0.f, 0.f};
    bf16x8 At[4][2], B0[2][2], B1[2][2];
    const char* cA = (const char*)g.A + (size_t)cur.pm * tstepA + (size_t)cur.pn * g.a_pn_bytes + (size_t)cur.kt0 * kstep; const char* cB = (const char*)g.Bt + (size_t)cur.pn * tstepB + (size_t)cur.kt0 * kstep;
    PG8_STAGE(PG8_SB(0, 0), cB, voffB); PG8_STAGE(PG8_SB(0, 1), cB + hstepB, voffB); PG8_STAGE(PG8_SA(0, 0), cA, voffA); PG8_STAGE(PG8_SA(0, 1), cA + hstepA, voffA);
    if (wr == 1) PG8_BAR;
    PG8_WAIT_V(2); PG8_BAR;
    PG8_STAGE(PG8_SB(1, 0), cB + kstep, voffB); PG8_STAGE(PG8_SA(1, 0), cA + kstep, voffA); PG8_STAGE(PG8_SB(1, 1), cB + hstepB + kstep, voffB);
    PG8_WAIT_V(6); PG8_BAR;
    for (;;) {
        const bool has_next = S.next(ui + 1, nxt);
        const char* nA = has_next ? (const char*)g.A + (size_t)nxt.pm * tstepA + (size_t)nxt.pn * g.a_pn_bytes + (size_t)nxt.kt0 * kstep : cA; const char* nB = has_next ? (const char*)g.Bt + (size_t)nxt.pn * tstepB + (size_t)nxt.kt0 * kstep : cB;
        const int nt = cur.nkt;
        const int row_w = __builtin_amdgcn_readfirstlane(cur.pm) * BM + wr * 64;
        const bool do0 = row_w < MV, do1 = row_w + HALF < MV;
        if (do0 && do1) {
        for (int t = 0; t < nt; t += 2) {
            const bool last = (t == nt - 2);
            const char* a1 = cA + (size_t)(t + 1) * kstep;
            const char* a2 = last ? nA : cA + (size_t)(t + 2) * kstep; const char* b2 = last ? nB : cB + (size_t)(t + 2) * kstep;
            const char* a3 = a2 + kstep; const char* b3 = b2 + kstep;
            PG8_LDB(B0, 0, 0); PG8_LDB(B1, 0, 1); PG8_SCHED; PG8_LDA(At, 0, 0); PG8_STAGE(PG8_SA(1, 1), a1 + hstepA, voffA);
            PG8_WAIT_V(8); PG8_WAIT_L(0); PG8_BAR; { PG8_MMA(0, 0, At, B0); PG8_MMA(0, 1, At, B1); } PG8_BAR; PG8_SCHED;
            PG8_LDA(At, 0, 1); PG8_STAGE(PG8_SB(0, 0), b2, voffB); PG8_STAGE(PG8_SB(0, 1), b2 + hstepB, voffB); PG8_STAGE(PG8_SA(0, 0), a2, voffA);
            PG8_WAIT_V(8); PG8_WAIT_L(0); PG8_BAR; { PG8_MMA(1, 0, At, B0); PG8_MMA(1, 1, At, B1); } PG8_BAR; PG8_SCHED;
            PG8_LDB(B0, 1, 0); PG8_LDB(B1, 1, 1); PG8_SCHED; PG8_LDA(At, 1, 0); PG8_STAGE(PG8_SA(0, 1), a2 + hstepA, voffA);
            PG8_WAIT_V(8); PG8_WAIT_L(0); PG8_BAR; { PG8_MMA(0, 0, At, B0); PG8_MMA(0, 1, At, B1); } PG8_BAR; PG8_SCHED;
            PG8_LDA(At, 1, 1); PG8_STAGE(PG8_SB(1, 0), b3, voffB); PG8_STAGE(PG8_SB(1, 1), b3 + hstepB, voffB); PG8_STAGE(PG8_SA(1, 0), a3, voffA);
            PG8_WAIT_V(8); PG8_WAIT_L(0); PG8_BAR; { PG8_MMA(1, 0, At, B0); PG8_MMA(1, 1, At, B1); } PG8_BAR; PG8_SCHED;
        }
        } else {
        for (int t = 0; t < nt; t += 2) {
            const bool last = (t == nt - 2);
            const char* a1 = cA + (size_t)(t + 1) * kstep;
            const char* a2 = last ? nA : cA + (size_t)(t + 2) * kstep; const char* b2 = last ? nB : cB + (size_t)(t + 2) * kstep;
            const char* a3 = a2 + kstep; const char* b3 = b2 + kstep;
            PG8_LDB(B0, 0, 0); PG8_LDB(B1, 0, 1); PG8_SCHED; PG8_LDA(At, 0, 0); PG8_STAGE(PG8_SA(1, 1), a1 + hstepA, voffA);
            PG8_WAIT_V(8); PG8_WAIT_L(0); PG8_BAR; if (do0) { PG8_MMA(0, 0, At, B0); PG8_MMA(0, 1, At, B1); } PG8_BAR; PG8_SCHED;
            PG8_LDA(At, 0, 1); PG8_STAGE(PG8_SB(0, 0), b2, voffB); PG8_STAGE(PG8_SB(0, 1), b2 + hstepB, voffB); PG8_STAGE(PG8_SA(0, 0), a2, voffA);
            PG8_WAIT_V(8); PG8_WAIT_L(0); PG8_BAR; if (do1) { PG8_MMA(1, 0, At, B0); PG8_MMA(1, 1, At, B1); } PG8_BAR; PG8_SCHED;
            PG8_LDB(B0, 1, 0); PG8_LDB(B1, 1, 1); PG8_SCHED; PG8_LDA(At, 1, 0); PG8_STAGE(PG8_SA(0, 1), a2 + hstepA, voffA);
            PG8_WAIT_V(8); PG8_WAIT_L(0); PG8_BAR; if (do0) { PG8_MMA(0, 0, At, B0); PG8_MMA(0, 1, At, B1); } PG8_BAR; PG8_SCHED;
            PG8_LDA(At, 1, 1); PG8_STAGE(PG8_SB(1, 0), b3, voffB); PG8_STAGE(PG8_SB(1, 1), b3 + hstepB, voffB); PG8_STAGE(PG8_SA(1, 0), a3, voffA);
            PG8_WAIT_V(8); PG8_WAIT_L(0); PG8_BAR; if (do1) { PG8_MMA(1, 0, At, B0); PG8_MMA(1, 1, At, B1); } PG8_BAR; PG8_SCHED;
        }
        }
        if (wr == 0) PG8_BAR;
        if constexpr (Epi::FUSED) E.fused(acc, cur, wr, wc, fr, fq, lds, wid, lane); else E(acc, cur, wr, wc, fr, fq);
        if (!has_next) break;
#pragma unroll
        for (int a = 0; a < 2; ++a)
#pragma unroll
            for (int b = 0; b < 2; ++b)
#pragma unroll
                for (int m = 0; m < 4; ++m)
#pragma unroll
                    for (int n = 0; n < 2; ++n) acc[a][b][m][n] = (f32x4){0.f, 0.f, 0.f, 0.f};
        cur = nxt; cA = nA; cB = nB; ++ui;
        if (wr == 1) PG8_BAR;
    }
    PG8_WAIT_V(0);
    PG8_BAR;
#undef PG8_SA
#undef PG8_SB
#undef PG8_STAGE
#undef PG8_LDA
#undef PG8_LDB
#undef PG8_MMA
#undef PG8_WAIT_V
#undef PG8_WAIT_L
#undef PG8_BAR
#undef PG8_SCHED
}

typedef const f32x4 (&AccRef)[2][2][4][2];
#define EPI_ROWS(...) _Pragma("unroll") for (int ai = 0; ai < 2; ++ai) _Pragma("unroll") for (int m = 0; m < 4; ++m) { const int r = u.pm * BM + ai * HALF + wr * 64 + m * 16 + fr; __VA_ARGS__; asm volatile("" ::: "memory"); }

struct EpiSwiGLU { static constexpr bool FUSED = false;
    bf16_t* H;
    __device__ __forceinline__ void operator()(AccRef acc, const Unit& u, int wr, int wc, int fr, int fq) const {
        const int col0 = u.pn * 128 + wc * 32 + 8 * fq;
        EPI_ROWS({
            const f32x4 g0 = acc[ai][0][m][0], g1 = acc[ai][0][m][1];
            const f32x4 v0 = g0 * sigm4(g0) * acc[ai][1][m][0], v1 = g1 * sigm4(g1) * acc[ai][1][m][1];
            *(u32x4*)(H + (size_t)r * FF + col0) = pack8(v0, v1);
        })
    }
};
template <bool X0> struct EpiAdd { static constexpr bool FUSED = false;
    X0Src src; float* out; float* pb; float scale;
    __device__ __forceinline__ void operator()(AccRef acc, const Unit& u, int wr, int wc, int fr, int fq) const {
        const int col0 = u.pn * BM + wc * 32 + 8 * fq;
        if (u.kt0 == 0) {
            EPI_ROWS({
                float* op = out + (size_t)r * D + col0; const float* bp = X0 ? x0_row(src, r) : out + (size_t)r * D;
                _Pragma("unroll") for (int bj = 0; bj < 2; ++bj) {
                    f32x4 b0 = (f32x4){0.f, 0.f, 0.f, 0.f}, b1 = b0;
                    if (!X0 || bp) { b0 = *(const f32x4*)(bp + col0 + bj * HALF); b1 = *(const f32x4*)(bp + col0 + bj * HALF + 4); }
                    *(f32x4*)(op + bj * HALF) = b0 + scale * acc[ai][bj][m][0]; *(f32x4*)(op + bj * HALF + 4) = b1 + scale * acc[ai][bj][m][1]; }
            })
        } else {
            float* pbq = pb + (size_t)(u.kt0 / u.nkt - 1) * ((size_t)(MP - TS_ROWS0) * D) - (size_t)TS_ROWS0 * D;
            EPI_ROWS({
                float* op = pbq + (size_t)r * D + col0;
                _Pragma("unroll") for (int bj = 0; bj < 2; ++bj) { *(f32x4*)(op + bj * HALF) = scale * acc[ai][bj][m][0]; *(f32x4*)(op + bj * HALF + 4) = scale * acc[ai][bj][m][1]; }
            })
        }
    }
};
template <int MODE  , bool X0> struct EpiDownFinal { static constexpr bool FUSED = true;
    X0Src src; float* X; float scale; const float* gain; float* out; bf16_t* XN; unsigned* xbuf; unsigned* cnt;
    __device__ __forceinline__ void fused(f32x4 (&acc)[2][2][4][2], const Unit& u, int wr, int wc, int fr, int fq, LAS unsigned char* lds, int wid, int lane) const {
        const int col0 = u.pn * BM + wc * 32 + 8 * fq;
        int c1 = col0, pm1 = u.pm, rb1 = wr * 64 + fr, wc1 = wc; asm volatile("" : "+v"(c1), "+s"(pm1), "+v"(rb1), "+v"(wc1));
        LAS float* P = (LAS float*)(lds + 131072);
        LAS float* S = (LAS float*)(lds + 131072 + 4096);
#pragma unroll
        for (int ai = 0; ai < 2; ++ai)
#pragma unroll
            for (int m = 0; m < 4; ++m) { const int r = pm1 * BM + ai * HALF + m * 16 + rb1; const float* xp = (X0 ? x0_row(src, r) : X + (size_t)r * D) + c1; float* xo = X + (size_t)r * D + c1; float q = 0.f;
#pragma unroll
                for (int bj = 0; bj < 2; ++bj)
#pragma unroll
                    for (int n = 0; n < 2; ++n) { const f32x4 b = *(const f32x4*)(xp + bj * HALF + 4 * n); const f32x4 v = b + scale * acc[ai][bj][m][n]; acc[ai][bj][m][n] = v;
                        if (MODE == 1) *(f32x4*)(xo + bj * HALF + 4 * n) = v;
                        q += (v[0] * v[0] + v[1] * v[1]) + (v[2] * v[2] + v[3] * v[3]); }
                q += __shfl_xor(q, 16); q += __shfl_xor(q, 32);
                if (fq == 0) P[(ai * HALF + m * 16 + rb1) * 4 + wc1] = q;
                asm volatile("" ::: "memory"); }
        asm volatile("s_waitcnt lgkmcnt(0)" ::: "memory"); __builtin_amdgcn_s_barrier(); asm volatile("" ::: "memory");
        int row = wid * 32 + (lane & 31); asm volatile("" : "+v"(row));
        if (lane < 32) { const float t = (P[row * 4 + 0] + P[row * 4 + 1]) + (P[row * 4 + 2] + P[row * 4 + 3]);
            __hip_atomic_store(xbuf + ((size_t)(u.pm * BM + row) * 8 + u.pn), __builtin_bit_cast(unsigned, t), __ATOMIC_RELAXED, __HIP_MEMORY_SCOPE_AGENT); }
        asm volatile("s_waitcnt vmcnt(0)" ::: "memory");
        if (lane == 0) (void)__hip_atomic_fetch_add(cnt + 64 * u.pm, 1u, __ATOMIC_RELAXED, __HIP_MEMORY_SCOPE_AGENT);
        if (wid == 0) { unsigned sp = 0;
            _Pragma("unroll 1") while ((unsigned)__builtin_amdgcn_readfirstlane(__hip_atomic_load(cnt + 64 * u.pm, __ATOMIC_RELAXED, __HIP_MEMORY_SCOPE_AGENT)) < 64u) { __builtin_amdgcn_s_sleep(2); if (++sp > (1u << 22)) break; }
            __builtin_amdgcn_fence(__ATOMIC_ACQUIRE, "agent"); }
        asm volatile("s_waitcnt vmcnt(0) lgkmcnt(0)" ::: "memory"); __builtin_amdgcn_s_barrier(); asm volatile("" ::: "memory");
        if (lane < 32) { const unsigned* sl = xbuf + (size_t)(u.pm * BM + row) * 8; float t = 0.f;
#pragma unroll
            for (int k = 0; k < 8; ++k) t += __builtin_bit_cast(float, __hip_atomic_load(sl + k, __ATOMIC_RELAXED, __HIP_MEMORY_SCOPE_AGENT));
            S[row] = 1.0f / sqrtf(t * (1.0f / D) + RMS_EPS); }
        asm volatile("s_waitcnt vmcnt(0) lgkmcnt(0)" ::: "memory"); __builtin_amdgcn_s_barrier(); asm volatile("" ::: "memory");
        int c5 = col0, pm5 = u.pm, rb5 = wr * 64 + fr; asm volatile("" : "+v"(c5), "+s"(pm5), "+v"(rb5));
        const int b0 = (pm5 * BM) / LP, t0 = pm5 * BM - b0 * LP;
#pragma unroll
        for (int ai = 0; ai < 2; ++ai)
#pragma unroll
            for (int m = 0; m < 4; ++m) { const int rl = ai * HALF + m * 16 + rb5; const float rs = S[rl];
                if (MODE == 0) { int t = t0 + rl, b = b0; if (t >= LP) { t -= LP; ++b; }
                    if (t >= NMETA) { float* op = out + O_YP + ((size_t)b * SEQ + (t - NMETA)) * D + c5;
#pragma unroll
                        for (int bj = 0; bj < 2; ++bj) { const f32x4 g0 = *(const f32x4*)(gain + c5 + bj * HALF), g1 = *(const f32x4*)(gain + c5 + bj * HALF + 4);
                            *(f32x4*)(op + bj * HALF) = acc[ai][bj][m][0] * rs * g0; *(f32x4*)(op + bj * HALF + 4) = acc[ai][bj][m][1] * rs * g1; } } }
                else { bf16_t* op = XN + (size_t)(pm5 * BM + rl) * D + c5;
#pragma unroll
                    for (int bj = 0; bj < 2; ++bj) { const f32x4 g0 = *(const f32x4*)(gain + c5 + bj * HALF), g1 = *(const f32x4*)(gain + c5 + bj * HALF + 4);
                        *(u32x4*)(op + bj * HALF) = pack8(acc[ai][bj][m][0] * rs * g0, acc[ai][bj][m][1] * rs * g1); } }
                asm volatile("" ::: "memory"); }
    }
};
struct EpiWin { static constexpr bool FUSED = false;
    float* UP; float* US; bf16_t* G; const float* bg;
    __device__ __forceinline__ void operator()(AccRef acc, const Unit& u, int wr, int wc, int fr, int fq) const {
        if (u.pn < 8) {
            float* O = (u.pn < 4 ? UP : US); const int col0 = (u.pn & 3) * BM + wc * 32 + 8 * fq;
            EPI_ROWS({
                float* op = O + (size_t)r * 1024 + col0;
                _Pragma("unroll") for (int bj = 0; bj < 2; ++bj) { *(f32x4*)(op + bj * HALF) = acc[ai][bj][m][0]; *(f32x4*)(op + bj * HALF + 4) = acc[ai][bj][m][1]; }
            })
        } else {
            const int col0 = (u.pn - 8) * BM + wc * 32 + 8 * fq;
            f32x4 bv[2][2];
#pragma unroll
            for (int bj = 0; bj < 2; ++bj) { bv[bj][0] = *(const f32x4*)(bg + col0 + bj * HALF); bv[bj][1] = *(const f32x4*)(bg + col0 + bj * HALF + 4); }
            EPI_ROWS({
                bf16_t* op = G + (size_t)r * 4096 + col0;
                _Pragma("unroll") for (int bj = 0; bj < 2; ++bj) *(u32x4*)(op + bj * HALF) = pack8(sigm4(acc[ai][bj][m][0] + bv[bj][0]), sigm4(acc[ai][bj][m][1] + bv[bj][1]));
            })
        }
    }
};
struct EpiPool { static constexpr bool FUSED = false;
    bf16_t* AB; const float* sc;
    __device__ __forceinline__ void operator()(AccRef acc, const Unit& u, int wr, int wc, int fr, int fq) const {
        const int col0 = u.pn * BM + wc * 32 + 8 * fq;
        f32x4 sv[2][2];
#pragma unroll
        for (int bj = 0; bj < 2; ++bj) { sv[bj][0] = *(const f32x4*)(sc + col0 + bj * HALF); sv[bj][1] = *(const f32x4*)(sc + col0 + bj * HALF + 4); }
        EPI_ROWS({
            bf16_t* op = AB + (size_t)r * 2048 + col0;
            _Pragma("unroll") for (int bj = 0; bj < 2; ++bj) *(u32x4*)(op + bj * HALF) = pack8(acc[ai][bj][m][0] * sv[bj][0], acc[ai][bj][m][1] * sv[bj][1]);
        })
    }
};
struct EpiGLU { static constexpr bool FUSED = false;
    bf16_t* AB; const bf16_t* SG; const float* gb;
    __device__ __forceinline__ void operator()(AccRef acc, const Unit& u, int wr, int wc, int fr, int fq) const {
        const int col0 = u.pn * BM + wc * 32 + 8 * fq;
        f32x4 bv[2][2];
#pragma unroll
        for (int bj = 0; bj < 2; ++bj) { bv[bj][0] = *(const f32x4*)(gb + col0 + bj * HALF); bv[bj][1] = *(const f32x4*)(gb + col0 + bj * HALF + 4); }
        EPI_ROWS({
            bf16_t* op = AB + (size_t)r * 2048 + 1024 + col0; const bf16_t* sp = SG + (size_t)r * 1024 + col0;
            _Pragma("unroll") for (int bj = 0; bj < 2; ++bj) { f32x4 s0, s1; unpack8(*(const u32x4*)(sp + bj * HALF), s0, s1);
                *(u32x4*)(op + bj * HALF) = pack8(s0 * sigm4(acc[ai][bj][m][0] + bv[bj][0]), s1 * sigm4(acc[ai][bj][m][1] + bv[bj][1])); }
        })
    }
};
struct EpiBr1 { static constexpr bool FUSED = false;
    bf16_t* T1; const bf16_t* G;
    __device__ __forceinline__ void operator()(AccRef acc, const Unit& u, int wr, int wc, int fr, int fq) const {
        const int col0 = u.pn * BM + wc * 32 + 8 * fq;
        EPI_ROWS({
            bf16_t* op = T1 + (size_t)r * 2048 + col0; const bf16_t* gp = G + (size_t)r * 4096 + col0;
            _Pragma("unroll") for (int bj = 0; bj < 2; ++bj) { f32x4 g0, g1; unpack8(*(const u32x4*)(gp + bj * HALF), g0, g1);
                *(u32x4*)(op + bj * HALF) = pack8(g0 * acc[ai][bj][m][0], g1 * acc[ai][bj][m][1]); }
        })
    }
};
struct EpiBr2 { static constexpr bool FUSED = false;
    const bf16_t* T1; const bf16_t* G; bf16_t* MRG;
    __device__ __forceinline__ void operator()(AccRef acc, const Unit& u, int wr, int wc, int fr, int fq) const {
        const int col0 = u.pn * BM + wc * 32 + 8 * fq;
        EPI_ROWS({
            const bf16_t* tp = T1 + (size_t)r * 2048 + col0; const bf16_t* gp = G + (size_t)r * 4096 + 2048 + col0; bf16_t* op = MRG + (size_t)r * 2048 + col0;
            _Pragma("unroll") for (int bj = 0; bj < 2; ++bj) { f32x4 g0, g1; unpack8(*(const u32x4*)(gp + bj * HALF), g0, g1);
                f32x4 t0, t1; unpack8(*(const u32x4*)(tp + bj * HALF), t0, t1);
                *(u32x4*)(op + bj * HALF) = pack8(t0 + g0 * acc[ai][bj][m][0], t1 + g1 * acc[ai][bj][m][1]); }
        })
    }
};
}

__device__ __forceinline__ void cvt_item(const float* W, int K, int N, bf16_t* WT, int mode, int item, int lane) {
    const int nblk = N >> 6, kb = item / nblk, nb = item - kb * nblk, k0 = kb << 6, n0 = nb << 6;
    const int rg = lane >> 4, nq = lane & 15;
    const float* src = W + (size_t)(k0 + 16 * rg) * N + n0 + 4 * nq;
    f32x4 v[16];
#pragma unroll
    for (int i = 0; i < 16; ++i) v[i] = __builtin_nontemporal_load((const f32x4*)(src + (size_t)i * N));
    const int drow0 = (mode == 0 ? n0 : ((n0 >> 7) * 256 + (mode == 2 ? 128 : 0) + (n0 & 127))) + 4 * nq;
    bf16_t* dst = WT + (size_t)drow0 * K + k0 + 16 * rg;
#pragma unroll
    for (int j = 0; j < 4; ++j)
#pragma unroll
        for (int h = 0; h < 2; ++h) {
            u32x4 w; w.x = cvt_pk_bf16(v[8 * h + 0][j], v[8 * h + 1][j]); w.y = cvt_pk_bf16(v[8 * h + 2][j], v[8 * h + 3][j]);
            w.z = cvt_pk_bf16(v[8 * h + 4][j], v[8 * h + 5][j]); w.w = cvt_pk_bf16(v[8 * h + 6][j], v[8 * h + 7][j]);
            *(u32x4*)(dst + (size_t)j * K + 8 * h) = w; }
}
struct Args { const float* in[33]; float* out; unsigned char* ws; int ph_lo, ph_hi; };
typedef const __attribute__((address_space(4))) Args* ArgsP;
struct Frame {
    ArgsP a; unsigned char* ws; float* out;
    LAS unsigned char* lds; int tid, lane, wave, G, gw, NGW;
};
__device__ __forceinline__ void cvt_ffn(const Frame& F, int i0, int w0, int nw, int part = 0, int nparts = 1) {
    constexpr int IG = (D / 64) * (FF / 64);
    bf16_t* wgu = (bf16_t*)(F.ws + WS_WGU); bf16_t* wd = (bf16_t*)(F.ws + WS_WD);
    const int ib = (int)((long)part * (3 * IG) / nparts), ie = (int)((long)(part + 1) * (3 * IG) / nparts);
    for (int it = ib + w0; it < ie; it += nw) {
        if (it < IG) cvt_item(F.a->in[i0], D, FF, wgu, 1, it, F.lane);
        else if (it < 2 * IG) cvt_item(F.a->in[i0 + 1], D, FF, wgu, 2, it - IG, F.lane);
        else cvt_item(F.a->in[i0 + 2], FF, D, wd, 0, it - 2 * IG, F.lane);
    }
}
__device__ __forceinline__ void cvt_mixer(const Frame& F, int w0, int nw, int it0, int it1) {
    constexpr int I_IN = (D / 64) * (WIN / 64)  , I_PW = 4 * 16, I_GLU = 256, I_A = 16 * 32, I_O = 32 * 32;
    constexpr int TOT = I_IN + I_PW + I_GLU + 2 * I_A + I_O;
    static_assert(TOT == 5440, "mixer conversion items");
    for (int it = it0 + w0; it < it1; it += nw) {
        int r = it;
        if (r < I_IN) { cvt_item(F.a->in[11], D, WIN, (bf16_t*)(F.ws + WS_WIN), 0, r, F.lane); continue; } r -= I_IN;
        if (r < I_PW) { const int g = r >> 4; cvt_item(F.a->in[13] + (size_t)g * 65536, 256, 256, (bf16_t*)(F.ws + WS_PW) + (size_t)g * 65536, 0, r & 15, F.lane); continue; } r -= I_PW;
        if (r < I_GLU) { cvt_item(F.a->in[23], 1024, 1024, (bf16_t*)(F.ws + WS_GLU), 0, r, F.lane); continue; } r -= I_GLU;
        if (r < I_A) { cvt_item(F.a->in[25], 1024, 2048, (bf16_t*)(F.ws + WS_WA), 0, r, F.lane); continue; } r -= I_A;
        if (r < I_A) { cvt_item(F.a->in[26], 1024, 2048, (bf16_t*)(F.ws + WS_WB), 0, r, F.lane); continue; } r -= I_A;
        cvt_item(F.a->in[27], 2048, 2048, (bf16_t*)(F.ws + WS_WOUT), 0, r, F.lane);
    }
}

__device__ __forceinline__ void rms_row(const float* xrow, const float* gain, bf16_t* orow, float* frow, int lane, float* copy = nullptr, const float* pbrow = nullptr, size_t pbstride = 0) {
    f32x4 v[8]; float s = 0.f;
#pragma unroll
    for (int j = 0; j < 8; ++j) { v[j] = ((const f32x4*)xrow)[64 * j + lane]; if (pbrow) { v[j] += ((const f32x4*)pbrow)[64 * j + lane]; v[j] += ((const f32x4*)(pbrow + pbstride))[64 * j + lane]; v[j] += ((const f32x4*)(pbrow + 2 * pbstride))[64 * j + lane]; } s += (v[j][0] * v[j][0] + v[j][1] * v[j][1]) + (v[j][2] * v[j][2] + v[j][3] * v[j][3]); }
    if (copy) {
#pragma unroll
        for (int j = 0; j < 8; ++j) ((f32x4*)copy)[64 * j + lane] = v[j]; }
    const float rs = 1.0f / sqrtf(wave_sum(s) * (1.0f / D) + RMS_EPS);
#pragma unroll
    for (int j = 0; j < 8; ++j) { const f32x4 gg = ((const f32x4*)gain)[64 * j + lane]; const f32x4 o = v[j] * rs * gg;
        if (orow) { u32x2 w; w.x = cvt_pk_bf16(o[0], o[1]); w.y = cvt_pk_bf16(o[2], o[3]); ((u32x2*)orow)[64 * j + lane] = w; }
        else ((f32x4*)frow)[64 * j + lane] = o; }
}
__device__ __forceinline__ void zero_row_bf16(bf16_t* orow, int lane) {
#pragma unroll
    for (int j = 0; j < 8; ++j) ((u32x2*)orow)[64 * j + lane] = (u32x2){0u, 0u};
}

__device__ __forceinline__ void sincos_r(float x, float& s, float& c) {
    const float k = rintf(x * 0.6366197723675814f);
    float r = fmaf(-k, 1.5707963705062866f, x); r = fmaf(-k, -4.371139000186241e-8f, r);
    const float z = r * r;
    const float sp = r + r * z * (-1.6666654611e-1f + z * (8.3321608736e-3f + z * (-1.9515295891e-4f)));
    const float cp = 1.0f - 0.5f * z + z * z * (4.166664568298827e-2f + z * (-1.388731625493765e-3f + z * 2.443315711809948e-5f));
    const int q = ((int)k) & 3;
    s = (q == 0) ? sp : (q == 1) ? cp : (q == 2) ? -sp : -cp;
    c = (q == 0) ? cp : (q == 1) ? -sp : (q == 2) ? -cp : sp;
}
__device__ __forceinline__ bf16x8 pack8s(f32x4 a, f32x4 b) { const u32x4 w = pack8(a, b); return __builtin_bit_cast(bf16x8, w); }

#define WSYNC() asm volatile("s_waitcnt lgkmcnt(0)" ::: "memory")
struct S5K { float lbr, lbi; bf16x8 bb[8]; bf16x8 cm[4]; f32x4 dsk; };

__device__ __forceinline__ void s5_consts(const Frame& F, int g, LAS float* tab, S5K& k) {
    const int lane = F.lane, i16 = lane & 15, kq = lane >> 4;
    const float lre = F.a->in[15][g * NP + lane], lim = F.a->in[16][g * NP + lane], dt = expf(F.a->in[17][g]);
    const float a = lre * dt, b = lim * dt;
    const float em1 = a * (1.0f + a * (0.5f + a * (1.0f / 6.0f + a * (1.0f / 24.0f + a * (1.0f / 120.0f + a * (1.0f / 720.0f))))));
    const float ea = 1.0f + em1;
    float sh, ch; sincos_r(0.5f * b, sh, ch);
    const float sb = 2.0f * sh * ch, cbm1 = -2.0f * sh * sh, cb = 1.0f + cbm1;
    k.lbr = ea * cb; k.lbi = ea * sb;
    const float rm1 = em1 * cb + cbm1, im1 = ea * sb;
    const float inv = 1.0f / (lre * lre + lim * lim);
    tab[2 * lane] = (rm1 * lre + im1 * lim) * inv; tab[2 * lane + 1] = (im1 * lre - rm1 * lim) * inv;
    WSYNC();
#pragma unroll
    for (int n4 = 0; n4 < 4; ++n4) {
        const int p = 16 * n4 + i16; const float qr = tab[2 * p], qi = tab[2 * p + 1];
        const float* br = F.a->in[18] + ((size_t)g * NP + p) * GS + 8 * (kq & 1); const float* bi = F.a->in[19] + ((size_t)g * NP + p) * GS + 8 * (kq & 1);
        const f32x4 r0 = *(const f32x4*)br, r1 = *(const f32x4*)(br + 4), i0 = *(const f32x4*)bi, i1 = *(const f32x4*)(bi + 4);
        k.bb[n4] = pack8s(qr * r0 - qi * i0, qr * r1 - qi * i1);
        k.bb[4 + n4] = pack8s(qr * i0 + qi * r0, qr * i1 + qi * r1);
    }
#pragma unroll
    for (int s = 0; s < 4; ++s) {
        const float* cp = (s < 2 ? F.a->in[20] : F.a->in[21]) + ((size_t)g * GS + i16) * NP + 32 * (s & 1) + 8 * kq;
        f32x4 c0 = *(const f32x4*)cp, c1 = *(const f32x4*)(cp + 4);
        if (s >= 2) { c0 = -c0; c1 = -c1; }
        k.cm[s] = pack8s(c0, c1);
    }
    k.dsk = *(const f32x4*)(F.a->in[22] + g * GS + 4 * kq);
    WSYNC();
}
__device__ __forceinline__ void s5_ld(const float* US, int row0, int g, int lane, f32x4& u0, f32x4& u1) {
    const float* up = US + (size_t)(row0 + (lane & 15)) * WSSM + g * GS + 8 * ((lane >> 4) & 1);
    u0 = *(const f32x4*)up; u1 = *(const f32x4*)(up + 4);
}
__device__ __forceinline__ void s5_bu(const f32x4 u0, const f32x4 u1, int lane, const S5K& k, LAS float* HB) {
    const int t = lane & 15, kq = lane >> 4;
    u32x4 hi = pack8(u0, u1);
    f32x4 h0, h1; unpack8(hi, h0, h1);
    const u32x4 lo = pack8(u0 - h0, u1 - h1);
    const bf16x8 uop = __builtin_bit_cast(bf16x8, (kq >= 2) ? lo : hi);
#pragma unroll
    for (int n = 0; n < 8; ++n) {
        const f32x4 d = __builtin_amdgcn_mfma_f32_16x16x32_bf16(k.bb[n], uop, (f32x4){0.f, 0.f, 0.f, 0.f}, 0, 0, 0);
        *(LAS f32x4*)(HB + t * 132 + 16 * n + 4 * kq) = d;
    }
    WSYNC();
}
__device__ __forceinline__ void s5_out(const f32x4 uu, bf16_t* SG, int row0, int g, int lane, const S5K& k, const LAS float* HB) {
    const int t = lane & 15, kq = lane >> 4;
    f32x4 acc = (f32x4){0.f, 0.f, 0.f, 0.f};
#pragma unroll
    for (int s = 0; s < 4; ++s) {
        const LAS float* hp = HB + t * 132 + 32 * s + 8 * kq;
        const f32x4 h0 = *(const LAS f32x4*)hp, h1 = *(const LAS f32x4*)(hp + 4);
        acc = __builtin_amdgcn_mfma_f32_16x16x32_bf16(k.cm[s], pack8s(h0, h1), acc, 0, 0, 0);
    }
    const f32x4 y = acc + k.dsk * uu;
    u32x2 w; w.x = cvt_pk_bf16(gelu_tanh(y[0]), gelu_tanh(y[1])); w.y = cvt_pk_bf16(gelu_tanh(y[2]), gelu_tanh(y[3]));
    *(u32x2*)(SG + (size_t)(row0 + t) * WSSM + g * GS + 4 * kq) = w;
    WSYNC();
}

__device__ __forceinline__ void s5_phase(const Frame& F) {
    const float* US = (const float*)(F.ws + WS_US); bf16_t* SG = (bf16_t*)(F.ws + WS_SG);
    LAS f32x2* EB = (LAS f32x2*)F.lds;
    LAS float* HB = (LAS float*)(F.lds + 66048 + F.wave * 8448);
    const int lane = F.lane;
    S5K k;
    for (int item = blockIdx.x; item < NBP * NG; item += F.G) {
        const int b = item >> 6, g = item & 63, rb = b * LP;
        s5_consts(F, g, HB, k);
        f32x4 nu0, nu1; s5_ld(US, rb + 16 * F.wave, g, lane, nu0, nu1);
        for (int c = F.wave; c < NCH; c += 8) {
            const f32x4 u0 = nu0, u1 = nu1; if (c + 8 < NCH) s5_ld(US, rb + 16 * (c + 8), g, lane, nu0, nu1);
            s5_bu(u0, u1, lane, k, HB);
            float br[16], bi[16];
#pragma unroll
            for (int t = 0; t < 16; ++t) { br[t] = HB[t * 132 + lane]; bi[t] = HB[t * 132 + 64 + lane]; }
            float hr = 0.f, hi = 0.f;
#pragma unroll
            for (int t = 0; t < 16; ++t) { const float nr = k.lbr * hr - k.lbi * hi + br[t], ni = k.lbr * hi + k.lbi * hr + bi[t]; hr = nr; hi = ni; }
            EB[c * 64 + lane] = (f32x2){hr, hi};
            WSYNC();
        }
        __syncthreads();
        if (F.wave == 0) {
            float pr = k.lbr, pi = k.lbi;
#pragma unroll
            for (int q = 0; q < 4; ++q) { const float nr = pr * pr - pi * pi, ni = 2.0f * pr * pi; pr = nr; pi = ni; }
            float hr = 0.f, hi = 0.f;
            for (int c0 = 0; c0 < NCH; c0 += 8) {
                f32x2 e[8];
#pragma unroll
                for (int j = 0; j < 8; ++j) e[j] = (c0 + j < NCH) ? EB[(c0 + j) * 64 + lane] : (f32x2){0.f, 0.f};
#pragma unroll
                for (int j = 0; j < 8; ++j) { const float nr = pr * hr - pi * hi + e[j][0], ni = pr * hi + pi * hr + e[j][1]; hr = nr; hi = ni; e[j] = (f32x2){hr, hi}; }
#pragma unroll
                for (int j = 0; j < 8; ++j) if (c0 + j < NCH) EB[(c0 + j) * 64 + lane] = e[j];
            }
            const f32x2 fin = EB[(NCH - 1) * 64 + lane];
            F.out[O_RP + (size_t)(b * NG + g) * NP + lane] = fin[0]; F.out[O_IP + (size_t)(b * NG + g) * NP + lane] = fin[1];
        }
        __syncthreads();
        s5_ld(US, rb + 16 * F.wave, g, lane, nu0, nu1);
        for (int c = F.wave; c < NCH; c += 8) {
            const f32x4 u0 = nu0, u1 = nu1; if (c + 8 < NCH) s5_ld(US, rb + 16 * (c + 8), g, lane, nu0, nu1);
            const f32x4 uu = *(const f32x4*)(US + (size_t)(rb + 16 * c + (lane & 15)) * WSSM + g * GS + 4 * (lane >> 4));
            s5_bu(u0, u1, lane, k, HB);
            float br[16], bi[16];
#pragma unroll
            for (int t = 0; t < 16; ++t) { br[t] = HB[t * 132 + lane]; bi[t] = HB[t * 132 + 64 + lane]; }
            f32x2 h0 = (f32x2){0.f, 0.f}; if (c > 0) h0 = EB[(c - 1) * 64 + lane];
            float hr = h0[0], hi = h0[1];
#pragma unroll
            for (int t = 0; t < 16; ++t) { const float nr = k.lbr * hr - k.lbi * hi + br[t], ni = k.lbr * hi + k.lbi * hr + bi[t]; hr = nr; hi = ni; br[t] = hr; bi[t] = hi; }
#pragma unroll
            for (int t = 0; t < 16; ++t) { HB[t * 132 + lane] = br[t]; HB[t * 132 + 64 + lane] = bi[t]; }
            WSYNC();
            s5_out(uu, SG, rb + 16 * c, g, lane, k, HB);
        }
        __syncthreads();
    }
    for (int it = F.gw; it < NG * (MSA / 16); it += F.NGW) {
        const int g = it >> 5, j = it & 31, row0 = MPR + 16 * j;
        f32x4 u0, u1; s5_ld(US, row0, g, lane, u0, u1);
        const f32x4 uu = *(const f32x4*)(US + (size_t)(row0 + (lane & 15)) * WSSM + g * GS + 4 * (lane >> 4));
        s5_consts(F, g, HB, k);
        s5_bu(u0, u1, lane, k, HB);
        float br[16], bi[16];
#pragma unroll
        for (int t = 0; t < 16; ++t) { br[t] = HB[t * 132 + lane]; bi[t] = HB[t * 132 + 64 + lane]; }
#pragma unroll
        for (int sq = 0; sq < 4; ++sq) {
            const size_t so = ((size_t)(4 * j + sq) * NG + g) * NP + lane;
            float hr = F.a->in[3][so], hi = F.a->in[4][so];
#pragma unroll
            for (int t = 4 * sq; t < 4 * sq + 4; ++t) { const float nr = k.lbr * hr - k.lbi * hi + br[t], ni = k.lbr * hi + k.lbi * hr + bi[t]; hr = nr; hi = ni; br[t] = hr; bi[t] = hi; }
            F.out[O_RS + so] = hr; F.out[O_IS + so] = hi;
        }
#pragma unroll
        for (int t = 0; t < 16; ++t) { HB[t * 132 + lane] = br[t]; HB[t * 132 + 64 + lane] = bi[t]; }
        WSYNC();
        s5_out(uu, SG, row0, g, lane, k, HB);
    }
}

__device__ __forceinline__ void store_d(bf16_t* p, f32x4 d) { u32x2 w; w.x = cvt_pk_bf16(d[0], d[1]); w.y = cvt_pk_bf16(d[2], d[3]); *(u32x2*)p = w; }
template <int W, int T> __device__ __forceinline__ void pool_rows(const f32x4* cur, const f32x4* old, int skip, int avail0, bf16_t* dd) {
    f32x4 u[T], o[W - 1];
#pragma unroll
    for (int k = 0; k < W - 1; ++k) o[k] = (k >= skip) ? old[(size_t)k * 256] : (f32x4){0.f, 0.f, 0.f, 0.f};
#pragma unroll
    for (int t = 0; t < T; ++t) u[t] = cur[(size_t)t * 256];
    f32x4 s = (f32x4){0.f, 0.f, 0.f, 0.f};
#pragma unroll
    for (int k = 0; k < W - 1; ++k) s += o[k];
#pragma unroll
    for (int t = 0; t < T; ++t) {
        s += u[t];
        const int av = avail0 + t + 1; const float inv = 1.0f / (float)(av < W ? av : W);
        store_d(dd + (size_t)t * WPOOL, s * inv - u[t]);
        if (t - (W - 1) >= 0) s -= u[t - (W - 1) >= 0 ? t - (W - 1) : 0]; else s -= o[t < W - 1 ? t : 0];
    }
}
__device__ __forceinline__ void pool_phase(const Frame& F) {
    const f32x4* UP4 = (const f32x4*)(F.ws + WS_UP); bf16_t* DD = (bf16_t*)(F.ws + WS_DD);
    const int half = F.tid >> 8, q = F.tid & 255, grp = __builtin_amdgcn_readfirstlane(q >> 6);
    constexpr int NPI = NBP * NCH  , NSI = NBS;
    for (int it = blockIdx.x * 2 + half; it < NPI + NSI; it += F.G * 2) {
        if (it < NPI) {
            const int b = it / NCH, ch = it - b * NCH, t0 = 16 * ch, rb = b * LP;
            const f32x4* cur = UP4 + (size_t)(rb + t0) * 256 + q; bf16_t* dd = DD + (size_t)(rb + t0) * WPOOL + 4 * q;
            if (grp == 0)      pool_rows<2, 16>(cur, cur - (size_t)1 * 256, 1 - t0 > 0 ? 1 - t0 : 0, t0, dd);
            else if (grp == 1) pool_rows<4, 16>(cur, cur - (size_t)3 * 256, 3 - t0 > 0 ? 3 - t0 : 0, t0, dd);
            else if (grp == 2) pool_rows<8, 16>(cur, cur - (size_t)7 * 256, 7 - t0 > 0 ? 7 - t0 : 0, t0, dd);
            else               pool_rows<16, 16>(cur, cur - (size_t)15 * 256, 15 - t0 > 0 ? 15 - t0 : 0, t0, dd);
        } else {
            const int bs = it - NPI, rs = MPR + 4 * bs; const f32x4* hist = (const f32x4*)F.a->in[2] + (size_t)bs * 15 * 256 + q;
            const f32x4* cur = UP4 + (size_t)rs * 256 + q; bf16_t* dd = DD + (size_t)rs * WPOOL + 4 * q;
            if (grp == 0)      pool_rows<2, 4>(cur, hist + (size_t)14 * 256, 0, 1 << 20, dd);
            else if (grp == 1) pool_rows<4, 4>(cur, hist + (size_t)12 * 256, 0, 1 << 20, dd);
            else if (grp == 2) pool_rows<8, 4>(cur, hist + (size_t)8 * 256, 0, 1 << 20, dd);
            else               pool_rows<16, 4>(cur, hist, 0, 1 << 20, dd);
        }
    }
    const int gt = blockIdx.x * 512 + F.tid, NT = F.G * 512;
    f32x4* pp = (f32x4*)(F.out + O_PP); f32x4* ps = (f32x4*)(F.out + O_PS);
    for (int i = gt; i < NBP * 15 * 256; i += NT) { const int c = i & 255, j = (i >> 8) % 15, b = i / (15 * 256); pp[i] = UP4[(size_t)(b * LP + LP - 15 + j) * 256 + c]; }
    for (int i = gt; i < NBS * 15 * 256; i += NT) { const int c = i & 255, j = (i >> 8) % 15, b = i / (15 * 256);
        ps[i] = (j < 11) ? ((const f32x4*)F.a->in[2])[((size_t)b * 15 + j + 4) * 256 + c] : UP4[(size_t)(MPR + 4 * b + j - 11) * 256 + c]; }
}


#define XB_TMO      128
#define XB_XCNT(j)  (256  + 64 * (j))
#define XB_XSUB(j)  (1280 + 64 * (j))
#define XB_XGEN(j)  (2304 + 64 * (j))
#define XB_TOP      3328
#define XB_TOPGEN   3392
#define XCD_BAR_WORDS 3456
#define XB_SPIN_CAP (1u << 20)
__device__ __forceinline__ unsigned xb_ld(unsigned* p)              { return __hip_atomic_load(p, __ATOMIC_RELAXED, __HIP_MEMORY_SCOPE_AGENT); }
__device__ __forceinline__ unsigned xb_add(unsigned* p, unsigned v) { return __hip_atomic_fetch_add(p, v, __ATOMIC_RELAXED, __HIP_MEMORY_SCOPE_AGENT); }
__device__ __forceinline__ unsigned xb_xcc_id() { return (unsigned)__builtin_amdgcn_s_getreg((3 << 11) | 20) & 0xFu; }
#define XB_SPIN(cond, bar) do { unsigned _sp = 0; while (cond) { __builtin_amdgcn_s_sleep(1); \
    if ((++_sp & 255u) == 0u) { if (xb_ld(&(bar)[XB_TMO])) break; if (_sp > XB_SPIN_CAP) { atomicAdd(&(bar)[XB_TMO], 1u); break; } } } } while (0)
__device__ __forceinline__ void xcd_barrier_complete(unsigned* bar, unsigned x, unsigned& nloc, unsigned& nx) {
    const unsigned G = gridDim.x;
    unsigned sum, cnt, mine, sp = 0u;
    for (;;) {
        sum = 0u; cnt = 0u; mine = 0u;
#pragma unroll
        for (unsigned j = 0; j < 16; ++j) { const unsigned c = xb_ld(&bar[XB_XCNT(j)]); sum += c; cnt += (c > 0u) ? 1u : 0u; mine = (j == x) ? c : mine; }
        if (sum == G) break;
        __builtin_amdgcn_s_sleep(1);
        if ((++sp & 255u) == 0u) { if (xb_ld(&bar[XB_TMO])) break; if (sp > XB_SPIN_CAP) { atomicAdd(&bar[XB_TMO], 1u); break; } }
    }
    nloc = mine > 0u ? mine : 1u; nx = cnt > 0u ? cnt : 1u;
}
__device__ __forceinline__ void xcd_barrier(unsigned* bar, volatile LAS unsigned* st) {
    asm volatile("s_waitcnt vmcnt(0)" ::: "memory");
    __syncthreads();
    if (threadIdx.x == 0) {
        __builtin_amdgcn_s_waitcnt(0);
        const unsigned x = xb_xcc_id();
        unsigned nloc = st[0], nx = st[1];
        if (nloc == 0u) { xcd_barrier_complete(bar, x, nloc, nx); st[0] = nloc; st[1] = nx; }
        const unsigned old = xb_add(&bar[XB_XSUB(x)], 1u);
        const unsigned gen = old / nloc;
        if (old + 1u == (gen + 1u) * nloc) {
            __builtin_amdgcn_fence(__ATOMIC_RELEASE, "agent");
            asm volatile("s_waitcnt vmcnt(0)" ::: "memory");
            const unsigned og = xb_add(&bar[XB_TOP], 1u);
            const unsigned tg = og / nx;
            if (og + 1u == (tg + 1u) * nx) xb_add(&bar[XB_TOPGEN], 1u);
            else XB_SPIN(xb_ld(&bar[XB_TOPGEN]) == tg, bar);
            __builtin_amdgcn_fence(__ATOMIC_ACQUIRE, "agent");
            xb_add(&bar[XB_XGEN(x)], 1u);
            asm volatile("s_waitcnt vmcnt(0)" ::: "memory");
        } else {
            __builtin_amdgcn_fence(__ATOMIC_ACQUIRE, "agent");
            XB_SPIN(xb_ld(&bar[XB_XGEN(x)]) == gen, bar);
            asm volatile("s_waitcnt vmcnt(0)" ::: "memory");
        }
    }
    __syncthreads();
}
constexpr int LDS_BARST = LDS_BYTES - 64;

constexpr int N_PHASES = 14;
#ifndef DBG_STOP
#define DBG_STOP 99
#endif
#ifndef DBG_SRC
#define DBG_SRC WS_UP
#endif

__device__ __forceinline__ Frame make_frame(LAS unsigned char* lds) {
    Frame F;
    ArgsP a = (ArgsP)__builtin_amdgcn_kernarg_segment_ptr(); asm volatile("" : "+s"(a));
    int t = threadIdx.x; asm volatile("" : "+v"(t));
    F.a = a; F.ws = a->ws; F.out = a->out; F.lds = lds;
    F.tid = t; F.lane = t & 63; F.wave = __builtin_amdgcn_readfirstlane(t >> 6); F.G = gridDim.x;
    F.gw = blockIdx.x * 8 + F.wave; F.NGW = F.G * 8;
    return F;
}
#define XN_(F) ((bf16_t*)((F).ws + WS_XN))
#define X_(F) ((float*)((F).ws + WS_X))
#define H_(F) ((bf16_t*)((F).ws + WS_H))
#define VCU_(F) (((F).G & 7) == 0 ? (int)((blockIdx.x & 7) * ((F).G >> 3) + (blockIdx.x >> 3)) : (int)blockIdx.x)
#define PB_(F) ((float*)((F).ws + WS_PB))
#define X0_(F) (X0Src{(F).a->in[5], (F).a->in[0], (F).a->in[1]})

__global__ void __launch_bounds__(512, 2) mk_fwd(Args args) {
    extern __shared__ __attribute__((aligned(16))) unsigned char lds_raw[];
    LAS unsigned char* const lds = (LAS unsigned char*)lds_raw;
    const int lo = args.ph_lo, hi = args.ph_hi;
    if (threadIdx.x < 2) ((volatile LAS unsigned*)(lds + LDS_BARST))[threadIdx.x] = 0u;
    if (threadIdx.x == 0) (void)xb_add((unsigned*)(args.ws + WS_CTL) + XB_XCNT(xb_xcc_id()), 1u);
    __syncthreads();
#define IN(k) (lo <= (k) && (k) < hi && ((k) < DBG_STOP || (k) == 13))
#define SEAM(k) do { if (lo <= (k) && (k) + 1 < hi) { if (hi > 1000) cg::this_grid().sync();   ArgsP a_ = (ArgsP)__builtin_amdgcn_kernarg_segment_ptr(); asm volatile("" : "+s"(a_)); xcd_barrier((unsigned*)(a_->ws + WS_CTL), (volatile LAS unsigned*)(lds + LDS_BARST)); } } while (0)

    if (IN(0)) { const Frame F = make_frame(lds);
        cvt_ffn(F, 7, F.gw, F.NGW);
        const X0Src x0 = X0_(F); bf16_t* XN = XN_(F);
        for (int r = F.gw; r < MP; r += F.NGW) { const float* xr = x0_row(x0, r); if (xr) rms_row(xr, F.a->in[6], XN + (size_t)r * D, nullptr, F.lane); else zero_row_bf16(XN + (size_t)r * D, F.lane); }
    }
    SEAM(0);
    if (IN(1)) { const Frame F = make_frame(lds);
        pg8::Gemm g{XN_(F), (const bf16_t*)(F.ws + WS_WGU), D, D, MP, 2 * FF, D, 0}; pg8::PadOrder S; S.init(2 * FF, D, F.G, blockIdx.x);
        pg8::EpiSwiGLU E{H_(F)}; pg8::gemm_phase(lds, g, S, E); }
    SEAM(1);
    if (IN(2)) { const Frame F = make_frame(lds);
        pg8::Gemm g{H_(F), (const bf16_t*)(F.ws + WS_WD), FF, FF, MP, D, FF, 0}; pg8::TailSplitOrder S; S.init(D, FF, F.G, blockIdx.x, 1);
        pg8::EpiDownFinal<1, true> E{X0_(F), X_(F), 0.5f, F.a->in[10], nullptr, XN_(F), (unsigned*)(F.ws + WS_CTL + CTL_XBUF), (unsigned*)(F.ws + WS_CTL + CTL_CNT)}; pg8::gemm_phase(lds, g, S, E);
        if ((int)blockIdx.x < 24 * pg8::TS_NSPLIT) { const Frame F3 = make_frame(lds);
            pg8::Gemm g3{H_(F3), (const bf16_t*)(F3.ws + WS_WD), FF, FF, MP, D, FF, 0}; pg8::TailSplitOrder S3; S3.init(D, FF, F3.G, blockIdx.x, 2);
            pg8::EpiAdd<true> E3{X0_(F3), X_(F3), PB_(F3), 0.5f}; pg8::gemm_phase(lds, g3, S3, E3); }
        if (lo == 0) { const Frame F2 = make_frame(lds); const int nb = 24 * pg8::TS_NSPLIT;
            if ((int)blockIdx.x >= nb) cvt_mixer(F2, ((int)blockIdx.x - nb) * 8 + F2.wave, (F2.G - nb) * 8, 0, 3904); } }
    SEAM(2);
    if (IN(3)) { const Frame F = make_frame(lds); bf16_t* XN = XN_(F); float* X = X_(F); const float* PB = PB_(F);
        for (int r = pg8::TS_ROWS0 + F.gw; r < MP; r += F.NGW) { if (r < MV) {
                rms_row(X + (size_t)r * D, F.a->in[10], XN + (size_t)r * D, nullptr, F.lane, r >= pg8::TS_ROWS0 ? X + (size_t)r * D : nullptr, r >= pg8::TS_ROWS0 ? PB + (size_t)(r - pg8::TS_ROWS0) * D : nullptr, (size_t)(MP - pg8::TS_ROWS0) * D); }
            else zero_row_bf16(XN + (size_t)r * D, F.lane); } }
    SEAM(3);
    if (IN(4)) { const Frame F = make_frame(lds);
        pg8::Gemm g{XN_(F), (const bf16_t*)(F.ws + WS_WIN), D, D, MP, WIN, D, 0}; pg8::StaticOrder S; S.init(MP, WIN, F.G, blockIdx.x, D);
        pg8::EpiWin E{(float*)(F.ws + WS_UP), (float*)(F.ws + WS_US), (bf16_t*)(F.ws + WS_G), F.a->in[12]}; pg8::gemm_phase(lds, g, S, E);
        { const Frame F2 = make_frame(lds); const int nb = (MP / 256) * (WIN / 256) - 3 * F2.G;
          if ((int)blockIdx.x >= nb) { cvt_ffn(F2, 29, ((int)blockIdx.x - nb) * 8 + F2.wave, (F2.G - nb) * 8, 0, 4); cvt_ffn(F2, 29, ((int)blockIdx.x - nb) * 8 + F2.wave, (F2.G - nb) * 8, 1, 4); } } }
    SEAM(4);
    if (IN(5)) { __syncthreads();
        { const Frame F = make_frame(lds); s5_phase(F); }
        { const Frame F = make_frame(lds); pool_phase(F); }
        __syncthreads(); }
    SEAM(5);
    if (IN(6)) {
        { const Frame F = make_frame(lds);
          pg8::Gemm g{(const bf16_t*)(F.ws + WS_DD), (const bf16_t*)(F.ws + WS_PW), WPOOL, 256, MP, WPOOL, 256, 512}; pg8::StaticOrder S; S.init(MP, WPOOL, F.G, blockIdx.x, 256);
          pg8::EpiPool E{XN_(F), F.a->in[14]}; pg8::gemm_phase(lds, g, S, E); }
        { const Frame F = make_frame(lds);
          pg8::Gemm g{(const bf16_t*)(F.ws + WS_SG), (const bf16_t*)(F.ws + WS_GLU), WSSM, WSSM, MP, WSSM, WSSM, 0}; pg8::StaticOrder S; S.init(MP, WSSM, F.G, (blockIdx.x + F.G / 2) % F.G, WSSM);
          pg8::EpiGLU E{XN_(F), (const bf16_t*)(F.ws + WS_SG), F.a->in[24]}; pg8::gemm_phase(lds, g, S, E); }
    }
    SEAM(6);
    if (IN(7)) { const Frame F = make_frame(lds);
        pg8::Gemm g{XN_(F), (const bf16_t*)(F.ws + WS_WA), 2048, 1024, MP, D, 1024, 0}; pg8::StaticOrder S; S.init(MP, D, F.G, blockIdx.x, 1024);
        pg8::EpiBr1 E{(bf16_t*)(F.ws + WS_T1), (const bf16_t*)(F.ws + WS_G)}; pg8::gemm_phase(lds, g, S, E);
        { const Frame F2 = make_frame(lds); if ((int)blockIdx.x >= 24) { cvt_mixer(F2, ((int)blockIdx.x - 24) * 8 + F2.wave, (F2.G - 24) * 8, 3904, 4416);
              cvt_ffn(F2, 29, ((int)blockIdx.x - 24) * 8 + F2.wave, (F2.G - 24) * 8, 2, 4); } } }
    SEAM(7);
    if (IN(8)) { const Frame F = make_frame(lds);
        pg8::Gemm g{XN_(F) + 1024, (const bf16_t*)(F.ws + WS_WB), 2048, 1024, MP, D, 1024, 0}; pg8::StaticOrder S; S.init(MP, D, F.G, blockIdx.x, 1024);
        pg8::EpiBr2 E{(const bf16_t*)(F.ws + WS_T1), (const bf16_t*)(F.ws + WS_G), (bf16_t*)(F.ws + WS_MRG)}; pg8::gemm_phase(lds, g, S, E);
        { const Frame F2 = make_frame(lds); if ((int)blockIdx.x >= 24) { cvt_mixer(F2, ((int)blockIdx.x - 24) * 8 + F2.wave, (F2.G - 24) * 8, 4416, 5440);
              cvt_ffn(F2, 29, ((int)blockIdx.x - 24) * 8 + F2.wave, (F2.G - 24) * 8, 3, 4); } } }
    SEAM(8);
    if (IN(9)) { const Frame F = make_frame(lds);
        pg8::Gemm g{(const bf16_t*)(F.ws + WS_MRG), (const bf16_t*)(F.ws + WS_WOUT), D, D, MP, D, D, 0}; pg8::TailSplitOrder S; S.init(D, D, F.G, blockIdx.x, 1);
        pg8::EpiDownFinal<1, false> E{X0_(F), X_(F), 1.0f, F.a->in[28], nullptr, XN_(F), (unsigned*)(F.ws + WS_CTL + CTL_XBUF + 262144), (unsigned*)(F.ws + WS_CTL + CTL_CNT) + 2048}; pg8::gemm_phase(lds, g, S, E);
        if ((int)blockIdx.x < 24 * pg8::TS_NSPLIT) { const Frame F3 = make_frame(lds);
            pg8::Gemm g3{(const bf16_t*)(F3.ws + WS_MRG), (const bf16_t*)(F3.ws + WS_WOUT), D, D, MP, D, D, 0}; pg8::TailSplitOrder S3; S3.init(D, D, F3.G, blockIdx.x, 2);
            pg8::EpiAdd<false> E3{X0_(F3), X_(F3), (float*)(F3.ws + WS_DD), 1.0f}; pg8::gemm_phase(lds, g3, S3, E3); } }
    SEAM(9);
    if (IN(10)) { const Frame F = make_frame(lds); bf16_t* XN = XN_(F); float* X = X_(F); const float* PB = (const float*)(F.ws + WS_DD);
        for (int r = pg8::TS_ROWS0 + F.gw; r < MP; r += F.NGW) { if (r < MV) {
                rms_row(X + (size_t)r * D, F.a->in[28], XN + (size_t)r * D, nullptr, F.lane, r >= pg8::TS_ROWS0 ? X + (size_t)r * D : nullptr, r >= pg8::TS_ROWS0 ? PB + (size_t)(r - pg8::TS_ROWS0) * D : nullptr, (size_t)(MP - pg8::TS_ROWS0) * D); }
            else zero_row_bf16(XN + (size_t)r * D, F.lane); } }
    SEAM(10);
    if (IN(11)) { const Frame F = make_frame(lds);
        pg8::Gemm g{XN_(F), (const bf16_t*)(F.ws + WS_WGU), D, D, MP, 2 * FF, D, 0}; pg8::PadOrder S; S.init(2 * FF, D, F.G, blockIdx.x);
        pg8::EpiSwiGLU E{H_(F)}; pg8::gemm_phase(lds, g, S, E); }
    SEAM(11);
    if (IN(12)) { { const Frame F = make_frame(lds);
        pg8::Gemm g{H_(F), (const bf16_t*)(F.ws + WS_WD), FF, FF, MP, D, FF, 0}; pg8::TailSplitOrder S; S.init(D, FF, F.G, blockIdx.x, 1);
        pg8::EpiDownFinal<0, false> E{X0_(F), X_(F), 0.5f, F.a->in[32], F.out, nullptr, (unsigned*)(F.ws + WS_CTL + CTL_XBUF + 2 * 262144), (unsigned*)(F.ws + WS_CTL + CTL_CNT) + 2 * 2048}; pg8::gemm_phase(lds, g, S, E); }
      if ((int)blockIdx.x < 24 * pg8::TS_NSPLIT) { const Frame F = make_frame(lds);
        pg8::Gemm g{H_(F), (const bf16_t*)(F.ws + WS_WD), FF, FF, MP, D, FF, 0}; pg8::TailSplitOrder S; S.init(D, FF, F.G, blockIdx.x, 2);
        pg8::EpiAdd<false> E{X0_(F), X_(F), PB_(F), 0.5f}; pg8::gemm_phase(lds, g, S, E); } }
    SEAM(12);
    if (IN(13) && DBG_STOP < 99) { const Frame F = make_frame(lds);
        const f32x4* src = (const f32x4*)(F.ws + DBG_SRC); f32x4* dst = (f32x4*)F.out;
        for (size_t i = (size_t)blockIdx.x * 512 + F.tid; i < O_PP / 4; i += (size_t)F.G * 512) dst[i] = src[i];
    } else
    if (IN(13)) { const Frame F = make_frame(lds); const float* X = X_(F);
        for (int r = pg8::TS_ROWS0 + F.gw; r < MV; r += F.NGW) {
            float* o;
            if (r < MPR) { const int b = r / LP, t = r - b * LP; if (t < NMETA) continue; o = F.out + O_YP + ((size_t)b * SEQ + (t - NMETA)) * D; }
            else o = F.out + O_YS + (size_t)(r - MPR) * D;
            rms_row(X + (size_t)r * D, F.a->in[32], nullptr, o, F.lane, nullptr, r >= pg8::TS_ROWS0 ? PB_(F) + (size_t)(r - pg8::TS_ROWS0) * D : nullptr, (size_t)(MP - pg8::TS_ROWS0) * D);
        }
    }
#undef IN
#undef SEAM
}

extern "C" void kernel_launch(void* const* d_in, const int* in_sizes, int n_in, void* d_out, int out_size, void* d_ws, size_t ws_size, hipStream_t stream) {
    static int grid = 0;
    if (grid == 0) {
        if (n_in != 33 || ws_size < WS_END) { fprintf(stderr, "kernel_launch: expected 33 inputs and >= %zu bytes of workspace; got %d, %zu\n", (size_t)WS_END, n_in, ws_size); grid = -1; return; }
        int dev = 0, cus = 0, per_cu = 0;
        if (hipGetDevice(&dev) != hipSuccess || hipDeviceGetAttribute(&cus, hipDeviceAttributeMultiprocessorCount, dev) != hipSuccess) { grid = -1; return; }
        if (hipFuncSetAttribute((const void*)mk_fwd, hipFuncAttributeMaxDynamicSharedMemorySize, LDS_BYTES) != hipSuccess) { fprintf(stderr, "kernel_launch: hipFuncSetAttribute failed\n"); grid = -1; return; }
        if (hipOccupancyMaxActiveBlocksPerMultiprocessor(&per_cu, (const void*)mk_fwd, 512, LDS_BYTES) != hipSuccess || per_cu < 1) { fprintf(stderr, "kernel_launch: occupancy query says %d\n", per_cu); per_cu = 1; }
        (void)hipGetLastError();
        grid = cus * per_cu;
        if (grid > 256) grid = 256;
        if (grid != 256) fprintf(stderr, "kernel_launch: this kernel needs a 256-workgroup cooperative grid; got capacity %d\n", grid);
    }
    if (grid < 0) return;
    Args a{};
    for (int i = 0; i < 33; ++i) a.in[i] = (const float*)d_in[i];
    a.out = (float*)d_out; a.ws = (unsigned char*)d_ws;
#if MK_N_LAUNCHES == 1
    if (hipMemsetAsync((char*)d_ws + WS_CTL, 0, CTL_XBUF  , stream) != hipSuccess) { fprintf(stderr, "kernel_launch: hipMemsetAsync failed\n"); return; }
    a.ph_lo = 0; a.ph_hi = N_PHASES;
    void* kargs[] = {&a};
    hipError_t e = hipLaunchCooperativeKernel((const void*)mk_fwd, dim3(grid), dim3(512), kargs, LDS_BYTES, stream);
    if (e != hipSuccess) fprintf(stderr, "kernel_launch: cooperative launch failed: %s (grid %d)\n", hipGetErrorString(e), grid);
#else
    for (int p = 0; p < N_PHASES; ++p) { a.ph_lo = p; a.ph_hi = p + 1; hipLaunchKernelGGL(mk_fwd, dim3(grid), dim3(512), LDS_BYTES, stream, a); }
#endif
}
```

```cpp
#include <hip/hip_runtime.h>
#include <hip/hip_cooperative_groups.h>
#include <cstdio>
#include <cstdint>
namespace cg = cooperative_groups;

#ifndef MK_N_LAUNCHES
#define MK_N_LAUNCHES 1
#endif

#define LAS __attribute__((address_space(3)))
typedef unsigned short bf16_t;
typedef short bf16x8 __attribute__((ext_vector_type(8)));
typedef float f32x4 __attribute__((ext_vector_type(4)));
typedef float f32x2 __attribute__((ext_vector_type(2)));
typedef unsigned u32x4 __attribute__((ext_vector_type(4)));
typedef unsigned u32x2 __attribute__((ext_vector_type(2)));

constexpr int D = 2048, FF = 5632, NBP = 4, SEQ = 2048, NMETA = 16, LP = SEQ + NMETA  , NBS = 128, LS = 4;
constexpr int MPR = NBP * LP  , MSA = NBS * LS  , MV = MPR + MSA  , MP = 8960  ;
constexpr int WPOOL = 1024, WSSM = 1024, NG = 64, NP = 64, GS = 16, WIN = 6144, NCH = LP / 16  ;
constexpr float RMS_EPS = 1e-6f;
constexpr float LOG2E = 1.4426950408889634f;

constexpr size_t O_YP = 0, O_YS = 16777216, O_PP = 17825792, O_PS = 17887232, O_RP = 19853312, O_IP = 19869696, O_RS = 19886080, O_IS = 20410368;

constexpr size_t MiB = 1u << 20;
constexpr size_t WS_WGU = 0;
constexpr size_t WS_WD = 44 * MiB;
constexpr size_t WS_WIN = 66 * MiB;
constexpr size_t WS_PW = 90 * MiB;
constexpr size_t WS_GLU = 91 * MiB;
constexpr size_t WS_WA = 93 * MiB;
constexpr size_t WS_WB = 97 * MiB;
constexpr size_t WS_WOUT = 101 * MiB;
constexpr size_t WS_XN = 110 * MiB;
constexpr size_t WS_X = 145 * MiB;
constexpr size_t WS_R = 215 * MiB;
constexpr size_t WS_H = WS_R;
constexpr size_t WS_UP = WS_R;
constexpr size_t WS_US = WS_R + 35 * MiB;
constexpr size_t WS_T1 = WS_R;
constexpr size_t WS_PB = WS_R + 100 * MiB;
constexpr size_t WS_G = WS_R + 70 * MiB;
constexpr size_t WS_DD = WS_R + 140 * MiB;
constexpr size_t WS_SG = WS_DD + 18 * MiB;
constexpr size_t WS_MRG = WS_SG + 18 * MiB;
constexpr size_t WS_CTL = WS_MRG + 35 * MiB;
constexpr size_t CTL_BYTES = 65536 + 3 * 262144;
constexpr size_t CTL_CNT = 16384, CTL_XBUF = 65536;
constexpr size_t WS_END = WS_CTL + CTL_BYTES;
static_assert((size_t)MP * 2048 * 2 <= 35 * MiB && (size_t)MP * 1024 * 2 <= 18 * MiB && (size_t)MP * FF * 2 <= 140 * MiB, "ws map");

constexpr int LDS_BYTES = 147456;

__device__ __forceinline__ unsigned f2bf(float f) { unsigned u = __builtin_bit_cast(unsigned, f); return (u + 0x7fffu + ((u >> 16) & 1u)) >> 16; }
__device__ __forceinline__ float bf2f(unsigned b) { return __builtin_bit_cast(float, b << 16); }
typedef __bf16 bf16x2v __attribute__((ext_vector_type(2)));
__device__ __forceinline__ unsigned cvt_pk_bf16(float lo, float hi) { const f32x2 v = {lo, hi}; const bf16x2v b = __builtin_convertvector(v, bf16x2v); return __builtin_bit_cast(unsigned, b); }
__device__ __forceinline__ u32x4 pack8(f32x4 a, f32x4 b) { u32x4 w; w.x = cvt_pk_bf16(a[0], a[1]); w.y = cvt_pk_bf16(a[2], a[3]); w.z = cvt_pk_bf16(b[0], b[1]); w.w = cvt_pk_bf16(b[2], b[3]); return w; }
__device__ __forceinline__ void unpack8(u32x4 w, f32x4& a, f32x4& b) {
    a[0] = __builtin_bit_cast(float, w.x << 16); a[1] = __builtin_bit_cast(float, w.x & 0xffff0000u); a[2] = __builtin_bit_cast(float, w.y << 16); a[3] = __builtin_bit_cast(float, w.y & 0xffff0000u);
    b[0] = __builtin_bit_cast(float, w.z << 16); b[1] = __builtin_bit_cast(float, w.z & 0xffff0000u); b[2] = __builtin_bit_cast(float, w.w << 16); b[3] = __builtin_bit_cast(float, w.w & 0xffff0000u); }
__device__ __forceinline__ float sigm(float x) { return __builtin_amdgcn_rcpf(1.0f + __builtin_amdgcn_exp2f(-LOG2E * x)); }
__device__ __forceinline__ f32x4 sigm4(f32x4 x) { f32x4 r; r[0] = sigm(x[0]); r[1] = sigm(x[1]); r[2] = sigm(x[2]); r[3] = sigm(x[3]); return r; }
__device__ __forceinline__ float gelu_tanh(float x) { const float z = 1.5957691216057308f * (x + 0.044715f * x * x * x); return x * sigm(z); }
__device__ __forceinline__ float wave_sum(float v) {
#pragma unroll
    for (int o = 1; o < 64; o <<= 1) v += __shfl_xor(v, o);
    return v;
}

struct X0Src { const float* meta; const float* xp; const float* xs; };
__device__ __forceinline__ const float* x0_row(const X0Src& s, int r) {
    if (r < MPR) { const int b = r / LP, t = r - b * LP; return t < NMETA ? s.meta + (size_t)t * D : s.xp + ((size_t)b * SEQ + (t - NMETA)) * D; }
    if (r < MV) return s.xs + (size_t)(r - MPR) * D;
    return nullptr;
}

namespace pg8 {
constexpr int BM = 256, BK = 64, HALF = 128, HTB = HALF * BK * 2, NXCD = 8, WGM = 8;
__host__ __device__ __forceinline__ int lds_byte(int r, int c) { const int st = (r >> 4) * 2 + (c >> 5), rr = r & 15, cc = c & 31, ob = rr * 64 + cc * 2; return st * 1024 + (ob ^ (((ob >> 9) & 1) << 5)); }
__host__ __device__ __forceinline__ void stage_rc(int b, int& R, int& C) { const int st = b / 1024, sb = b % 1024, swz = sb ^ (((sb >> 9) & 1) << 5); R = (st >> 1) * 16 + swz / 64; C = (st & 1) * 32 + (swz % 64) / 2; }
__host__ __device__ __forceinline__ int perm32(int rho) { const int n = rho >> 4, i = rho & 15; return 8 * (i >> 2) + 4 * n + (i & 3); }

struct Unit { int pm, pn, kt0, nkt, full; };
struct Gemm { const bf16_t* A; const bf16_t* Bt; int lda, ldb, M, N, K, a_pn_bytes; };

struct StaticOrder {
    int nM, nN, nwg, G, c, nkt;
    __device__ void init(int M, int N, int G_, int c_, int K = 0) { nM = M / BM; nN = N / BM; nwg = nM * nN; G = G_; c = c_; nkt = K / BK; }
    __device__ bool next(int i, Unit& u) const {
        const long L = (long)i * G + c; if (L >= nwg) return false;
        int wgid = (int)L; { const int q = nwg / NXCD, r = nwg % NXCD, xcd = wgid % NXCD, off = wgid / NXCD; wgid = (xcd < r ? xcd * (q + 1) : r * (q + 1) + (xcd - r) * q) + off; }
        const int nig = WGM * nN, gid = wgid / nig, fm = gid * WGM, gsz = (nM - fm) < WGM ? (nM - fm) : WGM;
        u.pm = fm + ((wgid % nig) % gsz); u.pn = (wgid % nig) / gsz; u.kt0 = 0; u.nkt = nkt; u.full = 1; return true;
    }
};
struct PadOrder {
    StaticOrder so; int c, nN, nkt;
    __device__ void init(int N, int K, int G, int c_) { so.init((MP / BM - 1) * BM, N, G, c_, K); c = c_; nN = N / BM; nkt = K / BK; }
    __device__ bool next(int i, Unit& u) const {
        if (so.next(i, u)) return true;
        const int n0 = so.nwg / so.G, rem = so.nwg - n0 * so.G;
        if (i < n0 || c < rem) return false;
        const int f = (i - n0) * (so.G - rem) + (c - rem); if (f >= nN) return false;
        u.pm = MP / BM - 1; u.pn = f; u.kt0 = 0; u.nkt = nkt; u.full = 1; return true;
    }
};
constexpr int TS_ROWS0 = 8192, TS_NSPLIT = 4;
struct TailSplitOrder {
    StaticOrder so; int c, nkt, mode;
    __device__ void init(int N, int K, int G, int c_, int mode_ = 0) { so.init(TS_ROWS0, N, G, c_, K); c = c_; nkt = K / BK; mode = mode_; }
    __device__ bool next(int i, Unit& u) const {
        if (mode == 2) ++i;
        if (i == 0) return so.next(0, u);
        if (i > 1 || mode == 1 || c >= 24 * TS_NSPLIT) return false;
        const int t = c / TS_NSPLIT, kq = c % TS_NSPLIT;
        u.pm = TS_ROWS0 / BM + (t >> 3); u.pn = t & 7; u.nkt = nkt / TS_NSPLIT; u.kt0 = kq * u.nkt; u.full = 0; return true;
    }
};

template <class Epi, class Order>
__device__ __forceinline__ void gemm_phase(LAS unsigned char* lds, const Gemm g, const Order& S, const Epi& E) {
    int tid_ = threadIdx.x; asm volatile("" : "+v"(tid_));
    const int tid = tid_, wid = __builtin_amdgcn_readfirstlane(tid >> 6), lane = tid & 63, wr = wid >> 2, wc = wid & 3, fr = lane & 15, fq = lane >> 4;
    unsigned voffA[2], voffB[2];
#pragma unroll
    for (int i = 0; i < 2; ++i) { int R, C; stage_rc(tid * 16 + i * 8192, R, C); const int Rb = (R & ~31) + perm32(R & 31);
        voffA[i] = (unsigned)(R * g.lda + C) * 2u; voffB[i] = (unsigned)(Rb * g.ldb + C) * 2u; }
    const size_t kstep = (size_t)(BK * 2);
    const size_t hstepA = (size_t)HALF * g.lda * 2, hstepB = (size_t)HALF * g.ldb * 2;
    const size_t tstepA = 2 * hstepA, tstepB = 2 * hstepB;
    const unsigned ldsw = (unsigned)wid * 1024u;
    const int aoff = lds_byte(wr * 64 + fr, fq * 8), boff = lds_byte(wc * 32 + fr, fq * 8);
#define PG8_SA(b, h) (((b) * 2 + (h)) * HTB)
#define PG8_SB(b, h) ((4 + (b) * 2 + (h)) * HTB)
#define PG8_STAGE(bufoff, gbase, voff) do { _Pragma("unroll") for (int _i = 0; _i < 2; ++_i) \
        __builtin_amdgcn_global_load_lds((const unsigned*)((const char*)(gbase) + (voff)[_i]), (LAS unsigned*)(lds + (bufoff) + ldsw + _i * 8192), 16, 0, 0); } while (0)
#define PG8_LDA(dst, b, h) do { _Pragma("unroll") for (int m = 0; m < 4; ++m) _Pragma("unroll") for (int k = 0; k < 2; ++k) dst[m][k] = *(const LAS bf16x8*)(lds + PG8_SA(b, h) + aoff + m * 2048 + k * 1024); } while (0)
#define PG8_LDB(dst, b, h) do { _Pragma("unroll") for (int n = 0; n < 2; ++n) _Pragma("unroll") for (int k = 0; k < 2; ++k) dst[n][k] = *(const LAS bf16x8*)(lds + PG8_SB(b, h) + boff + n * 2048 + k * 1024); } while (0)
#define PG8_MMA(ai, bj, At, Bt) do { __builtin_amdgcn_s_setprio(1); _Pragma("unroll") for (int m = 0; m < 4; ++m) _Pragma("unroll") for (int n = 0; n < 2; ++n) _Pragma("unroll") for (int k = 0; k < 2; ++k) \
        acc[ai][bj][m][n] = __builtin_amdgcn_mfma_f32_16x16x32_bf16(Bt[n][k], At[m][k], acc[ai][bj][m][n], 0, 0, 0); __builtin_amdgcn_s_setprio(0); } while (0)
#define PG8_WAIT_V(n) asm volatile("s_waitcnt vmcnt(" #n ")" ::: "memory")
#define PG8_WAIT_L(n) asm volatile("s_waitcnt lgkmcnt(" #n ")" ::: "memory")
#define PG8_BAR __builtin_amdgcn_s_barrier()
#define PG8_SCHED __builtin_amdgcn_sched_barrier(0)
    Unit cur, nxt; int ui = 0;
    if (!S.next(0, cur)) return;
    f32x4 acc[2][2][4][2];
#pragma unroll
    for (int a = 0; a < 2; ++a)
#pragma unroll
        for (int b = 0; b < 2; ++b)
#pragma unroll
            for (int m = 0; m < 4; ++m)
#pragma unroll
                for (int n = 0; n < 2; ++n) acc[a][b][m][n] = (f32x4){0.f, 0.f, 0.f, 0.f};
    bf16x8 At[4][2], B0[2][2], B1[2][2];
    const char* cA = (const char*)g.A + (size_t)cur.pm * tstepA + (size_t)cur.pn * g.a_pn_bytes + (size_t)cur.kt0 * kstep; const char* cB = (const char*)g.Bt + (size_t)cur.pn * tstepB + (size_t)cur.kt0 * kstep;
    PG8_STAGE(PG8_SB(0, 0), cB, voffB); PG8_STAGE(PG8_SB(0, 1), cB + hstepB, voffB); PG8_STAGE(PG8_SA(0, 0), cA, voffA); PG8_STAGE(PG8_SA(0, 1), cA + hstepA, voffA);
    if (wr == 1) PG8_BAR;
    PG8_WAIT_V(2); PG8_BAR;
    PG8_STAGE(PG8_SB(1, 0), cB + kstep, voffB); PG8_STAGE(PG8_SA(1, 0), cA + kstep, voffA); PG8_STAGE(PG8_SB(1, 1), cB + hstepB + kstep, voffB);
    PG8_WAIT_V(6); PG8_BAR;
    for (;;) {
        const bool has_next = S.next(ui + 1, nxt);
        const char* nA = has_next ? (const char*)g.A + (size_t)nxt.pm * tstepA + (size_t)nxt.pn * g.a_pn_bytes + (size_t)nxt.kt0 * kstep : cA; const char* nB = has_next ? (const char*)g.Bt + (size_t)nxt.pn * tstepB + (size_t)nxt.kt0 * kstep : cB;
        const int nt = cur.nkt;
        const int row_w = __builtin_amdgcn_readfirstlane(cur.pm) * BM + wr * 64;
        const bool do0 = row_w < MV, do1 = row_w + HALF < MV;
        if (do0 && do1) {
        for (int t = 0; t < nt; t += 2) {
            const bool last = (t == nt - 2);
            const char* a1 = cA + (size_t)(t + 1) * kstep;
            const char* a2 = last ? nA : cA + (size_t)(t + 2) * kstep; const char* b2 = last ? nB : cB + (size_t)(t + 2) * kstep;
            const char* a3 = a2 + kstep; const char* b3 = b2 + kstep;
            PG8_LDB(B0, 0, 0); PG8_LDB(B1, 0, 1); PG8_SCHED; PG8_LDA(At, 0, 0); PG8_STAGE(PG8_SA(1, 1), a1 + hstepA, voffA);
            PG8_WAIT_V(8); PG8_WAIT_L(0); PG8_BAR; { PG8_MMA(0, 0, At, B0); PG8_MMA(0, 1, At, B1); } PG8_BAR; PG8_SCHED;
            PG8_LDA(At, 0, 1); PG8_STAGE(PG8_SB(0, 0), b2, voffB); PG8_STAGE(PG8_SB(0, 1), b2 + hstepB, voffB); PG8_STAGE(PG8_SA(0, 0), a2, voffA);
            PG8_WAIT_V(8); PG8_WAIT_L(0); PG8_BAR; { PG8_MMA(1, 0, At, B0); PG8_MMA(1, 1, At, B1); } PG8_BAR; PG8_SCHED;
            PG8_LDB(B0, 1, 0); PG8_LDB(B1, 1, 1); PG8_SCHED; PG8_LDA(At, 1, 0); PG8_STAGE(PG8_SA(0, 1), a2 + hstepA, voffA);
            PG8_WAIT_V(8); PG8_WAIT_L(0); PG8_BAR; { PG8_MMA(0, 0, At, B0); PG8_MMA(0, 1, At, B1); } PG8_BAR; PG8_SCHED;
            PG8_LDA(At, 1, 1); PG8_STAGE(PG8_SB(1, 0), b3, voffB); PG8_STAGE(PG8_SB(1, 1), b3 + hstepB, voffB); PG8_STAGE(PG8_SA(1, 0), a3, voffA);
            PG8_WAIT_V(8); PG8_WAIT_L(0); PG8_BAR; { PG8_MMA(1, 0, At, B0); PG8_MMA(1, 1, At, B1); } PG8_BAR; PG8_SCHED;
        }
        } else {
        for (int t = 0; t < nt; t += 2) {
            const bool last = (t == nt - 2);
            const char* a1 = cA + (size_t)(t + 1) * kstep;
            const char* a2 = last ? nA : cA + (size_t)(t + 2) * kstep; const char* b2 = last ? nB : cB + (size_t)(t + 2) * kstep;
            const char* a3 = a2 + kstep; const char* b3 = b2 + kstep;
            PG8_LDB(B0, 0, 0); PG8_LDB(B1, 0, 1); PG8_SCHED; PG8_LDA(At, 0, 0); PG8_STAGE(PG8_SA(1, 1), a1 + hstepA, voffA);
            PG8_WAIT_V(8); PG8_WAIT_L(0); PG8_BAR; if (do0) { PG8_MMA(0, 0, At, B0); PG8_MMA(0, 1, At, B1); } PG8_BAR; PG8_SCHED;
            PG8_LDA(At, 0, 1); PG8_STAGE(PG8_SB(0, 0), b2, voffB); PG8_STAGE(PG8_SB(0, 1), b2 + hstepB, voffB); PG8_STAGE(PG8_SA(0, 0), a2, voffA);
            PG8_WAIT_V(8); PG8_WAIT_L(0); PG8_BAR; if (do1) { PG8_MMA(1, 0, At, B0); PG8_MMA(1, 1, At, B1); } PG8_BAR; PG8_SCHED;
            PG8_LDB(B0, 1, 0); PG8_LDB(B1, 1, 1); PG8_SCHED; PG8_LDA(At, 1, 0); PG8_STAGE(PG8_SA(0, 1), a2 + hstepA, voffA);
            PG8_WAIT_V(8); PG8_WAIT_L(0); PG8_BAR; if (do0) { PG8_MMA(0, 0, At, B0); PG8_MMA(0, 1, At, B1); } PG8_BAR; PG8_SCHED;
            PG8_LDA(At, 1, 1); PG8_STAGE(PG8_SB(1, 0), b3, voffB); PG8_STAGE(PG8_SB(1, 1), b3 + hstepB, voffB); PG8_STAGE(PG8_SA(1, 0), a3, voffA);
            PG8_WAIT_V(8); PG8_WAIT_L(0); PG8_BAR; if (do1) { PG8_MMA(1, 0, At, B0); PG8_MMA(1, 1, At, B1); } PG8_BAR; PG8_SCHED;
        }
        }
        if (wr == 0) PG8_BAR;
        if constexpr (Epi::FUSED) E.fused(acc, cur, wr, wc, fr, fq, lds, wid, lane); else E(acc, cur, wr, wc, fr, fq);
        if (!has_next) break;
#pragma unroll
        for (int a = 0; a < 2; ++a)
#pragma unroll
            for (int b = 0; b < 2; ++b)
#pragma unroll
                for (int m = 0; m < 4; ++m)
#pragma unroll
                    for (int n = 0; n < 2; ++n) acc[a][b][m][n] = (f32x4){0.f, 0.f, 0.f, 0.f};
        cur = nxt; cA = nA; cB = nB; ++ui;
        if (wr == 1) PG8_BAR;
    }
    PG8_WAIT_V(0);
    PG8_BAR;
#undef PG8_SA
#undef PG8_SB
#undef PG8_STAGE
#undef PG8_LDA
#undef PG8_LDB
#undef PG8_MMA
#undef PG8_WAIT_V
#undef PG8_WAIT_L
#undef PG8_BAR
#undef PG8_SCHED
}

typedef const f32x4 (&AccRef)[2][2][4][2];
#define EPI_ROWS(...) _Pragma("unroll") for (int ai = 0; ai < 2; ++ai) _Pragma("unroll") for (int m = 0; m < 4; ++m) { const int r = u.pm * BM + ai * HALF + wr * 64 + m * 16 + fr; __VA_ARGS__; asm volatile("" ::: "memory"); }

struct EpiSwiGLU { static constexpr bool FUSED = false;
    bf16_t* H;
    __device__ __forceinline__ void operator()(AccRef acc, const Unit& u, int wr, int wc, int fr, int fq) const {
        const int col0 = u.pn * 128 + wc * 32 + 8 * fq;
        EPI_ROWS({
            const f32x4 g0 = acc[ai][0][m][0], g1 = acc[ai][0][m][1];
            const f32x4 v0 = g0 * sigm4(g0) * acc[ai][1][m][0], v1 = g1 * sigm4(g1) * acc[ai][1][m][1];
            *(u32x4*)(H + (size_t)r * FF + col0) = pack8(v0, v1);
        })
    }
};
template <bool X0> struct EpiAdd { static constexpr bool FUSED = false;
    X0Src src; float* out; float* pb; float scale;
    __device__ __forceinline__ void operator()(AccRef acc, const Unit& u, int wr, int wc, int fr, int fq) const {
        const int col0 = u.pn * BM + wc * 32 + 8 * fq;
        if (u.kt0 == 0) {
            EPI_ROWS({
                float* op = out + (size_t)r * D + col0; const float* bp = X0 ? x0_row(src, r) : out + (size_t)r * D;
                _Pragma("unroll") for (int bj = 0; bj < 2; ++bj) {
                    f32x4 b0 = (f32x4){0.f, 0.f, 0.f, 0.f}, b1 = b0;
                    if (!X0 || bp) { b0 = *(const f32x4*)(bp + col0 + bj * HALF); b1 = *(const f32x4*)(bp + col0 + bj * HALF + 4); }
                    *(f32x4*)(op + bj * HALF) = b0 + scale * acc[ai][bj][m][0]; *(f32x4*)(op + bj * HALF + 4) = b1 + scale * acc[ai][bj][m][1]; }
            })
        } else {
            float* pbq = pb + (size_t)(u.kt0 / u.nkt - 1) * ((size_t)(MP - TS_ROWS0) * D) - (size_t)TS_ROWS0 * D;
            EPI_ROWS({
                float* op = pbq + (size_t)r * D + col0;
                _Pragma("unroll") for (int bj = 0; bj < 2; ++bj) { *(f32x4*)(op + bj * HALF) = scale * acc[ai][bj][m][0]; *(f32x4*)(op + bj * HALF + 4) = scale * acc[ai][bj][m][1]; }
            })
        }
    }
};
template <int MODE  , bool X0> struct EpiDownFinal { static constexpr bool FUSED = true;
    X0Src src; float* X; float scale; const float* gain; float* out; bf16_t* XN; unsigned* xbuf; unsigned* cnt;
    __device__ __forceinline__ void fused(f32x4 (&acc)[2][2][4][2], const Unit& u, int wr, int wc, int fr, int fq, LAS unsigned char* lds, int wid, int lane) const {
        const int col0 = u.pn * BM + wc * 32 + 8 * fq;
        int c1 = col0, pm1 = u.pm, rb1 = wr * 64 + fr, wc1 = wc; asm volatile("" : "+v"(c1), "+s"(pm1), "+v"(rb1), "+v"(wc1));
        LAS float* P = (LAS float*)(lds + 131072);
        LAS float* S = (LAS float*)(lds + 131072 + 4096);
#pragma unroll
        for (int ai = 0; ai < 2; ++ai)
#pragma unroll
            for (int m = 0; m < 4; ++m) { const int r = pm1 * BM + ai * HALF + m * 16 + rb1; const float* xp = (X0 ? x0_row(src, r) : X + (size_t)r * D) + c1; float* xo = X + (size_t)r * D + c1; float q = 0.f;
#pragma unroll
                for (int bj = 0; bj < 2; ++bj)
#pragma unroll
                    for (int n = 0; n < 2; ++n) { const f32x4 b = *(const f32x4*)(xp + bj * HALF + 4 * n); const f32x4 v = b + scale * acc[ai][bj][m][n]; acc[ai][bj][m][n] = v;
                        if (MODE == 1) *(f32x4*)(xo + bj * HALF + 4 * n) = v;
                        q += (v[0] * v[0] + v[1] * v[1]) + (v[2] * v[2] + v[3] * v[3]); }
                q += __shfl_xor(q, 16); q += __shfl_xor(q, 32);
                if (fq == 0) P[(ai * HALF + m * 16 + rb1) * 4 + wc1] = q;
                asm volatile("" ::: "memory"); }
        asm volatile("s_waitcnt lgkmcnt(0)" ::: "memory"); __builtin_amdgcn_s_barrier(); asm volatile("" ::: "memory");
        int row = wid * 32 + (lane & 31); asm volatile("" : "+v"(row));
        if (lane < 32) { const float t = (P[row * 4 + 0] + P[row * 4 + 1]) + (P[row * 4 + 2] + P[row * 4 + 3]);
            __hip_atomic_store(xbuf + ((size_t)(u.pm * BM + row) * 8 + u.pn), __builtin_bit_cast(unsigned, t), __ATOMIC_RELAXED, __HIP_MEMORY_SCOPE_AGENT); }
        asm volatile("s_waitcnt vmcnt(0)" ::: "memory");
        if (lane == 0) (void)__hip_atomic_fetch_add(cnt + 64 * u.pm, 1u, __ATOMIC_RELAXED, __HIP_MEMORY_SCOPE_AGENT);
        if (wid == 0) { unsigned sp = 0;
            _Pragma("unroll 1") while ((unsigned)__builtin_amdgcn_readfirstlane(__hip_atomic_load(cnt + 64 * u.pm, __ATOMIC_RELAXED, __HIP_MEMORY_SCOPE_AGENT)) < 64u) { __builtin_amdgcn_s_sleep(2); if (++sp > (1u << 22)) break; }
            __builtin_amdgcn_fence(__ATOMIC_ACQUIRE, "agent"); }
        asm volatile("s_waitcnt vmcnt(0) lgkmcnt(0)" ::: "memory"); __builtin_amdgcn_s_barrier(); asm volatile("" ::: "memory");
        if (lane < 32) { const unsigned* sl = xbuf + (size_t)(u.pm * BM + row) * 8; float t = 0.f;
#pragma unroll
            for (int k = 0; k < 8; ++k) t += __builtin_bit_cast(float, __hip_atomic_load(sl + k, __ATOMIC_RELAXED, __HIP_MEMORY_SCOPE_AGENT));
            S[row] = 1.0f / sqrtf(t * (1.0f / D) + RMS_EPS); }
        asm volatile("s_waitcnt vmcnt(0) lgkmcnt(0)" ::: "memory"); __builtin_amdgcn_s_barrier(); asm volatile("" ::: "memory");
        int c5 = col0, pm5 = u.pm, rb5 = wr * 64 + fr; asm volatile("" : "+v"(c5), "+s"(pm5), "+v"(rb5));
        const int b0 = (pm5 * BM) / LP, t0 = pm5 * BM - b0 * LP;
#pragma unroll
        for (int ai = 0; ai < 2; ++ai)
#pragma unroll
            for (int m = 0; m < 4; ++m) { const int rl = ai * HALF + m * 16 + rb5; const float rs = S[rl];
                if (MODE == 0) { int t = t0 + rl, b = b0; if (t >= LP) { t -= LP; ++b; }
                    if (t >= NMETA) { float* op = out + O_YP + ((size_t)b * SEQ + (t - NMETA)) * D + c5;
#pragma unroll
                        for (int bj = 0; bj < 2; ++bj) { const f32x4 g0 = *(const f32x4*)(gain + c5 + bj * HALF), g1 = *(const f32x4*)(gain + c5 + bj * HALF + 4);
                            *(f32x4*)(op + bj * HALF) = acc[ai][bj][m][0] * rs * g0; *(f32x4*)(op + bj * HALF + 4) = acc[ai][bj][m][1] * rs * g1; } } }
                else { bf16_t* op = XN + (size_t)(pm5 * BM + rl) * D + c5;
#pragma unroll
                    for (int bj = 0; bj < 2; ++bj) { const f32x4 g0 = *(const f32x4*)(gain + c5 + bj * HALF), g1 = *(const f32x4*)(gain + c5 + bj * HALF + 4);
                        *(u32x4*)(op + bj * HALF) = pack8(acc[ai][bj][m][0] * rs * g0, acc[ai][bj][m][1] * rs * g1); } }
                asm volatile("" ::: "memory"); }
    }
};
struct EpiWin { static constexpr bool FUSED = false;
    float* UP; float* US; bf16_t* G; const float* bg;
    __device__ __forceinline__ void operator()(AccRef acc, const Unit& u, int wr, int wc, int fr, int fq) const {
        if (u.pn < 8) {
            float* O = (u.pn < 4 ? UP : US); const int col0 = (u.pn & 3) * BM + wc * 32 + 8 * fq;
            EPI_ROWS({
                float* op = O + (size_t)r * 1024 + col0;
                _Pragma("unroll") for (int bj = 0; bj < 2; ++bj) { *(f32x4*)(op + bj * HALF) = acc[ai][bj][m][0]; *(f32x4*)(op + bj * HALF + 4) = acc[ai][bj][m][1]; }
            })
        } else {
            const int col0 = (u.pn - 8) * BM + wc * 32 + 8 * fq;
            f32x4 bv[2][2];
#pragma unroll
            for (int bj = 0; bj < 2; ++bj) { bv[bj][0] = *(const f32x4*)(bg + col0 + bj * HALF); bv[bj][1] = *(const f32x4*)(bg + col0 + bj * HALF + 4); }
            EPI_ROWS({
                bf16_t* op = G + (size_t)r * 4096 + col0;
                _Pragma("unroll") for (int bj = 0; bj < 2; ++bj) *(u32x4*)(op + bj * HALF) = pack8(sigm4(acc[ai][bj][m][0] + bv[bj][0]), sigm4(acc[ai][bj][m][1] + bv[bj][1]));
            })
        }
    }
};
struct EpiPool { static constexpr bool FUSED = false;
    bf16_t* AB; const float* sc;
    __device__ __forceinline__ void operator()(AccRef acc, const Unit& u, int wr, int wc, int fr, int fq) const {
        const int col0 = u.pn * BM + wc * 32 + 8 * fq;
        f32x4 sv[2][2];
#pragma unroll
        for (int bj = 0; bj < 2; ++bj) { sv[bj][0] = *(const f32x4*)(sc + col0 + bj * HALF); sv[bj][1] = *(const f32x4*)(sc + col0 + bj * HALF + 4); }
        EPI_ROWS({
            bf16_t* op = AB + (size_t)r * 2048 + col0;
            _Pragma("unroll") for (int bj = 0; bj < 2; ++bj) *(u32x4*)(op + bj * HALF) = pack8(acc[ai][bj][m][0] * sv[bj][0], acc[ai][bj][m][1] * sv[bj][1]);
        })
    }
};
struct EpiGLU { static constexpr bool FUSED = false;
    bf16_t* AB; const bf16_t* SG; const float* gb;
    __device__ __forceinline__ void operator()(AccRef acc, const Unit& u, int wr, int wc, int fr, int fq) const {
        const int col0 = u.pn * BM + wc * 32 + 8 * fq;
        f32x4 bv[2][2];
#pragma unroll
        for (int bj = 0; bj < 2; ++bj) { bv[bj][0] = *(const f32x4*)(gb + col0 + bj * HALF); bv[bj][1] = *(const f32x4*)(gb + col0 + bj * HALF + 4); }
        EPI_ROWS({
            bf16_t* op = AB + (size_t)r * 2048 + 1024 + col0; const bf16_t* sp = SG + (size_t)r * 1024 + col0;
            _Pragma("unroll") for (int bj = 0; bj < 2; ++bj) { f32x4 s0, s1; unpack8(*(const u32x4*)(sp + bj * HALF), s0, s1);
                *(u32x4*)(op + bj * HALF) = pack8(s0 * sigm4(acc[ai][bj][m][0] + bv[bj][0]), s1 * sigm4(acc[ai][bj][m][1] + bv[bj][1])); }
        })
    }
};
struct EpiBr1 { static constexpr bool FUSED = false;
    bf16_t* T1; const bf16_t* G;
    __device__ __forceinline__ void operator()(AccRef acc, const Unit& u, int wr, int wc, int fr, int fq) const {
        const int col0 = u.pn * BM + wc * 32 + 8 * fq;
        EPI_ROWS({
            bf16_t* op = T1 + (size_t)r * 2048 + col0; const bf16_t* gp = G + (size_t)r * 4096 + col0;
            _Pragma("unroll") for (int bj = 0; bj < 2; ++bj) { f32x4 g0, g1; unpack8(*(const u32x4*)(gp + bj * HALF), g0, g1);
                *(u32x4*)(op + bj * HALF) = pack8(g0 * acc[ai][bj][m][0], g1 * acc[ai][bj][m][1]); }
        })
    }
};
struct EpiBr2 { static constexpr bool FUSED = false;
    const bf16_t* T1; const bf16_t* G; bf16_t* MRG;
    __device__ __forceinline__ void operator()(AccRef acc, const Unit& u, int wr, int wc, int fr, int fq) const {
        const int col0 = u.pn * BM + wc * 32 + 8 * fq;
        EPI_ROWS({
            const bf16_t* tp = T1 + (size_t)r * 2048 + col0; const bf16_t* gp = G + (size_t)r * 4096 + 2048 + col0; bf16_t* op = MRG + (size_t)r * 2048 + col0;
            _Pragma("unroll") for (int bj = 0; bj < 2; ++bj) { f32x4 g0, g1; unpack8(*(const u32x4*)(gp + bj * HALF), g0, g1);
                f32x4 t0, t1; unpack8(*(const u32x4*)(tp + bj * HALF), t0, t1);
                *(u32x4*)(op + bj * HALF) = pack8(t0 + g0 * acc[ai][bj][m][0], t1 + g1 * acc[ai][bj][m][1]); }
        })
    }
};
}

__device__ __forceinline__ void cvt_item(const float* W, int K, int N, bf16_t* WT, int mode, int item, int lane) {
    const int nblk = N >> 6, kb = item / nblk, nb = item - kb * nblk, k0 = kb << 6, n0 = nb << 6;
    const int rg = lane >> 4, nq = lane & 15;
    const float* src = W + (size_t)(k0 + 16 * rg) * N + n0 + 4 * nq;
    f32x4 v[16];
#pragma unroll
    for (int i = 0; i < 16; ++i) v[i] = __builtin_nontemporal_load((const f32x4*)(src + (size_t)i * N));
    const int drow0 = (mode == 0 ? n0 : ((n0 >> 7) * 256 + (mode == 2 ? 128 : 0) + (n0 & 127))) + 4 * nq;
    bf16_t* dst = WT + (size_t)drow0 * K + k0 + 16 * rg;
#pragma unroll
    for (int j = 0; j < 4; ++j)
#pragma unroll
        for (int h = 0; h < 2; ++h) {
            u32x4 w; w.x = cvt_pk_bf16(v[8 * h + 0][j], v[8 * h + 1][j]); w.y = cvt_pk_bf16(v[8 * h + 2][j], v[8 * h + 3][j]);
            w.z = cvt_pk_bf16(v[8 * h + 4][j], v[8 * h + 5][j]); w.w = cvt_pk_bf16(v[8 * h + 6][j], v[8 * h + 7][j]);
            *(u32x4*)(dst + (size_t)j * K + 8 * h) = w; }
}
struct Args { const float* in[33]; float* out; unsigned char* ws; int ph_lo, ph_hi; };
typedef const __attribute__((address_space(4))) Args* ArgsP;
struct Frame {
    ArgsP a; unsigned char* ws; float* out;
    LAS unsigned char* lds; int tid, lane, wave, G, gw, NGW;
};
__device__ __forceinline__ void cvt_ffn(const Frame& F, int i0, int w0, int nw, int part = 0, int nparts = 1) {
    constexpr int IG = (D / 64) * (FF / 64);
    bf16_t* wgu = (bf16_t*)(F.ws + WS_WGU); bf16_t* wd = (bf16_t*)(F.ws + WS_WD);
    const int ib = (int)((long)part * (3 * IG) / nparts), ie = (int)((long)(part + 1) * (3 * IG) / nparts);
    for (int it = ib + w0; it < ie; it += nw) {
        if (it < IG) cvt_item(F.a->in[i0], D, FF, wgu, 1, it, F.lane);
        else if (it < 2 * IG) cvt_item(F.a->in[i0 + 1], D, FF, wgu, 2, it - IG, F.lane);
        else cvt_item(F.a->in[i0 + 2], FF, D, wd, 0, it - 2 * IG, F.lane);
    }
}
__device__ __forceinline__ void cvt_mixer(const Frame& F, int w0, int nw, int it0, int it1) {
    constexpr int I_IN = (D / 64) * (WIN / 64)  , I_PW = 4 * 16, I_GLU = 256, I_A = 16 * 32, I_O = 32 * 32;
    constexpr int TOT = I_IN + I_PW + I_GLU + 2 * I_A + I_O;
    static_assert(TOT == 5440, "mixer conversion items");
    for (int it = it0 + w0; it < it1; it += nw) {
        int r = it;
        if (r < I_IN) { cvt_item(F.a->in[11], D, WIN, (bf16_t*)(F.ws + WS_WIN), 0, r, F.lane); continue; } r -= I_IN;
        if (r < I_PW) { const int g = r >> 4; cvt_item(F.a->in[13] + (size_t)g * 65536, 256, 256, (bf16_t*)(F.ws + WS_PW) + (size_t)g * 65536, 0, r & 15, F.lane); continue; } r -= I_PW;
        if (r < I_GLU) { cvt_item(F.a->in[23], 1024, 1024, (bf16_t*)(F.ws + WS_GLU), 0, r, F.lane); continue; } r -= I_GLU;
        if (r < I_A) { cvt_item(F.a->in[25], 1024, 2048, (bf16_t*)(F.ws + WS_WA), 0, r, F.lane); continue; } r -= I_A;
        if (r < I_A) { cvt_item(F.a->in[26], 1024, 2048, (bf16_t*)(F.ws + WS_WB), 0, r, F.lane); continue; } r -= I_A;
        cvt_item(F.a->in[27], 2048, 2048, (bf16_t*)(F.ws + WS_WOUT), 0, r, F.lane);
    }
}

__device__ __forceinline__ void rms_row(const float* xrow, const float* gain, bf16_t* orow, float* frow, int lane, float* copy = nullptr, const float* pbrow = nullptr, size_t pbstride = 0) {
    f32x4 v[8]; float s = 0.f;
#pragma unroll
    for (int j = 0; j < 8; ++j) { v[j] = ((const f32x4*)xrow)[64 * j + lane]; if (pbrow) { v[j] += ((const f32x4*)pbrow)[64 * j + lane]; v[j] += ((const f32x4*)(pbrow + pbstride))[64 * j + lane]; v[j] += ((const f32x4*)(pbrow + 2 * pbstride))[64 * j + lane]; } s += (v[j][0] * v[j][0] + v[j][1] * v[j][1]) + (v[j][2] * v[j][2] + v[j][3] * v[j][3]); }
    if (copy) {
#pragma unroll
        for (int j = 0; j < 8; ++j) ((f32x4*)copy)[64 * j + lane] = v[j]; }
    const float rs = 1.0f / sqrtf(wave_sum(s) * (1.0f / D) + RMS_EPS);
#pragma unroll
    for (int j = 0; j < 8; ++j) { const f32x4 gg = ((const f32x4*)gain)[64 * j + lane]; const f32x4 o = v[j] * rs * gg;
        if (orow) { u32x2 w; w.x = cvt_pk_bf16(o[0], o[1]); w.y = cvt_pk_bf16(o[2], o[3]); ((u32x2*)orow)[64 * j + lane] = w; }
        else ((f32x4*)frow)[64 * j + lane] = o; }
}
__device__ __forceinline__ void zero_row_bf16(bf16_t* orow, int lane) {
#pragma unroll
    for (int j = 0; j < 8; ++j) ((u32x2*)orow)[64 * j + lane] = (u32x2){0u, 0u};
}

__device__ __forceinline__ void sincos_r(float x, float& s, float& c) {
    const float k = rintf(x * 0.6366197723675814f);
    float r = fmaf(-k, 1.5707963705062866f, x); r = fmaf(-k, -4.371139000186241e-8f, r);
    const float z = r * r;
    const float sp = r + r * z * (-1.6666654611e-1f + z * (8.3321608736e-3f + z * (-1.9515295891e-4f)));
    const float cp = 1.0f - 0.5f * z + z * z * (4.166664568298827e-2f + z * (-1.388731625493765e-3f + z * 2.443315711809948e-5f));
    const int q = ((int)k) & 3;
    s = (q == 0) ? sp : (q == 1) ? cp : (q == 2) ? -sp : -cp;
    c = (q == 0) ? cp : (q == 1) ? -sp : (q == 2) ? -cp : sp;
}
__device__ __forceinline__ bf16x8 pack8s(f32x4 a, f32x4 b) { const u32x4 w = pack8(a, b); return __builtin_bit_cast(bf16x8, w); }

#define WSYNC() asm volatile("s_waitcnt lgkmcnt(0)" ::: "memory")
struct S5K { float lbr, lbi; bf16x8 bb[8]; bf16x8 cm[4]; f32x4 dsk; };

__device__ __forceinline__ void s5_consts(const Frame& F, int g, LAS float* tab, S5K& k) {
    const int lane = F.lane, i16 = lane & 15, kq = lane >> 4;
    const float lre = F.a->in[15][g * NP + lane], lim = F.a->in[16][g * NP + lane], dt = expf(F.a->in[17][g]);
    const float a = lre * dt, b = lim * dt;
    const float em1 = a * (1.0f + a * (0.5f + a * (1.0f / 6.0f + a * (1.0f / 24.0f + a * (1.0f / 120.0f + a * (1.0f / 720.0f))))));
    const float ea = 1.0f + em1;
    float sh, ch; sincos_r(0.5f * b, sh, ch);
    const float sb = 2.0f * sh * ch, cbm1 = -2.0f * sh * sh, cb = 1.0f + cbm1;
    k.lbr = ea * cb; k.lbi = ea * sb;
    const float rm1 = em1 * cb + cbm1, im1 = ea * sb;
    const float inv = 1.0f / (lre * lre + lim * lim);
    tab[2 * lane] = (rm1 * lre + im1 * lim) * inv; tab[2 * lane + 1] = (im1 * lre - rm1 * lim) * inv;
    WSYNC();
#pragma unroll
    for (int n4 = 0; n4 < 4; ++n4) {
        const int p = 16 * n4 + i16; const float qr = tab[2 * p], qi = tab[2 * p + 1];
        const float* br = F.a->in[18] + ((size_t)g * NP + p) * GS + 8 * (kq & 1); const float* bi = F.a->in[19] + ((size_t)g * NP + p) * GS + 8 * (kq & 1);
        const f32x4 r0 = *(const f32x4*)br, r1 = *(const f32x4*)(br + 4), i0 = *(const f32x4*)bi, i1 = *(const f32x4*)(bi + 4);
        k.bb[n4] = pack8s(qr * r0 - qi * i0, qr * r1 - qi * i1);
        k.bb[4 + n4] = pack8s(qr * i0 + qi * r0, qr * i1 + qi * r1);
    }
#pragma unroll
    for (int s = 0; s < 4; ++s) {
        const float* cp = (s < 2 ? F.a->in[20] : F.a->in[21]) + ((size_t)g * GS + i16) * NP + 32 * (s & 1) + 8 * kq;
        f32x4 c0 = *(const f32x4*)cp, c1 = *(const f32x4*)(cp + 4);
        if (s >= 2) { c0 = -c0; c1 = -c1; }
        k.cm[s] = pack8s(c0, c1);
    }
    k.dsk = *(const f32x4*)(F.a->in[22] + g * GS + 4 * kq);
    WSYNC();
}
__device__ __forceinline__ void s5_ld(const float* US, int row0, int g, int lane, f32x4& u0, f32x4& u1) {
    const float* up = US + (size_t)(row0 + (lane & 15)) * WSSM + g * GS + 8 * ((lane >> 4) & 1);
    u0 = *(const f32x4*)up; u1 = *(const f32x4*)(up + 4);
}
__device__ __forceinline__ void s5_bu(const f32x4 u0, const f32x4 u1, int lane, const S5K& k, LAS float* HB) {
    const int t = lane & 15, kq = lane >> 4;
    u32x4 hi = pack8(u0, u1);
    f32x4 h0, h1; unpack8(hi, h0, h1);
    const u32x4 lo = pack8(u0 - h0, u1 - h1);
    const bf16x8 uop = __builtin_bit_cast(bf16x8, (kq >= 2) ? lo : hi);
#pragma unroll
    for (int n = 0; n < 8; ++n) {
        const f32x4 d = __builtin_amdgcn_mfma_f32_16x16x32_bf16(k.bb[n], uop, (f32x4){0.f, 0.f, 0.f, 0.f}, 0, 0, 0);
        *(LAS f32x4*)(HB + t * 132 + 16 * n + 4 * kq) = d;
    }
    WSYNC();
}
__device__ __forceinline__ void s5_out(const f32x4 uu, bf16_t* SG, int row0, int g, int lane, const S5K& k, const LAS float* HB) {
    const int t = lane & 15, kq = lane >> 4;
    f32x4 acc = (f32x4){0.f, 0.f, 0.f, 0.f};
#pragma unroll
    for (int s = 0; s < 4; ++s) {
        const LAS float* hp = HB + t * 132 + 32 * s + 8 * kq;
        const f32x4 h0 = *(const LAS f32x4*)hp, h1 = *(const LAS f32x4*)(hp + 4);
        acc = __builtin_amdgcn_mfma_f32_16x16x32_bf16(k.cm[s], pack8s(h0, h1), acc, 0, 0, 0);
    }
    const f32x4 y = acc + k.dsk * uu;
    u32x2 w; w.x = cvt_pk_bf16(gelu_tanh(y[0]), gelu_tanh(y[1])); w.y = cvt_pk_bf16(gelu_tanh(y[2]), gelu_tanh(y[3]));
    *(u32x2*)(SG + (size_t)(row0 + t) * WSSM + g * GS + 4 * kq) = w;
    WSYNC();
}

__device__ __forceinline__ void s5_phase(const Frame& F) {
    const float* US = (const float*)(F.ws + WS_US); bf16_t* SG = (bf16_t*)(F.ws + WS_SG);
    LAS f32x2* EB = (LAS f32x2*)F.lds;
    LAS float* HB = (LAS float*)(F.lds + 66048 + F.wave * 8448);
    const int lane = F.lane;
    S5K k;
    for (int item = blockIdx.x; item < NBP * NG; item += F.G) {
        const int b = item >> 6, g = item & 63, rb = b * LP;
        s5_consts(F, g, HB, k);
        f32x4 nu0, nu1; s5_ld(US, rb + 16 * F.wave, g, lane, nu0, nu1);
        for (int c = F.wave; c < NCH; c += 8) {
            const f32x4 u0 = nu0, u1 = nu1; if (c + 8 < NCH) s5_ld(US, rb + 16 * (c + 8), g, lane, nu0, nu1);
            s5_bu(u0, u1, lane, k, HB);
            float br[16], bi[16];
#pragma unroll
            for (int t = 0; t < 16; ++t) { br[t] = HB[t * 132 + lane]; bi[t] = HB[t * 132 + 64 + lane]; }
            float hr = 0.f, hi = 0.f;
#pragma unroll
            for (int t = 0; t < 16; ++t) { const float nr = k.lbr * hr - k.lbi * hi + br[t], ni = k.lbr * hi + k.lbi * hr + bi[t]; hr = nr; hi = ni; }
            EB[c * 64 + lane] = (f32x2){hr, hi};
            WSYNC();
        }
        __syncthreads();
        if (F.wave == 0) {
            float pr = k.lbr, pi = k.lbi;
#pragma unroll
            for (int q = 0; q < 4; ++q) { const float nr = pr * pr - pi * pi, ni = 2.0f * pr * pi; pr = nr; pi = ni; }
            float hr = 0.f, hi = 0.f;
            for (int c0 = 0; c0 < NCH; c0 += 8) {
                f32x2 e[8];
#pragma unroll
                for (int j = 0; j < 8; ++j) e[j] = (c0 + j < NCH) ? EB[(c0 + j) * 64 + lane] : (f32x2){0.f, 0.f};
#pragma unroll
                for (int j = 0; j < 8; ++j) { const float nr = pr * hr - pi * hi + e[j][0], ni = pr * hi + pi * hr + e[j][1]; hr = nr; hi = ni; e[j] = (f32x2){hr, hi}; }
#pragma unroll
                for (int j = 0; j < 8; ++j) if (c0 + j < NCH) EB[(c0 + j) * 64 + lane] = e[j];
            }
            const f32x2 fin = EB[(NCH - 1) * 64 + lane];
            F.out[O_RP + (size_t)(b * NG + g) * NP + lane] = fin[0]; F.out[O_IP + (size_t)(b * NG + g) * NP + lane] = fin[1];
        }
        __syncthreads();
        s5_ld(US, rb + 16 * F.wave, g, lane, nu0, nu1);
        for (int c = F.wave; c < NCH; c += 8) {
            const f32x4 u0 = nu0, u1 = nu1; if (c + 8 < NCH) s5_ld(US, rb + 16 * (c + 8), g, lane, nu0, nu1);
            const f32x4 uu = *(const f32x4*)(US + (size_t)(rb + 16 * c + (lane & 15)) * WSSM + g * GS + 4 * (lane >> 4));
            s5_bu(u0, u1, lane, k, HB);
            float br[16], bi[16];
#pragma unroll
            for (int t = 0; t < 16; ++t) { br[t] = HB[t * 132 + lane]; bi[t] = HB[t * 132 + 64 + lane]; }
            f32x2 h0 = (f32x2){0.f, 0.f}; if (c > 0) h0 = EB[(c - 1) * 64 + lane];
            float hr = h0[0], hi = h0[1];
#pragma unroll
            for (int t = 0; t < 16; ++t) { const float nr = k.lbr * hr - k.lbi * hi + br[t], ni = k.lbr * hi + k.lbi * hr + bi[t]; hr = nr; hi = ni; br[t] = hr; bi[t] = hi; }
#pragma unroll
            for (int t = 0; t < 16; ++t) { HB[t * 132 + lane] = br[t]; HB[t * 132 + 64 + lane] = bi[t]; }
            WSYNC();
            s5_out(uu, SG, rb + 16 * c, g, lane, k, HB);
        }
        __syncthreads();
    }
    for (int it = F.gw; it < NG * (MSA / 16); it += F.NGW) {
        const int g = it >> 5, j = it & 31, row0 = MPR + 16 * j;
        f32x4 u0, u1; s5_ld(US, row0, g, lane, u0, u1);
        const f32x4 uu = *(const f32x4*)(US + (size_t)(row0 + (lane & 15)) * WSSM + g * GS + 4 * (lane >> 4));
        s5_consts(F, g, HB, k);
        s5_bu(u0, u1, lane, k, HB);
        float br[16], bi[16];
#pragma unroll
        for (int t = 0; t < 16; ++t) { br[t] = HB[t * 132 + lane]; bi[t] = HB[t * 132 + 64 + lane]; }
#pragma unroll
        for (int sq = 0; sq < 4; ++sq) {
            const size_t so = ((size_t)(4 * j + sq) * NG + g) * NP + lane;
            float hr = F.a->in[3][so], hi = F.a->in[4][so];
#pragma unroll
            for (int t = 4 * sq; t < 4 * sq + 4; ++t) { const float nr = k.lbr * hr - k.lbi * hi + br[t], ni = k.lbr * hi + k.lbi * hr + bi[t]; hr = nr; hi = ni; br[t] = hr; bi[t] = hi; }
            F.out[O_RS + so] = hr; F.out[O_IS + so] = hi;
        }
#pragma unroll
        for (int t = 0; t < 16; ++t) { HB[t * 132 + lane] = br[t]; HB[t * 132 + 64 + lane] = bi[t]; }
        WSYNC();
        s5_out(uu, SG, row0, g, lane, k, HB);
    }
}

__device__ __forceinline__ void store_d(bf16_t* p, f32x4 d) { u32x2 w; w.x = cvt_pk_bf16(d[0], d[1]); w.y = cvt_pk_bf16(d[2], d[3]); *(u32x2*)p = w; }
template <int W, int T> __device__ __forceinline__ void pool_rows(const f32x4* cur, const f32x4* old, int skip, int avail0, bf16_t* dd) {
    f32x4 u[T], o[W - 1];
#pragma unroll
    for (int k = 0; k < W - 1; ++k) o[k] = (k >= skip) ? old[(size_t)k * 256] : (f32x4){0.f, 0.f, 0.f, 0.f};
#pragma unroll
    for (int t = 0; t < T; ++t) u[t] = cur[(size_t)t * 256];
    f32x4 s = (f32x4){0.f, 0.f, 0.f, 0.f};
#pragma unroll
    for (int k = 0; k < W - 1; ++k) s += o[k];
#pragma unroll
    for (int t = 0; t < T; ++t) {
        s += u[t];
        const int av = avail0 + t + 1; const float inv = 1.0f / (float)(av < W ? av : W);
        store_d(dd + (size_t)t * WPOOL, s * inv - u[t]);
        if (t - (W - 1) >= 0) s -= u[t - (W - 1) >= 0 ? t - (W - 1) : 0]; else s -= o[t < W - 1 ? t : 0];
    }
}
__device__ __forceinline__ void pool_phase(const Frame& F) {
    const f32x4* UP4 = (const f32x4*)(F.ws + WS_UP); bf16_t* DD = (bf16_t*)(F.ws + WS_DD);
    const int half = F.tid >> 8, q = F.tid & 255, grp = __builtin_amdgcn_readfirstlane(q >> 6);
    constexpr int NPI = NBP * NCH  , NSI = NBS;
    for (int it = blockIdx.x * 2 + half; it < NPI + NSI; it += F.G * 2) {
        if (it < NPI) {
            const int b = it / NCH, ch = it - b * NCH, t0 = 16 * ch, rb = b * LP;
            const f32x4* cur = UP4 + (size_t)(rb + t0) * 256 + q; bf16_t* dd = DD + (size_t)(rb + t0) * WPOOL + 4 * q;
            if (grp == 0)      pool_rows<2, 16>(cur, cur - (size_t)1 * 256, 1 - t0 > 0 ? 1 - t0 : 0, t0, dd);
            else if (grp == 1) pool_rows<4, 16>(cur, cur - (size_t)3 * 256, 3 - t0 > 0 ? 3 - t0 : 0, t0, dd);
            else if (grp == 2) pool_rows<8, 16>(cur, cur - (size_t)7 * 256, 7 - t0 > 0 ? 7 - t0 : 0, t0, dd);
            else               pool_rows<16, 16>(cur, cur - (size_t)15 * 256, 15 - t0 > 0 ? 15 - t0 : 0, t0, dd);
        } else {
            const int bs = it - NPI, rs = MPR + 4 * bs; const f32x4* hist = (const f32x4*)F.a->in[2] + (size_t)bs * 15 * 256 + q;
            const f32x4* cur = UP4 + (size_t)rs * 256 + q; bf16_t* dd = DD + (size_t)rs * WPOOL + 4 * q;
            if (grp == 0)      pool_rows<2, 4>(cur, hist + (size_t)14 * 256, 0, 1 << 20, dd);
            else if (grp == 1) pool_rows<4, 4>(cur, hist + (size_t)12 * 256, 0, 1 << 20, dd);
            else if (grp == 2) pool_rows<8, 4>(cur, hist + (size_t)8 * 256, 0, 1 << 20, dd);
            else               pool_rows<16, 4>(cur, hist, 0, 1 << 20, dd);
        }
    }
    const int gt = blockIdx.x * 512 + F.tid, NT = F.G * 512;
    f32x4* pp = (f32x4*)(F.out + O_PP); f32x4* ps = (f32x4*)(F.out + O_PS);
    for (int i = gt; i < NBP * 15 * 256; i += NT) { const int c = i & 255, j = (i >> 8) % 15, b = i / (15 * 256); pp[i] = UP4[(size_t)(b * LP + LP - 15 + j) * 256 + c]; }
    for (int i = gt; i < NBS * 15 * 256; i += NT) { const int c = i & 255, j = (i >> 8) % 15, b = i / (15 * 256);
        ps[i] = (j < 11) ? ((const f32x4*)F.a->in[2])[((size_t)b * 15 + j + 4) * 256 + c] : UP4[(size_t)(MPR + 4 * b + j - 11) * 256 + c]; }
}


#define XB_TMO      128
#define XB_XCNT(j)  (256  + 64 * (j))
#define XB_XSUB(j)  (1280 + 64 * (j))
#define XB_XGEN(j)  (2304 + 64 * (j))
#define XB_TOP      3328
#define XB_TOPGEN   3392
#define XCD_BAR_WORDS 3456
#define XB_SPIN_CAP (1u << 20)
__device__ __forceinline__ unsigned xb_ld(unsigned* p)              { return __hip_atomic_load(p, __ATOMIC_RELAXED, __HIP_MEMORY_SCOPE_AGENT); }
__device__ __forceinline__ unsigned xb_add(unsigned* p, unsigned v) { return __hip_atomic_fetch_add(p, v, __ATOMIC_RELAXED, __HIP_MEMORY_SCOPE_AGENT); }
__device__ __forceinline__ unsigned xb_xcc_id() { return (unsigned)__builtin_amdgcn_s_getreg((3 << 11) | 20) & 0xFu; }
#define XB_SPIN(cond, bar) do { unsigned _sp = 0; while (cond) { __builtin_amdgcn_s_sleep(1); \
    if ((++_sp & 255u) == 0u) { if (xb_ld(&(bar)[XB_TMO])) break; if (_sp > XB_SPIN_CAP) { atomicAdd(&(bar)[XB_TMO], 1u); break; } } } } while (0)
__device__ __forceinline__ void xcd_barrier_complete(unsigned* bar, unsigned x, unsigned& nloc, unsigned& nx) {
    const unsigned G = gridDim.x;
    unsigned sum, cnt, mine, sp = 0u;
    for (;;) {
        sum = 0u; cnt = 0u; mine = 0u;
#pragma unroll
        for (unsigned j = 0; j < 16; ++j) { const unsigned c = xb_ld(&bar[XB_XCNT(j)]); sum += c; cnt += (c > 0u) ? 1u : 0u; mine = (j == x) ? c : mine; }
        if (sum == G) break;
        __builtin_amdgcn_s_sleep(1);
        if ((++sp & 255u) == 0u) { if (xb_ld(&bar[XB_TMO])) break; if (sp > XB_SPIN_CAP) { atomicAdd(&bar[XB_TMO], 1u); break; } }
    }
    nloc = mine > 0u ? mine : 1u; nx = cnt > 0u ? cnt : 1u;
}
__device__ __forceinline__ void xcd_barrier(unsigned* bar, volatile LAS unsigned* st) {
    asm volatile("s_waitcnt vmcnt(0)" ::: "memory");
    __syncthreads();
    if (threadIdx.x == 0) {
        __builtin_amdgcn_s_waitcnt(0);
        const unsigned x = xb_xcc_id();
        unsigned nloc = st[0], nx = st[1];
        if (nloc == 0u) { xcd_barrier_complete(bar, x, nloc, nx); st[0] = nloc; st[1] = nx; }
        const unsigned old = xb_add(&bar[XB_XSUB(x)], 1u);
        const unsigned gen = old / nloc;
        if (old + 1u == (gen + 1u) * nloc) {
            __builtin_amdgcn_fence(__ATOMIC_RELEASE, "agent");
            asm volatile("s_waitcnt vmcnt(0)" ::: "memory");
            __builtin_amdgcn_fence(__ATOMIC_ACQUIRE, "agent");
            const unsigned og = xb_add(&bar[XB_TOP], 1u);
            const unsigned tg = og / nx;
            if (og + 1u == (tg + 1u) * nx) xb_add(&bar[XB_TOPGEN], 1u);
            else XB_SPIN(xb_ld(&bar[XB_TOPGEN]) == tg, bar);
            xb_add(&bar[XB_XGEN(x)], 1u);
            asm volatile("s_waitcnt vmcnt(0)" ::: "memory");
        } else {
            __builtin_amdgcn_fence(__ATOMIC_ACQUIRE, "agent");
            XB_SPIN(xb_ld(&bar[XB_XGEN(x)]) == gen, bar);
            asm volatile("s_waitcnt vmcnt(0)" ::: "memory");
        }
    }
    __syncthreads();
}
constexpr int LDS_BARST = LDS_BYTES - 64;

constexpr int N_PHASES = 14;
#ifndef DBG_STOP
#define DBG_STOP 99
#endif
#ifndef DBG_SRC
#define DBG_SRC WS_UP
#endif

__device__ __forceinline__ Frame make_frame(LAS unsigned char* lds) {
    Frame F;
    ArgsP a = (ArgsP)__builtin_amdgcn_kernarg_segment_ptr(); asm volatile("" : "+s"(a));
    int t = threadIdx.x; asm volatile("" : "+v"(t));
    F.a = a; F.ws = a->ws; F.out = a->out; F.lds = lds;
    F.tid = t; F.lane = t & 63; F.wave = __builtin_amdgcn_readfirstlane(t >> 6); F.G = gridDim.x;
    F.gw = blockIdx.x * 8 + F.wave; F.NGW = F.G * 8;
    return F;
}
#define XN_(F) ((bf16_t*)((F).ws + WS_XN))
#define X_(F) ((float*)((F).ws + WS_X))
#define H_(F) ((bf16_t*)((F).ws + WS_H))
#define VCU_(F) (((F).G & 7) == 0 ? (int)((blockIdx.x & 7) * ((F).G >> 3) + (blockIdx.x >> 3)) : (int)blockIdx.x)
#define PB_(F) ((float*)((F).ws + WS_PB))
#define X0_(F) (X0Src{(F).a->in[5], (F).a->in[0], (F).a->in[1]})

__global__ void __launch_bounds__(512, 2) mk_fwd(Args args) {
    extern __shared__ __attribute__((aligned(16))) unsigned char lds_raw[];
    LAS unsigned char* const lds = (LAS unsigned char*)lds_raw;
    const int lo = args.ph_lo, hi = args.ph_hi;
    if (threadIdx.x < 2) ((volatile LAS unsigned*)(lds + LDS_BARST))[threadIdx.x] = 0u;
    if (threadIdx.x == 0) (void)xb_add((unsigned*)(args.ws + WS_CTL) + XB_XCNT(xb_xcc_id()), 1u);
    __syncthreads();
#define IN(k) (lo <= (k) && (k) < hi && ((k) < DBG_STOP || (k) == 13))
#define SEAM(k) do { if (lo <= (k) && (k) + 1 < hi) { if (hi > 1000) cg::this_grid().sync();   ArgsP a_ = (ArgsP)__builtin_amdgcn_kernarg_segment_ptr(); asm volatile("" : "+s"(a_)); xcd_barrier((unsigned*)(a_->ws + WS_CTL), (volatile LAS unsigned*)(lds + LDS_BARST)); } } while (0)

    if (IN(0)) { const Frame F = make_frame(lds);
        cvt_ffn(F, 7, F.gw, F.NGW);
        const X0Src x0 = X0_(F); bf16_t* XN = XN_(F);
        for (int r = F.gw; r < MP; r += F.NGW) { const float* xr = x0_row(x0, r); if (xr) rms_row(xr, F.a->in[6], XN + (size_t)r * D, nullptr, F.lane); else zero_row_bf16(XN + (size_t)r * D, F.lane); }
    }
    SEAM(0);
    if (IN(1)) { const Frame F = make_frame(lds);
        pg8::Gemm g{XN_(F), (const bf16_t*)(F.ws + WS_WGU), D, D, MP, 2 * FF, D, 0}; pg8::PadOrder S; S.init(2 * FF, D, F.G, blockIdx.x);
        pg8::EpiSwiGLU E{H_(F)}; pg8::gemm_phase(lds, g, S, E); }
    SEAM(1);
    if (IN(2)) { const Frame F = make_frame(lds);
        pg8::Gemm g{H_(F), (const bf16_t*)(F.ws + WS_WD), FF, FF, MP, D, FF, 0}; pg8::TailSplitOrder S; S.init(D, FF, F.G, blockIdx.x, 1);
        pg8::EpiDownFinal<1, true> E{X0_(F), X_(F), 0.5f, F.a->in[10], nullptr, XN_(F), (unsigned*)(F.ws + WS_CTL + CTL_XBUF), (unsigned*)(F.ws + WS_CTL + CTL_CNT)}; pg8::gemm_phase(lds, g, S, E);
        if ((int)blockIdx.x < 24 * pg8::TS_NSPLIT) { const Frame F3 = make_frame(lds);
            pg8::Gemm g3{H_(F3), (const bf16_t*)(F3.ws + WS_WD), FF, FF, MP, D, FF, 0}; pg8::TailSplitOrder S3; S3.init(D, FF, F3.G, blockIdx.x, 2);
            pg8::EpiAdd<true> E3{X0_(F3), X_(F3), PB_(F3), 0.5f}; pg8::gemm_phase(lds, g3, S3, E3); }
        if (lo == 0) { const Frame F2 = make_frame(lds); const int nb = 24 * pg8::TS_NSPLIT;
            if ((int)blockIdx.x >= nb) cvt_mixer(F2, ((int)blockIdx.x - nb) * 8 + F2.wave, (F2.G - nb) * 8, 0, 3904); } }
    SEAM(2);
    if (IN(3)) { const Frame F = make_frame(lds); bf16_t* XN = XN_(F); float* X = X_(F); const float* PB = PB_(F);
        for (int r = pg8::TS_ROWS0 + F.gw; r < MP; r += F.NGW) { if (r < MV) {
                rms_row(X + (size_t)r * D, F.a->in[10], XN + (size_t)r * D, nullptr, F.lane, r >= pg8::TS_ROWS0 ? X + (size_t)r * D : nullptr, r >= pg8::TS_ROWS0 ? PB + (size_t)(r - pg8::TS_ROWS0) * D : nullptr, (size_t)(MP - pg8::TS_ROWS0) * D); }
            else zero_row_bf16(XN + (size_t)r * D, F.lane); } }
    SEAM(3);
    if (IN(4)) { const Frame F = make_frame(lds);
        pg8::Gemm g{XN_(F), (const bf16_t*)(F.ws + WS_WIN), D, D, MP, WIN, D, 0}; pg8::StaticOrder S; S.init(MP, WIN, F.G, blockIdx.x, D);
        pg8::EpiWin E{(float*)(F.ws + WS_UP), (float*)(F.ws + WS_US), (bf16_t*)(F.ws + WS_G), F.a->in[12]}; pg8::gemm_phase(lds, g, S, E);
        { const Frame F2 = make_frame(lds); const int nb = (MP / 256) * (WIN / 256) - 3 * F2.G;
          if ((int)blockIdx.x >= nb) { cvt_ffn(F2, 29, ((int)blockIdx.x - nb) * 8 + F2.wave, (F2.G - nb) * 8, 0, 4); cvt_ffn(F2, 29, ((int)blockIdx.x - nb) * 8 + F2.wave, (F2.G - nb) * 8, 1, 4); } } }
    SEAM(4);
    if (IN(5)) { __syncthreads();
        { const Frame F = make_frame(lds); s5_phase(F); }
        { const Frame F = make_frame(lds); pool_phase(F); }
        __syncthreads(); }
    SEAM(5);
    if (IN(6)) {
        { const Frame F = make_frame(lds);
          pg8::Gemm g{(const bf16_t*)(F.ws + WS_DD), (const bf16_t*)(F.ws + WS_PW), WPOOL, 256, MP, WPOOL, 256, 512}; pg8::StaticOrder S; S.init(MP, WPOOL, F.G, blockIdx.x, 256);
          pg8::EpiPool E{XN_(F), F.a->in[14]}; pg8::gemm_phase(lds, g, S, E); }
        { const Frame F = make_frame(lds);
          pg8::Gemm g{(const bf16_t*)(F.ws + WS_SG), (const bf16_t*)(F.ws + WS_GLU), WSSM, WSSM, MP, WSSM, WSSM, 0}; pg8::StaticOrder S; S.init(MP, WSSM, F.G, (blockIdx.x + F.G / 2) % F.G, WSSM);
          pg8::EpiGLU E{XN_(F), (const bf16_t*)(F.ws + WS_SG), F.a->in[24]}; pg8::gemm_phase(lds, g, S, E); }
    }
    SEAM(6);
    if (IN(7)) { const Frame F = make_frame(lds);
        pg8::Gemm g{XN_(F), (const bf16_t*)(F.ws + WS_WA), 2048, 1024, MP, D, 1024, 0}; pg8::StaticOrder S; S.init(MP, D, F.G, blockIdx.x, 1024);
        pg8::EpiBr1 E{(bf16_t*)(F.ws + WS_T1), (const bf16_t*)(F.ws + WS_G)}; pg8::gemm_phase(lds, g, S, E);
        { const Frame F2 = make_frame(lds); if ((int)blockIdx.x >= 24) { cvt_mixer(F2, ((int)blockIdx.x - 24) * 8 + F2.wave, (F2.G - 24) * 8, 3904, 4416);
              cvt_ffn(F2, 29, ((int)blockIdx.x - 24) * 8 + F2.wave, (F2.G - 24) * 8, 2, 4); } } }
    SEAM(7);
    if (IN(8)) { const Frame F = make_frame(lds);
        pg8::Gemm g{XN_(F) + 1024, (const bf16_t*)(F.ws + WS_WB), 2048, 1024, MP, D, 1024, 0}; pg8::StaticOrder S; S.init(MP, D, F.G, blockIdx.x, 1024);
        pg8::EpiBr2 E{(const bf16_t*)(F.ws + WS_T1), (const bf16_t*)(F.ws + WS_G), (bf16_t*)(F.ws + WS_MRG)}; pg8::gemm_phase(lds, g, S, E);
        { const Frame F2 = make_frame(lds); if ((int)blockIdx.x >= 24) { cvt_mixer(F2, ((int)blockIdx.x - 24) * 8 + F2.wave, (F2.G - 24) * 8, 4416, 5440);
              cvt_ffn(F2, 29, ((int)blockIdx.x - 24) * 8 + F2.wave, (F2.G - 24) * 8, 3, 4); } } }
    SEAM(8);
    if (IN(9)) { const Frame F = make_frame(lds);
        pg8::Gemm g{(const bf16_t*)(F.ws + WS_MRG), (const bf16_t*)(F.ws + WS_WOUT), D, D, MP, D, D, 0}; pg8::TailSplitOrder S; S.init(D, D, F.G, blockIdx.x, 1);
        pg8::EpiDownFinal<1, false> E{X0_(F), X_(F), 1.0f, F.a->in[28], nullptr, XN_(F), (unsigned*)(F.ws + WS_CTL + CTL_XBUF + 262144), (unsigned*)(F.ws + WS_CTL + CTL_CNT) + 2048}; pg8::gemm_phase(lds, g, S, E);
        if ((int)blockIdx.x < 24 * pg8::TS_NSPLIT) { const Frame F3 = make_frame(lds);
            pg8::Gemm g3{(const bf16_t*)(F3.ws + WS_MRG), (const bf16_t*)(F3.ws + WS_WOUT), D, D, MP, D, D, 0}; pg8::TailSplitOrder S3; S3.init(D, D, F3.G, blockIdx.x, 2);
            pg8::EpiAdd<false> E3{X0_(F3), X_(F3), (float*)(F3.ws + WS_DD), 1.0f}; pg8::gemm_phase(lds, g3, S3, E3); } }
    SEAM(9);
    if (IN(10)) { const Frame F = make_frame(lds); bf16_t* XN = XN_(F); float* X = X_(F); const float* PB = (const float*)(F.ws + WS_DD);
        for (int r = pg8::TS_ROWS0 + F.gw; r < MP; r += F.NGW) { if (r < MV) {
                rms_row(X + (size_t)r * D, F.a->in[28], XN + (size_t)r * D, nullptr, F.lane, r >= pg8::TS_ROWS0 ? X + (size_t)r * D : nullptr, r >= pg8::TS_ROWS0 ? PB + (size_t)(r - pg8::TS_ROWS0) * D : nullptr, (size_t)(MP - pg8::TS_ROWS0) * D); }
            else zero_row_bf16(XN + (size_t)r * D, F.lane); } }
    SEAM(10);
    if (IN(11)) { const Frame F = make_frame(lds);
        pg8::Gemm g{XN_(F), (const bf16_t*)(F.ws + WS_WGU), D, D, MP, 2 * FF, D, 0}; pg8::PadOrder S; S.init(2 * FF, D, F.G, blockIdx.x);
        pg8::EpiSwiGLU E{H_(F)}; pg8::gemm_phase(lds, g, S, E); }
    SEAM(11);
    if (IN(12)) { { const Frame F = make_frame(lds);
        pg8::Gemm g{H_(F), (const bf16_t*)(F.ws + WS_WD), FF, FF, MP, D, FF, 0}; pg8::TailSplitOrder S; S.init(D, FF, F.G, blockIdx.x, 1);
        pg8::EpiDownFinal<0, false> E{X0_(F), X_(F), 0.5f, F.a->in[32], F.out, nullptr, (unsigned*)(F.ws + WS_CTL + CTL_XBUF + 2 * 262144), (unsigned*)(F.ws + WS_CTL + CTL_CNT) + 2 * 2048}; pg8::gemm_phase(lds, g, S, E); }
      if ((int)blockIdx.x < 24 * pg8::TS_NSPLIT) { const Frame F = make_frame(lds);
        pg8::Gemm g{H_(F), (const bf16_t*)(F.ws + WS_WD), FF, FF, MP, D, FF, 0}; pg8::TailSplitOrder S; S.init(D, FF, F.G, blockIdx.x, 2);
        pg8::EpiAdd<false> E{X0_(F), X_(F), PB_(F), 0.5f}; pg8::gemm_phase(lds, g, S, E); } }
    SEAM(12);
    if (IN(13) && DBG_STOP < 99) { const Frame F = make_frame(lds);
        const f32x4* src = (const f32x4*)(F.ws + DBG_SRC); f32x4* dst = (f32x4*)F.out;
        for (size_t i = (size_t)blockIdx.x * 512 + F.tid; i < O_PP / 4; i += (size_t)F.G * 512) dst[i] = src[i];
    } else
    if (IN(13)) { const Frame F = make_frame(lds); const float* X = X_(F);
        for (int r = pg8::TS_ROWS0 + F.gw; r < MV; r += F.NGW) {
            float* o;
            if (r < MPR) { const int b = r / LP, t = r - b * LP; if (t < NMETA) continue; o = F.out + O_YP + ((size_t)b * SEQ + (t - NMETA)) * D; }
            else o = F.out + O_YS + (size_t)(r - MPR) * D;
            rms_row(X + (size_t)r * D, F.a->in[32], nullptr, o, F.lane, nullptr, r >= pg8::TS_ROWS0 ? PB_(F) + (size_t)(r - pg8::TS_ROWS0) * D : nullptr, (size_t)(MP - pg8::TS_ROWS0) * D);
        }
    }
#undef IN
#undef SEAM
}

extern "C" void kernel_launch(void* const* d_in, const int* in_sizes, int n_in, void* d_out, int out_size, void* d_ws, size_t ws_size, hipStream_t stream) {
    static int grid = 0;
    if (grid == 0) {
        if (n_in != 33 || ws_size < WS_END) { fprintf(stderr, "kernel_launch: expected 33 inputs and >= %zu bytes of workspace; got %d, %zu\n", (size_t)WS_END, n_in, ws_size); grid = -1; return; }
        int dev = 0, cus = 0, per_cu = 0;
        if (hipGetDevice(&dev) != hipSuccess || hipDeviceGetAttribute(&cus, hipDeviceAttributeMultiprocessorCount, dev) != hipSuccess) { grid = -1; return; }
        if (hipFuncSetAttribute((const void*)mk_fwd, hipFuncAttributeMaxDynamicSharedMemorySize, LDS_BYTES) != hipSuccess) { fprintf(stderr, "kernel_launch: hipFuncSetAttribute failed\n"); grid = -1; return; }
        if (hipOccupancyMaxActiveBlocksPerMultiprocessor(&per_cu, (const void*)mk_fwd, 512, LDS_BYTES) != hipSuccess || per_cu < 1) { fprintf(stderr, "kernel_launch: occupancy query says %d\n", per_cu); per_cu = 1; }
        (void)hipGetLastError();
        grid = cus * per_cu;
        if (grid > 256) grid = 256;
        if (grid != 256) fprintf(stderr, "kernel_launch: this kernel needs a 256-workgroup cooperative grid; got capacity %d\n", grid);
    }
    if (grid < 0) return;
    Args a{};
    for (int i = 0; i < 33; ++i) a.in[i] = (const float*)d_in[i];
    a.out = (float*)d_out; a.ws = (unsigned char*)d_ws;
#if MK_N_LAUNCHES == 1
    if (hipMemsetAsync((char*)d_ws + WS_CTL, 0, CTL_XBUF  , stream) != hipSuccess) { fprintf(stderr, "kernel_launch: hipMemsetAsync failed\n"); return; }
    a.ph_lo = 0; a.ph_hi = N_PHASES;
    void* kargs[] = {&a};
    hipError_t e = hipLaunchCooperativeKernel((const void*)mk_fwd, dim3(grid), dim3(512), kargs, LDS_BYTES, stream);
    if (e != hipSuccess) fprintf(stderr, "kernel_launch: cooperative launch failed: %s (grid %d)\n", hipGetErrorString(e), grid);
#else
    for (int p = 0; p < N_PHASES; ++p) { a.ph_lo = p; a.ph_hi = p + 1; hipLaunchKernelGGL(mk_fwd, dim3(grid), dim3(512), LDS_BYTES, stream, a); }
#endif
}
```
